# Optimizing an MI355X kernel written in HIP

```python
import jax, jax.numpy as jnp
from jax import lax
import numpy as np

D_MODEL = 1024
BATCH = 8
SEQ = 2048
DEPTH = 2

GRID_W = 64
CTX_LEN = 256
HEAD_DIM = 64
ATTN_BLOCK = 128
WINDOW = 128
ROPE_THETA = 10000.0
NORM_EPS = 1e-6
N_MOD = 9
N_BRANCHES = 3
D_FF = 2816
A_HEADS = 8
A_KV_HEADS = 2
B_HEADS = 8
B_KV_HEADS = 2
C_HEADS = 8
C_NOPE_DIM = 64
C_ROPE_DIM = 32
C_QK_DIM = C_NOPE_DIM + C_ROPE_DIM
C_V_DIM = 64
C_Q_RANK = 384
C_KV_RANK = 256

A_Q = A_HEADS * HEAD_DIM
A_KV = A_KV_HEADS * HEAD_DIM
B_Q = B_HEADS * HEAD_DIM
B_KV = B_KV_HEADS * HEAD_DIM
C_OUT = C_HEADS * C_V_DIM
KV_SPLITS = (A_KV, A_KV, B_KV, B_KV, C_KV_RANK, C_ROPE_DIM)
Q_SPLITS = (A_Q, B_Q, C_Q_RANK)
GATE_COLS = N_BRANCHES * D_MODEL
KV_COLS = sum(KV_SPLITS)
IN_COLS = KV_COLS + sum(Q_SPLITS) + GATE_COLS

kernel_name = "hybrid_gated_tri_attention_dit_block"


def rms_norm(x, g):
    xf = x.astype(jnp.float32)
    y = xf * lax.rsqrt(jnp.mean(jnp.square(xf), axis=-1, keepdims=True) + NORM_EPS)
    return (y * g.astype(jnp.float32)).astype(x.dtype)


def adaln(h, g, shift, scale):
    return rms_norm(h, g) * (1 + scale) + shift


def swiglu(h, w_in, w_out):
    gate, up = jnp.split(h @ w_in, 2, axis=-1)
    return (jax.nn.silu(gate) * up) @ w_out


def split_cols(t, sizes):
    idx = [int(i) for i in np.cumsum(sizes)[:-1]]
    return jnp.split(t, idx, axis=-1)


def heads(t, n_heads):
    return t.reshape(t.shape[0], t.shape[1], n_heads, -1)


def axial_rope_tables(n_tokens, rot_dim):
    rows = n_tokens // GRID_W
    row = jnp.repeat(jnp.arange(rows, dtype=jnp.float32), GRID_W)
    col = jnp.tile(jnp.arange(GRID_W, dtype=jnp.float32), rows)
    n_freq = rot_dim // 4
    inv_freq = ROPE_THETA ** (-jnp.arange(n_freq, dtype=jnp.float32) / n_freq)
    ang = jnp.concatenate([row[:, None] * inv_freq, col[:, None] * inv_freq], axis=-1)
    return jnp.cos(ang)[:, None, :], jnp.sin(ang)[:, None, :]


def apply_rope(x, rope):
    cos, sin = rope
    cos = cos.astype(x.dtype)
    sin = sin.astype(x.dtype)
    x1, x2 = x[..., 0::2], x[..., 1::2]
    return jnp.stack([x1 * cos - x2 * sin, x1 * sin + x2 * cos], axis=-1).reshape(x.shape)


def qk_prep(t, n_heads, g, rope):
    t = rms_norm(heads(t, n_heads), g)
    return t if rope is None else apply_rope(t, rope)


def rope_tail(t, n_rot, rope):
    if rope is None:
        return t
    return jnp.concatenate([t[..., :-n_rot], apply_rope(t[..., -n_rot:], rope)], axis=-1)


def mla_keys_values(c_kv, k_rope, p, rope):
    kv = heads(rms_norm(c_kv, p["c_kv_lat_norm"]) @ p["c_w_ukv"], C_HEADS)
    k_nope, v = kv[..., :C_NOPE_DIM], kv[..., C_NOPE_DIM:]
    k_rope = jnp.broadcast_to(k_rope[:, :, None, :], k_nope.shape[:-1] + (C_ROPE_DIM,))
    k = rms_norm(jnp.concatenate([k_nope, k_rope], axis=-1), p["c_k_norm"])
    return rope_tail(k, C_ROPE_DIM, rope), v


def mla_queries(c_q, p, rope):
    q = heads(rms_norm(c_q, p["c_q_lat_norm"]) @ p["c_w_uq"], C_HEADS)
    return rope_tail(rms_norm(q, p["c_q_norm"]), C_ROPE_DIM, rope)


def blocked_gqa(q, k, v, sink=None):
    bsz, n_q, n_heads, dqk = q.shape
    n_kv = k.shape[2]
    grp = n_heads // n_kv
    dv = v.shape[-1]
    nb = n_q // ATTN_BLOCK
    scale = dqk ** -0.5
    qb = jnp.moveaxis(q.reshape(bsz, nb, ATTN_BLOCK, n_kv, grp, dqk), 1, 0)

    def attend(q_blk):
        s = jnp.einsum('bqkgd,bmkd->bkgqm', q_blk, k).astype(jnp.float32) * scale
        if sink is not None:
            s_sink = jnp.broadcast_to(sink.astype(jnp.float32).reshape(n_kv, grp, 1, 1), s.shape[:-1] + (1,))
            s = jnp.concatenate([s, s_sink], axis=-1)
        p = jax.nn.softmax(s, axis=-1).astype(v.dtype)
        if sink is not None:
            p = p[..., :-1]
        return jnp.einsum('bkgqm,bmkd->bqkgd', p, v)

    o = lax.map(attend, qb)
    return jnp.moveaxis(o, 0, 1).reshape(bsz, n_q, n_heads * dv)


def windowed_gqa_with_sink(q, k, v, k_ctx, v_ctx, sink):
    bsz, seq, n_heads, dh = q.shape
    n_kv = k.shape[2]
    grp = n_heads // n_kv
    n_ctx = k_ctx.shape[1]
    nb = seq // ATTN_BLOCK
    halo = (WINDOW // ATTN_BLOCK) * ATTN_BLOCK
    span = ATTN_BLOCK + 2 * halo
    scale = dh ** -0.5
    pad = ((0, 0), (halo, halo), (0, 0), (0, 0))
    kp = jnp.pad(k, pad)
    vp = jnp.pad(v, pad)
    qb = jnp.moveaxis(q.reshape(bsz, nb, ATTN_BLOCK, n_kv, grp, dh), 1, 0)
    offs = jnp.arange(span) - halo
    rel = offs[None, :] - jnp.arange(ATTN_BLOCK)[:, None]
    sink_f = sink.astype(jnp.float32).reshape(n_kv, grp, 1, 1)

    def attend(args):
        n, q_blk = args
        start = n * ATTN_BLOCK
        k_blk = lax.dynamic_slice_in_dim(kp, start, span, axis=1)
        v_blk = lax.dynamic_slice_in_dim(vp, start, span, axis=1)
        k_pos = start + offs
        valid = (jnp.abs(rel) <= WINDOW) & ((k_pos >= 0) & (k_pos < seq))[None, :]
        s_loc = jnp.einsum('bqkgd,bmkd->bkgqm', q_blk, k_blk).astype(jnp.float32) * scale
        s_loc = jnp.where(valid, s_loc, -jnp.inf)
        s_ctx = jnp.einsum('bqkgd,bmkd->bkgqm', q_blk, k_ctx).astype(jnp.float32) * scale
        s_sink = jnp.broadcast_to(sink_f, s_ctx.shape[:-1] + (1,))
        p = jax.nn.softmax(jnp.concatenate([s_loc, s_ctx, s_sink], axis=-1), axis=-1).astype(v.dtype)
        return (jnp.einsum('bkgqm,bmkd->bqkgd', p[..., :span], v_blk)
                + jnp.einsum('bkgqm,bmkd->bqkgd', p[..., span:span + n_ctx], v_ctx))

    o = lax.map(attend, (jnp.arange(nb), qb))
    return jnp.moveaxis(o, 0, 1).reshape(bsz, seq, n_heads * dh)


def merge_branches(ya, yb, yc, gates, p):
    ga, gb, gc = jnp.split(gates, N_BRANCHES, axis=-1)
    m = (jax.nn.sigmoid(ga) * (ya @ p["w_branch_a"])
         + jax.nn.sigmoid(gb) * (yb @ p["w_branch_b"])
         + jax.nn.sigmoid(gc) * (yc @ p["w_branch_c"]))
    return m @ p["w_out"]


def token_mixers(ux, uz, p, rope_hd, rope_c, ctx_out):
    w_in = p["w_in"]
    ak, av, bk, bv, ckv, ckr = split_cols(uz @ w_in[:, :KV_COLS], KV_SPLITS)
    ka_z = qk_prep(ak, A_KV_HEADS, p["a_k_norm"], None)
    va_z = heads(av, A_KV_HEADS)
    kb_z = qk_prep(bk, B_KV_HEADS, p["b_k_norm"], None)
    vb_z = heads(bv, B_KV_HEADS)
    kc_z, vc_z = mla_keys_values(ckv, ckr, p, None)
    ak, av, bk, bv, ckv, ckr, aq, bq, cq, gates = split_cols(ux @ w_in, KV_SPLITS + Q_SPLITS + (GATE_COLS,))
    ka_x = qk_prep(ak, A_KV_HEADS, p["a_k_norm"], rope_hd)
    va_x = heads(av, A_KV_HEADS)
    kb_x = qk_prep(bk, B_KV_HEADS, p["b_k_norm"], rope_hd)
    vb_x = heads(bv, B_KV_HEADS)
    kc_x, vc_x = mla_keys_values(ckv, ckr, p, rope_c)
    qa_x = qk_prep(aq, A_HEADS, p["a_q_norm"], rope_hd)
    qb_x = qk_prep(bq, B_HEADS, p["b_q_norm"], rope_hd)
    qc_x = mla_queries(cq, p, rope_c)
    ya = windowed_gqa_with_sink(qa_x, ka_x, va_x, ka_z, va_z, p["a_sink"])
    yb = blocked_gqa(qb_x, jnp.concatenate([kb_z, kb_x], axis=1), jnp.concatenate([vb_z, vb_x], axis=1))
    yc = blocked_gqa(qc_x, jnp.concatenate([kc_z, kc_x], axis=1), jnp.concatenate([vc_z, vc_x], axis=1))
    mix_x = merge_branches(ya, yb, yc, gates, p)
    if not ctx_out:
        return mix_x, None
    aq, bq, cq, gates = split_cols(uz @ w_in[:, KV_COLS:], Q_SPLITS + (GATE_COLS,))
    ya = blocked_gqa(qk_prep(aq, A_HEADS, p["a_q_norm"], None), ka_z, va_z, sink=p["a_sink"])
    yb = blocked_gqa(qk_prep(bq, B_HEADS, p["b_q_norm"], None), kb_z, vb_z)
    yc = blocked_gqa(mla_queries(cq, p, None), kc_z, vc_z)
    return mix_x, merge_branches(ya, yb, yc, gates, p)


def setup_inputs(seed: int = 0) -> dict:
    key = jax.random.key(seed)
    ks = jax.random.split(key, 32)
    f32 = jnp.float32

    def w(k, shape, fan_in, mult=1.0):
        return jax.random.normal(k, shape, f32) * (mult * fan_in ** -0.5)

    def gain(k, shape):
        return 1.0 + 0.02 * jax.random.normal(k, shape, f32)

    D = D_MODEL
    return {
        "x": jax.random.normal(ks[0], (BATCH, SEQ, D), f32),
        "c": jax.random.normal(ks[1], (BATCH, D), f32),
        "ctx": jax.random.normal(ks[2], (BATCH, CTX_LEN, D), f32),
        "c_ctx": jax.random.normal(ks[3], (D,), f32),
        "ada_w": w(ks[4], (DEPTH, D, N_MOD * D), D, 0.5),
        "ada_b": 0.02 * jax.random.normal(ks[5], (DEPTH, N_MOD * D), f32),
        "ffn1_norm": gain(ks[6], (DEPTH, D)),
        "ffn1_w_in": w(ks[7], (DEPTH, D, 2 * D_FF), D),
        "ffn1_w_out": w(ks[8], (DEPTH, D_FF, D), D_FF),
        "mix_norm": gain(ks[9], (DEPTH, D)),
        "mix_w_in": w(ks[10], (DEPTH, D, IN_COLS), D),
        "a_q_norm": gain(ks[11], (DEPTH, HEAD_DIM)),
        "a_k_norm": gain(ks[12], (DEPTH, HEAD_DIM)),
        "a_sink": 0.5 * jax.random.normal(ks[13], (DEPTH, A_HEADS), f32),
        "b_q_norm": gain(ks[14], (DEPTH, HEAD_DIM)),
        "b_k_norm": gain(ks[15], (DEPTH, HEAD_DIM)),
        "c_q_lat_norm": gain(ks[16], (DEPTH, C_Q_RANK)),
        "c_w_uq": w(ks[17], (DEPTH, C_Q_RANK, C_HEADS * C_QK_DIM), C_Q_RANK),
        "c_kv_lat_norm": gain(ks[18], (DEPTH, C_KV_RANK)),
        "c_w_ukv": w(ks[19], (DEPTH, C_KV_RANK, C_HEADS * (C_NOPE_DIM + C_V_DIM)), C_KV_RANK),
        "c_q_norm": gain(ks[20], (DEPTH, C_QK_DIM)),
        "c_k_norm": gain(ks[21], (DEPTH, C_QK_DIM)),
        "w_branch_a": w(ks[22], (DEPTH, A_Q, D), A_Q),
        "w_branch_b": w(ks[23], (DEPTH, B_Q, D), B_Q),
        "w_branch_c": w(ks[24], (DEPTH, C_OUT, D), C_OUT),
        "mix_w_out": w(ks[25], (DEPTH, D, D), D),
        "ffn2_norm": gain(ks[26], (DEPTH, D)),
        "ffn2_w_in": w(ks[27], (DEPTH, D, 2 * D_FF), D),
        "ffn2_w_out": w(ks[28], (DEPTH, D_FF, D), D_FF),
    }


def reference(x, c, ctx, c_ctx, ada_w, ada_b, ffn1_norm, ffn1_w_in, ffn1_w_out, mix_norm, mix_w_in,
              a_q_norm, a_k_norm, a_sink, b_q_norm, b_k_norm, c_q_lat_norm, c_w_uq, c_kv_lat_norm, c_w_ukv,
              c_q_norm, c_k_norm, w_branch_a, w_branch_b, w_branch_c, mix_w_out, ffn2_norm, ffn2_w_in,
              ffn2_w_out):
    n_lat = x.shape[1]
    rope_hd = axial_rope_tables(n_lat, HEAD_DIM)
    rope_c = axial_rope_tables(n_lat, C_ROPE_DIM)
    cond_x = jax.nn.silu(c)
    cond_z = jax.nn.silu(c_ctx)
    z = ctx
    for l in range(DEPTH):
        last = l == DEPTH - 1
        mx = [m[:, None, :] for m in jnp.split(cond_x @ ada_w[l] + ada_b[l], N_MOD, axis=-1)]
        mz = [m[None, None, :] for m in jnp.split(cond_z @ ada_w[l] + ada_b[l], N_MOD, axis=-1)]
        x = x + 0.5 * mx[2] * swiglu(adaln(x, ffn1_norm[l], mx[0], mx[1]), ffn1_w_in[l], ffn1_w_out[l])
        z = z + 0.5 * mz[2] * swiglu(adaln(z, ffn1_norm[l], mz[0], mz[1]), ffn1_w_in[l], ffn1_w_out[l])
        lp = {
            "w_in": mix_w_in[l], "a_q_norm": a_q_norm[l], "a_k_norm": a_k_norm[l], "a_sink": a_sink[l],
            "b_q_norm": b_q_norm[l], "b_k_norm": b_k_norm[l], "c_q_lat_norm": c_q_lat_norm[l],
            "c_w_uq": c_w_uq[l], "c_kv_lat_norm": c_kv_lat_norm[l], "c_w_ukv": c_w_ukv[l],
            "c_q_norm": c_q_norm[l], "c_k_norm": c_k_norm[l], "w_branch_a": w_branch_a[l],
            "w_branch_b": w_branch_b[l], "w_branch_c": w_branch_c[l], "w_out": mix_w_out[l],
        }
        mix_x, mix_z = token_mixers(adaln(x, mix_norm[l], mx[3], mx[4]), adaln(z, mix_norm[l], mz[3], mz[4]),
                                    lp, rope_hd, rope_c, not last)
        x = x + mx[5] * mix_x
        x = x + 0.5 * mx[8] * swiglu(adaln(x, ffn2_norm[l], mx[6], mx[7]), ffn2_w_in[l], ffn2_w_out[l])
        if not last:
            z = z + mz[5] * mix_z
            z = z + 0.5 * mz[8] * swiglu(adaln(z, ffn2_norm[l], mz[6], mz[7]), ffn2_w_in[l], ffn2_w_out[l])
    return x
```

```cpp
#include <hip/hip_runtime.h>
#include <cstdio>
#include <cstdint>
#include <cmath>

constexpr int D = 1024, NB_ = 8, SEQ = 2048, CTXL = 256, DFF = 2816, DEPTH = 2;
constexpr int NLAT = NB_ * SEQ;
constexpr int NCTX = NB_ * CTXL;
constexpr int MT = NLAT + NCTX;
constexpr int NMOD = 9, MODW = NMOD * D;
constexpr int INC = 5280;
constexpr int O_AK = 0, O_AV = 128, O_BK = 256, O_BV = 384, O_CKV = 512, O_CKR = 768, O_AQ = 800, O_BQ = 1312, O_CQ = 1824, O_G = 2208;
constexpr int P1W = 2304;
constexpr int P_KA = 0, P_VA = 128, P_KB = 256, P_VB = 384, P_CKV = 512, P_CQ = 768, P_CKR = 1152, P_QA = 1280, P_QB = 1792;
constexpr float EPS = 1e-6f;
constexpr float LOG2E = 1.4426950408889634f;
constexpr float QSC64 = 0.125f * LOG2E;
constexpr float QSC96 = 0.10206207261596575f * LOG2E;

typedef unsigned short bf16_t;
typedef short bf16x8 __attribute__((ext_vector_type(8)));
typedef float f32x4 __attribute__((ext_vector_type(4)));
typedef unsigned u32x4 __attribute__((ext_vector_type(4)));
typedef unsigned u32x2 __attribute__((ext_vector_type(2)));

constexpr size_t WS_CTL = 0;
constexpr size_t WS_MOD = 1u << 20;
constexpr size_t WS_ROPE_HD = WS_MOD + (size_t)DEPTH * 9 * MODW * 4;
constexpr size_t WS_ROPE_C = WS_ROPE_HD + (size_t)SEQ * 32 * 2 * 4;
constexpr size_t WS_ROWSS = WS_ROPE_C + (size_t)SEQ * 16 * 2 * 4;
constexpr size_t WS_Z = WS_ROWSS + (size_t)MT * 12 * 4;
constexpr size_t WS_H = WS_Z + (size_t)NCTX * D * 4;
constexpr size_t WS_RA = WS_H + (size_t)MT * D * 2;
constexpr size_t RA_BYTES = (size_t)MT * 3072 * 2;
constexpr size_t WS_P1 = WS_RA + RA_BYTES;
constexpr size_t WS_YC = WS_P1 + (size_t)MT * P1W * 2;
constexpr size_t WS_W = WS_YC + (size_t)MT * 512 * 2;
constexpr size_t WS_END = WS_W + 52u * 1024 * 1024;
constexpr size_t RA_QC = 0, RA_KC = (size_t)MT * 768 * 2, RA_KVR = 2 * (size_t)MT * 768 * 2;

struct Params {
    const float* in[29];
    float* out;
    unsigned char* ws;
    float invf_hd[16];
    float invf_c[8];
    int ph_lo, ph_hi;
};

__device__ __forceinline__ float bf2f(bf16_t v) { return __uint_as_float((unsigned)v << 16); }
__device__ __forceinline__ bf16_t f2bf(float f) { unsigned u = __float_as_uint(f); return (bf16_t)((u + 0x7fffu + ((u >> 16) & 1u)) >> 16); }
__device__ __forceinline__ unsigned pk2(float lo, float hi) { return (unsigned)f2bf(lo) | ((unsigned)f2bf(hi) << 16); }
__device__ __forceinline__ float sigmoidf_(float v) { return 1.0f / (1.0f + __expf(-v)); }
__device__ __forceinline__ int row_mb(int r) { return r < NLAT ? (r >> 11) : 8; }

struct Ctx {
    const Params* p;
    int tid, lane, wave, wg, nwg;
    unsigned char* ws;
    float* mod; float* rope_hd; float* rope_c; float* rowss; float* Z; bf16_t* H; bf16_t* ACT; bf16_t* QC; bf16_t* KC; bf16_t* KVR; bf16_t* G; bf16_t* P1; bf16_t* YC;
};
__device__ __forceinline__ void ctx_init(Ctx& c, const Params* p, int wg, int nwg) {
    c.p = p; c.tid = threadIdx.x; c.lane = c.tid & 63; c.wave = __builtin_amdgcn_readfirstlane(c.tid >> 6); c.wg = wg; c.nwg = nwg;
    unsigned char* ws = p->ws; c.ws = ws;
    c.mod = (float*)(ws + WS_MOD); c.rope_hd = (float*)(ws + WS_ROPE_HD); c.rope_c = (float*)(ws + WS_ROPE_C); c.rowss = (float*)(ws + WS_ROWSS);
    c.Z = (float*)(ws + WS_Z); c.H = (bf16_t*)(ws + WS_H); c.ACT = (bf16_t*)(ws + WS_RA);
    c.QC = (bf16_t*)(ws + WS_RA + RA_QC); c.KC = (bf16_t*)(ws + WS_RA + RA_KC); c.KVR = (bf16_t*)(ws + WS_RA + RA_KVR); c.G = (bf16_t*)(ws + WS_RA);
    c.P1 = (bf16_t*)(ws + WS_P1); c.YC = (bf16_t*)(ws + WS_YC);
}
__device__ __forceinline__ const float* xin_row(const Ctx& c, int r, bool from_input) {
    if (from_input) return r < NLAT ? c.p->in[0] + (size_t)r * D : c.p->in[2] + (size_t)(r - NLAT) * D;
    return r < NLAT ? c.p->out + (size_t)r * D : c.Z + (size_t)(r - NLAT) * D;
}
__device__ __forceinline__ float* xout_row(const Ctx& c, int r) { return r < NLAT ? c.p->out + (size_t)r * D : c.Z + (size_t)(r - NLAT) * D; }

__device__ __forceinline__ void sincos_d(double x, float& s, float& c) {
    const double TWO_PI = 6.283185307179586476925286766559;
    const double k = rint(x * (1.0 / TWO_PI)); const double r = x - k * TWO_PI; const double r2 = r * r;
    double ts = r, ss = r, tc = 1.0, sc = 1.0;
    for (int n = 1; n <= 15; ++n) { ts *= -r2 / (double)((2 * n) * (2 * n + 1)); ss += ts; tc *= -r2 / (double)((2 * n - 1) * (2 * n)); sc += tc; }
    s = (float)ss; c = (float)sc;
}
__device__ __forceinline__ void phase_mod(Ctx& c, float* lds) {
    const Params* p = c.p;
    float* cond = lds;
    float* red = lds + 9 * 1024;
    for (int i = c.tid; i < 9 * 1024; i += 512) { const int mb = i >> 10, k = i & 1023; const float v = mb < 8 ? p->in[1][mb * 1024 + k] : p->in[3][k]; cond[i] = v * sigmoidf_(v); }
    __syncthreads();
    const int ks = c.tid >> 6, cc = c.tid & 63;
    for (int u = c.wg; u < DEPTH * MODW / 64; u += c.nwg) {
        const int n0 = u * 64, l = n0 / MODW, nn = n0 % MODW;
        float acc[9];
#pragma unroll
        for (int m = 0; m < 9; ++m) acc[m] = 0.f;
        const float* w = p->in[4] + ((size_t)l * D + ks * 128) * MODW + nn + cc;
#pragma unroll 8
        for (int k = 0; k < 128; ++k) { const float wv = w[(size_t)k * MODW];
#pragma unroll
            for (int m = 0; m < 9; ++m) acc[m] += cond[m * 1024 + ks * 128 + k] * wv; }
#pragma unroll
        for (int m = 0; m < 9; ++m) red[(ks * 9 + m) * 64 + cc] = acc[m];
        __syncthreads();
        for (int o = c.tid; o < 9 * 64; o += 512) { const int m = o >> 6, c2 = o & 63; float s = 0.f;
#pragma unroll
            for (int k2 = 0; k2 < 8; ++k2) s += red[(k2 * 9 + m) * 64 + c2];
            c.mod[((size_t)l * 9 + m) * MODW + nn + c2] = s + p->in[5][(size_t)l * MODW + nn + c2]; }
        __syncthreads();
    }
    const int gt = c.wg * 512 + c.tid, ngt = c.nwg * 512;
    for (int i = gt; i < SEQ * 48; i += ngt) {
        const int s = i / 48, j = i % 48; const int row = s >> 6, col = s & 63; float sn, cs;
        if (j < 32) { const double ang = (double)(j < 16 ? row : col) * (double)p->invf_hd[j & 15]; sincos_d(ang, sn, cs); c.rope_hd[(s * 32 + j) * 2] = cs; c.rope_hd[(s * 32 + j) * 2 + 1] = sn; }
        else { const int jj = j - 32; const double ang = (double)(jj < 8 ? row : col) * (double)p->invf_c[jj & 7]; sincos_d(ang, sn, cs); c.rope_c[(s * 16 + jj) * 2] = cs; c.rope_c[(s * 16 + jj) * 2 + 1] = sn; }
    }
}

__device__ __forceinline__ float wave_sum(float v) {
#pragma unroll
    for (int o = 1; o < 64; o <<= 1) v += __shfl_xor(v, o);
    return v;
}
__device__ __forceinline__ void phase_norm(Ctx& c, int l, const float* gain, int shift_idx, int rows, bool from_input) {
    const int gw = c.wg * 8 + c.wave, ngw = c.nwg * 8;
    for (int r = gw; r < rows; r += ngw) {
        const f32x4* xr = (const f32x4*)xin_row(c, r, from_input) + c.lane;
        f32x4 v[4]; float s = 0.f;
#pragma unroll
        for (int j = 0; j < 4; ++j) { v[j] = xr[64 * j]; s += (v[j].x * v[j].x + v[j].y * v[j].y) + (v[j].z * v[j].z + v[j].w * v[j].w); }
        const float rstd = 1.0f / sqrtf(wave_sum(s) * (1.0f / D) + EPS);
        const float* md = c.mod + ((size_t)l * 9 + row_mb(r)) * MODW;
        unsigned long long* o8 = (unsigned long long*)(c.H + (size_t)r * D) + c.lane;
#pragma unroll
        for (int j = 0; j < 4; ++j) { const int k = 4 * c.lane + 256 * j;
            const f32x4 g = *(const f32x4*)(gain + k), sh = *(const f32x4*)(md + shift_idx * D + k), sc = *(const f32x4*)(md + (shift_idx + 1) * D + k);
            const f32x4 y = v[j] * rstd * g * (sc + 1.0f) + sh;
            o8[64 * j] = (unsigned long long)pk2(y.x, y.y) | ((unsigned long long)pk2(y.z, y.w) << 32); }
    }
}

template <int NB>
__device__ __forceinline__ void naive_tile(const bf16_t* A, int lda, int K, int row0, const float* const (&wp)[NB], int ldw, const float* kscale, f32x4 (&acc)[NB], int lane) {
    const int r = lane & 15, q = lane >> 4;
    const bf16_t* ap = A + (size_t)(row0 + r) * lda + q * 8;
    for (int k0 = 0; k0 < K; k0 += 32) {
        const bf16x8 a = *(const bf16x8*)(ap + k0);
        float ks[8];
#pragma unroll
        for (int j = 0; j < 8; ++j) ks[j] = kscale ? kscale[k0 + q * 8 + j] : 1.0f;
#pragma unroll
        for (int nb = 0; nb < NB; ++nb) { bf16x8 b;
#pragma unroll
            for (int j = 0; j < 8; ++j) b[j] = (short)f2bf(wp[nb][(size_t)(k0 + q * 8 + j) * ldw + r] * ks[j]);
            acc[nb] = __builtin_amdgcn_mfma_f32_16x16x32_bf16(a, b, acc[nb], 0, 0, 0); }
    }
}
__device__ __forceinline__ float quad16_sum(float v) { v += __shfl_xor(v, 1); v += __shfl_xor(v, 2); v += __shfl_xor(v, 4); v += __shfl_xor(v, 8); return v; }

__device__ __forceinline__ void naive_ffn_up(Ctx& c, const float* w_in, int rows) {
    const int gw = c.wg * 8 + c.wave, ngw = c.nwg * 8, r = c.lane & 15, q = c.lane >> 4;
    const int nu = (rows / 16) * 176;
    for (int u = gw; u < nu; u += ngw) {
        const int rt = u / 176, cg = u % 176, row0 = rt * 16, c0 = cg * 16;
        const float* wp[2] = {w_in + c0, w_in + DFF + c0};
        f32x4 acc[2] = {{0.f, 0.f, 0.f, 0.f}, {0.f, 0.f, 0.f, 0.f}};
        naive_tile<2>(c.H, D, D, row0, wp, 2 * DFF, nullptr, acc, c.lane);
#pragma unroll
        for (int i = 0; i < 4; ++i) { const float g = acc[0][i], up = acc[1][i]; c.ACT[(size_t)(row0 + q * 4 + i) * DFF + c0 + r] = f2bf(g * sigmoidf_(g) * up); }
    }
}
__device__ __forceinline__ void naive_res(Ctx& c, int l, const bf16_t* A, int lda, int K, const float* W, float coef, int gi, int rows, bool from_input) {
    const int gw = c.wg * 8 + c.wave, ngw = c.nwg * 8, r = c.lane & 15, q = c.lane >> 4;
    const int nu = (rows / 16) * 16;
    for (int u = gw; u < nu; u += ngw) {
        const int rt = u / 16, cg = u % 16, row0 = rt * 16, c0 = cg * 64;
        const float* wp[4] = {W + c0, W + c0 + 16, W + c0 + 32, W + c0 + 48};
        f32x4 acc[4];
#pragma unroll
        for (int nb = 0; nb < 4; ++nb) acc[nb] = (f32x4){0.f, 0.f, 0.f, 0.f};
        naive_tile<4>(A, lda, K, row0, wp, D, nullptr, acc, c.lane);
#pragma unroll
        for (int i = 0; i < 4; ++i) { const int row = row0 + q * 4 + i; const float* md = c.mod + ((size_t)l * 9 + row_mb(row)) * MODW + gi * D;
            const float* bi = xin_row(c, row, from_input); float* bo = xout_row(c, row);
#pragma unroll
            for (int nb = 0; nb < 4; ++nb) { const int cc = c0 + nb * 16 + r; bo[cc] = bi[cc] + coef * md[cc] * acc[nb][i]; } }
    }
}
__device__ __forceinline__ void naive_inproj(Ctx& c, int l, int rows) {
    const Params* p = c.p;
    const int gw = c.wg * 8 + c.wave, ngw = c.nwg * 8, r = c.lane & 15, q = c.lane >> 4;
    const float* W = p->in[10] + (size_t)l * D * INC;
    const int nu = (rows / 16) * 36;
    for (int u = gw; u < nu; u += ngw) {
        const int rt = u / 36, g = u % 36, row0 = rt * 16;
        if (g == 19) continue;
        int src, dst, kind;
        if (g < 2) { src = O_AK + 64 * g; dst = P_KA + 64 * g; kind = 1; }
        else if (g < 4) { src = O_AV + 64 * (g - 2); dst = P_VA + 64 * (g - 2); kind = 0; }
        else if (g < 6) { src = O_BK + 64 * (g - 4); dst = P_KB + 64 * (g - 4); kind = 2; }
        else if (g < 8) { src = O_BV + 64 * (g - 6); dst = P_VB + 64 * (g - 6); kind = 0; }
        else if (g < 12) { src = O_CKV + 64 * (g - 8); dst = P_CKV + 64 * (g - 8); kind = 0; }
        else if (g < 18) { src = O_CQ + 64 * (g - 12); dst = P_CQ + 64 * (g - 12); kind = 0; }
        else if (g == 18) { src = O_CKR; dst = P_CKR; kind = 0; }
        else if (g < 28) { src = O_AQ + 64 * (g - 20); dst = P_QA + 64 * (g - 20); kind = 3; }
        else { src = O_BQ + 64 * (g - 28); dst = P_QB + 64 * (g - 28); kind = 4; }
        const float* wp[4] = {W + src, W + src + 16, W + src + (g == 18 ? 0 : 32), W + src + (g == 18 ? 0 : 48)};
        f32x4 acc[4];
#pragma unroll
        for (int nb = 0; nb < 4; ++nb) acc[nb] = (f32x4){0.f, 0.f, 0.f, 0.f};
        naive_tile<4>(c.H, D, D, row0, wp, INC, nullptr, acc, c.lane);
        const float* gn = kind == 1 ? p->in[12] + l * 64 : kind == 2 ? p->in[15] + l * 64 : kind == 3 ? p->in[11] + l * 64 : p->in[14] + l * 64;
#pragma unroll
        for (int i = 0; i < 4; ++i) {
            const int row = row0 + q * 4 + i;
            bf16_t* o = c.P1 + (size_t)row * P1W + dst;
            if (kind == 0) {
#pragma unroll
                for (int nb = 0; nb < 4; ++nb) { if (g == 18 && nb >= 2) o[nb * 16 + r] = 0; else o[nb * 16 + r] = f2bf(acc[nb][i]); }
            } else {
                float ss = 0.f;
#pragma unroll
                for (int nb = 0; nb < 4; ++nb) ss += acc[nb][i] * acc[nb][i];
                ss = quad16_sum(ss);
                const float rstd = 1.0f / sqrtf(ss * (1.0f / 64.0f) + EPS);
                const float qs = kind >= 3 ? QSC64 : 1.0f;
#pragma unroll
                for (int nb = 0; nb < 4; ++nb) { const int d = nb * 16 + r; float v = acc[nb][i] * rstd * gn[d];
                    const float pr = __shfl_xor(v, 1);
                    if (row < NLAT) { const int s = row & 2047; const float cs = c.rope_hd[(s * 32 + (d >> 1)) * 2], sn = c.rope_hd[(s * 32 + (d >> 1)) * 2 + 1];
                        v = (d & 1) ? (pr * sn + v * cs) : (v * cs - pr * sn); }
                    o[d] = f2bf(v * qs); }
            }
        }
    }
}
__device__ __forceinline__ void naive_rowss(Ctx& c, int rows) {
    const int gw = c.wg * 8 + c.wave, ngw = c.nwg * 8;
    for (int r = gw; r < rows; r += ngw) {
        const bf16_t* pr = c.P1 + (size_t)r * P1W;
        float s1 = 0.f, s2 = 0.f;
        for (int k = c.lane; k < 256; k += 64) { const float v = bf2f(pr[P_CKV + k]); s1 += v * v; }
        for (int k = c.lane; k < 384; k += 64) { const float v = bf2f(pr[P_CQ + k]); s2 += v * v; }
        s1 = wave_sum(s1); s2 = wave_sum(s2);
        if (c.lane < 12) c.rowss[(size_t)r * 12 + c.lane] = c.lane == 0 ? s1 : (c.lane == 4 ? s2 : 0.f);
    }
}
__device__ __forceinline__ float rowss_kv(const Ctx& c, int row) { const f32x4 a = *(const f32x4*)(c.rowss + (size_t)row * 12); return 1.0f / sqrtf(((a.x + a.y) + (a.z + a.w)) * (1.0f / 256.0f) + EPS); }
__device__ __forceinline__ float rowss_q(const Ctx& c, int row) { const f32x4 a = *(const f32x4*)(c.rowss + (size_t)row * 12 + 4), b = *(const f32x4*)(c.rowss + (size_t)row * 12 + 8);
    return 1.0f / sqrtf((((a.x + a.y) + (a.z + a.w)) + ((b.x + b.y) + (b.z + b.w))) * (1.0f / 384.0f) + EPS); }
__device__ __forceinline__ void naive_mla_q(Ctx& c, int l, int rows) {
    const Params* p = c.p;
    const int gw = c.wg * 8 + c.wave, ngw = c.nwg * 8, r = c.lane & 15, q = c.lane >> 4;
    const float* W = p->in[17] + (size_t)l * 384 * 768; const float* gl = p->in[16] + l * 384; const float* gn = p->in[20] + l * 96;
    const int nu = (rows / 16) * 8;
    for (int u = gw; u < nu; u += ngw) {
        const int rt = u / 8, h = u % 8, row0 = rt * 16;
        const float* wp[6];
#pragma unroll
        for (int nb = 0; nb < 6; ++nb) wp[nb] = W + 96 * h + 16 * nb;
        f32x4 acc[6];
#pragma unroll
        for (int nb = 0; nb < 6; ++nb) acc[nb] = (f32x4){0.f, 0.f, 0.f, 0.f};
        naive_tile<6>(c.P1 + P_CQ, P1W, 384, row0, wp, 768, gl, acc, c.lane);
#pragma unroll
        for (int i = 0; i < 4; ++i) {
            const int row = row0 + q * 4 + i; const float rq = rowss_q(c, row);
            float ss = 0.f;
#pragma unroll
            for (int nb = 0; nb < 6; ++nb) { acc[nb][i] *= rq; ss += acc[nb][i] * acc[nb][i]; }
            ss = quad16_sum(ss);
            const float rstd = 1.0f / sqrtf(ss * (1.0f / 96.0f) + EPS);
            bf16_t* o = c.QC + (size_t)row * 768 + 96 * h;
#pragma unroll
            for (int nb = 0; nb < 6; ++nb) { const int d = nb * 16 + r; float v = acc[nb][i] * rstd * gn[d];
                const float pr = __shfl_xor(v, 1);
                if (nb >= 4 && row < NLAT) { const int s = row & 2047, pi = (d - 64) >> 1; const float cs = c.rope_c[(s * 16 + pi) * 2], sn = c.rope_c[(s * 16 + pi) * 2 + 1];
                    v = (d & 1) ? (pr * sn + v * cs) : (v * cs - pr * sn); }
                o[d] = f2bf(v * QSC96); }
        }
    }
}
__device__ __forceinline__ void naive_mla_kv(Ctx& c, int l, int rows) {
    const Params* p = c.p;
    const int gw = c.wg * 8 + c.wave, ngw = c.nwg * 8, r = c.lane & 15, q = c.lane >> 4;
    const float* W = p->in[19] + (size_t)l * 256 * 1024; const float* gl = p->in[18] + l * 256; const float* gn = p->in[21] + l * 96;
    const int nu = (rows / 16) * 8;
    for (int u = gw; u < nu; u += ngw) {
        const int rt = u / 8, h = u % 8, row0 = rt * 16;
        const float* wp[8];
#pragma unroll
        for (int nb = 0; nb < 8; ++nb) wp[nb] = W + 128 * h + 16 * nb;
        f32x4 acc[8];
#pragma unroll
        for (int nb = 0; nb < 8; ++nb) acc[nb] = (f32x4){0.f, 0.f, 0.f, 0.f};
        naive_tile<8>(c.P1 + P_CKV, P1W, 256, row0, wp, 1024, gl, acc, c.lane);
#pragma unroll
        for (int i = 0; i < 4; ++i) {
            const int row = row0 + q * 4 + i; const float rk = rowss_kv(c, row);
            const float kr0 = bf2f(c.P1[(size_t)row * P1W + P_CKR + r]), kr1 = bf2f(c.P1[(size_t)row * P1W + P_CKR + 16 + r]);
            float ss = kr0 * kr0 + kr1 * kr1;
#pragma unroll
            for (int nb = 0; nb < 4; ++nb) { acc[nb][i] *= rk; ss += acc[nb][i] * acc[nb][i]; }
            ss = quad16_sum(ss);
            const float rstd = 1.0f / sqrtf(ss * (1.0f / 96.0f) + EPS);
            bf16_t* o = c.KC + (size_t)row * 768 + 96 * h;
#pragma unroll
            for (int nb = 0; nb < 4; ++nb) { const int d = nb * 16 + r; o[d] = f2bf(acc[nb][i] * rstd * gn[d]); }
#pragma unroll
            for (int nb = 0; nb < 2; ++nb) { const int d = 64 + nb * 16 + r; float v = (nb == 0 ? kr0 : kr1) * rstd * gn[d];
                const float pr = __shfl_xor(v, 1);
                if (row < NLAT) { const int s = row & 2047, pi = (d - 64) >> 1; const float cs = c.rope_c[(s * 16 + pi) * 2], sn = c.rope_c[(s * 16 + pi) * 2 + 1];
                    v = (d & 1) ? (pr * sn + v * cs) : (v * cs - pr * sn); }
                o[d] = f2bf(v); }
            bf16_t* ov = c.KVR + (size_t)row * 1024 + 128 * h + 64;
#pragma unroll
            for (int nb = 0; nb < 4; ++nb) ov[nb * 16 + r] = f2bf(acc[4 + nb][i] * rk);
        }
    }
}
__device__ __forceinline__ void naive_gates(Ctx& c, int l, int rows) {
    const int gw = c.wg * 8 + c.wave, ngw = c.nwg * 8, r = c.lane & 15, q = c.lane >> 4;
    const float* W = c.p->in[10] + (size_t)l * D * INC + O_G;
    const int nu = (rows / 16) * 48;
    for (int u = gw; u < nu; u += ngw) {
        const int rt = u / 48, cg = u % 48, row0 = rt * 16, c0 = cg * 64;
        const float* wp[4] = {W + c0, W + c0 + 16, W + c0 + 32, W + c0 + 48};
        f32x4 acc[4];
#pragma unroll
        for (int nb = 0; nb < 4; ++nb) acc[nb] = (f32x4){0.f, 0.f, 0.f, 0.f};
        naive_tile<4>(c.H, D, D, row0, wp, INC, nullptr, acc, c.lane);
#pragma unroll
        for (int i = 0; i < 4; ++i)
#pragma unroll
            for (int nb = 0; nb < 4; ++nb) c.G[(size_t)(row0 + q * 4 + i) * 3072 + c0 + nb * 16 + r] = f2bf(sigmoidf_(acc[nb][i]));
    }
}
__device__ __forceinline__ void naive_merge(Ctx& c, int l, int rows) {
    const Params* p = c.p;
    const int gw = c.wg * 8 + c.wave, ngw = c.nwg * 8, r = c.lane & 15, q = c.lane >> 4;
    const int nu = (rows / 16) * 16;
    for (int u = gw; u < nu; u += ngw) {
        const int rt = u / 16, cg = u % 16, row0 = rt * 16, c0 = cg * 64;
        float tot[4][4];
#pragma unroll
        for (int nb = 0; nb < 4; ++nb)
#pragma unroll
            for (int i = 0; i < 4; ++i) tot[nb][i] = 0.f;
#pragma unroll
        for (int br = 0; br < 3; ++br) {
            const float* W = p->in[22 + br] + (size_t)l * 512 * D;
            const float* wp[4] = {W + c0, W + c0 + 16, W + c0 + 32, W + c0 + 48};
            f32x4 acc[4];
#pragma unroll
            for (int nb = 0; nb < 4; ++nb) acc[nb] = (f32x4){0.f, 0.f, 0.f, 0.f};
            const bf16_t* A = br == 0 ? c.P1 + P_QA : (br == 1 ? c.P1 + P_QB : c.YC);
            naive_tile<4>(A, br == 2 ? 512 : P1W, 512, row0, wp, D, nullptr, acc, c.lane);
#pragma unroll
            for (int i = 0; i < 4; ++i)
#pragma unroll
                for (int nb = 0; nb < 4; ++nb) tot[nb][i] += bf2f(c.G[(size_t)(row0 + q * 4 + i) * 3072 + br * 1024 + c0 + nb * 16 + r]) * acc[nb][i];
        }
#pragma unroll
        for (int i = 0; i < 4; ++i)
#pragma unroll
            for (int nb = 0; nb < 4; ++nb) c.H[(size_t)(row0 + q * 4 + i) * D + c0 + nb * 16 + r] = f2bf(tot[nb][i]);
    }
}

template <int DQK>
__device__ __forceinline__ void naive_attn_keys(const bf16_t* Kb, int kpitch, const bf16_t* Vb, int vpitch, int k_lo, int k_hi, int srow, int window, const float (&qv)[DQK], float& m, float& l, float (&o)[64]) {
    for (int j = k_lo; j < k_hi; ++j) {
        const bf16_t* kr = Kb + (size_t)j * kpitch;
        float s = 0.f;
#pragma unroll
        for (int d8 = 0; d8 < DQK / 8; ++d8) { const bf16x8 kk = *(const bf16x8*)(kr + d8 * 8);
#pragma unroll
            for (int e = 0; e < 8; ++e) s += qv[d8 * 8 + e] * bf2f((bf16_t)kk[e]); }
        const bool ok = window < 0 || (j - srow <= window && srow - j <= window);
        if (ok) {
            const float mn = fmaxf(m, s); const float f = exp2f(m - mn), pp = exp2f(s - mn);
            l = l * f + pp; m = mn;
            const bf16_t* vr = Vb + (size_t)j * vpitch;
#pragma unroll
            for (int d8 = 0; d8 < 8; ++d8) { const bf16x8 vv = *(const bf16x8*)(vr + d8 * 8);
#pragma unroll
                for (int e = 0; e < 8; ++e) o[d8 * 8 + e] = o[d8 * 8 + e] * f + pp * bf2f((bf16_t)vv[e]); }
        }
    }
}
__device__ __forceinline__ void naive_attn(Ctx& c, int l, int row_lo, int row_hi) {
    const Params* p = c.p;
    const int gw = c.wg * 8 + c.wave, ngw = c.nwg * 8;
    const int nrw = (row_hi - row_lo) / 64;
    for (int u = gw; u < nrw * 24; u += ngw) {
        const int br = u / (nrw * 8), rem = u % (nrw * 8), h = rem / nrw, rw = rem % nrw;
        const int row = row_lo + rw * 64 + c.lane;
        const bool lat = row < NLAT; const int b = lat ? (row >> 11) : ((row - NLAT) >> 8); const int s = row & 2047;
        const int crow0 = NLAT + b * CTXL, lrow0 = b * SEQ;
        float o[64];
#pragma unroll
        for (int d = 0; d < 64; ++d) o[d] = 0.f;
        float m = -1e30f, lsum = 0.f;
        if (br == 2) {
            float qv[96];
            const bf16_t* qp = c.QC + (size_t)row * 768 + 96 * h;
#pragma unroll
            for (int d8 = 0; d8 < 12; ++d8) { const bf16x8 t = *(const bf16x8*)(qp + d8 * 8);
#pragma unroll
                for (int e = 0; e < 8; ++e) qv[d8 * 8 + e] = bf2f((bf16_t)t[e]); }
            naive_attn_keys<96>(c.KC + (size_t)crow0 * 768 + 96 * h, 768, c.KVR + (size_t)crow0 * 1024 + 128 * h + 64, 1024, 0, CTXL, 0, -1, qv, m, lsum, o);
            if (lat) naive_attn_keys<96>(c.KC + (size_t)lrow0 * 768 + 96 * h, 768, c.KVR + (size_t)lrow0 * 1024 + 128 * h + 64, 1024, 0, SEQ, 0, -1, qv, m, lsum, o);
            const float inv = 1.0f / lsum; bf16_t* op = c.YC + (size_t)row * 512 + 64 * h;
#pragma unroll
            for (int d8 = 0; d8 < 8; ++d8) { u32x4 w; w.x = pk2(o[d8 * 8] * inv, o[d8 * 8 + 1] * inv); w.y = pk2(o[d8 * 8 + 2] * inv, o[d8 * 8 + 3] * inv); w.z = pk2(o[d8 * 8 + 4] * inv, o[d8 * 8 + 5] * inv); w.w = pk2(o[d8 * 8 + 6] * inv, o[d8 * 8 + 7] * inv); *(u32x4*)(op + d8 * 8) = w; }
        } else {
            float qv[64];
            const int qoff = br == 0 ? P_QA : P_QB, koff = (br == 0 ? P_KA : P_KB) + 64 * (h >> 2), voff = (br == 0 ? P_VA : P_VB) + 64 * (h >> 2);
            bf16_t* qp = c.P1 + (size_t)row * P1W + qoff + 64 * h;
#pragma unroll
            for (int d8 = 0; d8 < 8; ++d8) { const bf16x8 t = *(const bf16x8*)(qp + d8 * 8);
#pragma unroll
                for (int e = 0; e < 8; ++e) qv[d8 * 8 + e] = bf2f((bf16_t)t[e]); }
            if (br == 0) { m = p->in[13][l * 8 + h] * LOG2E; lsum = 1.0f; }
            naive_attn_keys<64>(c.P1 + (size_t)crow0 * P1W + koff, P1W, c.P1 + (size_t)crow0 * P1W + voff, P1W, 0, CTXL, 0, -1, qv, m, lsum, o);
            if (lat) {
                if (br == 0) { const int s0 = __builtin_amdgcn_readfirstlane(s) & ~63; const int klo = s0 - 128 < 0 ? 0 : s0 - 128, khi = s0 + 63 + 128 + 1 > SEQ ? SEQ : s0 + 63 + 128 + 1;
                    naive_attn_keys<64>(c.P1 + (size_t)lrow0 * P1W + koff, P1W, c.P1 + (size_t)lrow0 * P1W + voff, P1W, klo, khi, s, 128, qv, m, lsum, o); }
                else naive_attn_keys<64>(c.P1 + (size_t)lrow0 * P1W + koff, P1W, c.P1 + (size_t)lrow0 * P1W + voff, P1W, 0, SEQ, 0, -1, qv, m, lsum, o);
            }
            const float inv = 1.0f / lsum;
#pragma unroll
            for (int d8 = 0; d8 < 8; ++d8) { u32x4 w; w.x = pk2(o[d8 * 8] * inv, o[d8 * 8 + 1] * inv); w.y = pk2(o[d8 * 8 + 2] * inv, o[d8 * 8 + 3] * inv); w.z = pk2(o[d8 * 8 + 4] * inv, o[d8 * 8 + 5] * inv); w.w = pk2(o[d8 * 8 + 6] * inv, o[d8 * 8 + 7] * inv); *(u32x4*)(qp + d8 * 8) = w; }
        }
    }
}

constexpr int NPHASE = 1 + 14 * DEPTH;
template <int S> __device__ __forceinline__ void run_stage(Ctx& c, int l, unsigned char* lds) {
    const Params* p = c.p;
    const bool last = l == DEPTH - 1;
    const int rows_all = MT, rows_mix = last ? NLAT : MT;
    if constexpr (S == -1) phase_mod(c, (float*)lds);
    if constexpr (S == 0) phase_norm(c, l, p->in[6] + l * D, 0, rows_all, l == 0);
    if constexpr (S == 1) naive_ffn_up(c, p->in[7] + (size_t)l * D * 2 * DFF, rows_all);
    if constexpr (S == 2) naive_res(c, l, c.ACT, DFF, DFF, p->in[8] + (size_t)l * DFF * D, 0.5f, 2, rows_all, l == 0);
    if constexpr (S == 3) phase_norm(c, l, p->in[9] + l * D, 3, rows_all, false);
    if constexpr (S == 4) naive_inproj(c, l, rows_all);
    if constexpr (S == 5) naive_rowss(c, rows_all);
    if constexpr (S == 6) { naive_mla_q(c, l, rows_mix); naive_mla_kv(c, l, rows_all); }
    if constexpr (S == 7) naive_attn(c, l, 0, rows_mix);
    if constexpr (S == 8) naive_gates(c, l, rows_mix);
    if constexpr (S == 9) naive_merge(c, l, rows_mix);
    if constexpr (S == 10) naive_res(c, l, c.H, D, D, p->in[25] + (size_t)l * D * D, 1.0f, 5, rows_mix, false);
    if constexpr (S == 11) phase_norm(c, l, p->in[26] + l * D, 6, rows_mix, false);
    if constexpr (S == 12) naive_ffn_up(c, p->in[27] + (size_t)l * D * 2 * DFF, rows_mix);
    if constexpr (S == 13) naive_res(c, l, c.ACT, DFF, DFF, p->in[28] + (size_t)l * DFF * D, 0.5f, 8, rows_mix, false);
}
template <int S> __global__ void __launch_bounds__(512, 2) k_stage(Params prm, int l) {
    extern __shared__ __attribute__((aligned(16))) unsigned char lds[];
    Ctx c; ctx_init(c, &prm, blockIdx.x, gridDim.x);
    run_stage<S>(c, l, lds);
}
constexpr int LDS_BYTES = 65536;
template <int S> static void launch_stage(const Params& p, int l, hipStream_t stream) {
    static int inited = 0;
    if (!inited) { (void)hipFuncSetAttribute((const void*)k_stage<S>, hipFuncAttributeMaxDynamicSharedMemorySize, LDS_BYTES); inited = 1; }
    hipLaunchKernelGGL(k_stage<S>, dim3(1024), dim3(512), LDS_BYTES, stream, p, l);
}

extern "C" void kernel_launch(void* const* d_in, const int* in_sizes, int n_in, void* d_out, int out_size, void* d_ws, size_t ws_size, hipStream_t stream) {
    if (n_in != 29 || out_size != NLAT * D || ws_size < WS_END) { fprintf(stderr, "kernel_launch: unexpected shapes (n_in %d out %d ws %zu need %zu)\n", n_in, out_size, ws_size, (size_t)WS_END); return; }
    Params p{};
    for (int i = 0; i < 29; ++i) p.in[i] = (const float*)d_in[i];
    p.out = (float*)d_out; p.ws = (unsigned char*)d_ws;
    for (int f = 0; f < 16; ++f) p.invf_hd[f] = (float)pow(10000.0, -(double)f / 16.0);
    for (int f = 0; f < 8; ++f) p.invf_c[f] = (float)pow(10000.0, -(double)f / 8.0);
    (void)hipMemsetAsync((char*)d_ws + WS_CTL, 0, 1u << 20, stream);
    launch_stage<-1>(p, 0, stream);
    for (int l = 0; l < DEPTH; ++l) {
        launch_stage<0>(p, l, stream); launch_stage<1>(p, l, stream); launch_stage<2>(p, l, stream); launch_stage<3>(p, l, stream);
        launch_stage<4>(p, l, stream); launch_stage<5>(p, l, stream); launch_stage<6>(p, l, stream); launch_stage<7>(p, l, stream);
        launch_stage<8>(p, l, stream); launch_stage<9>(p, l, stream); launch_stage<10>(p, l, stream); launch_stage<11>(p, l, stream);
        launch_stage<12>(p, l, stream); launch_stage<13>(p, l, stream);
    }
}
```

```cpp
#include <hip/hip_runtime.h>
#include <cstdio>
#include <cstdint>
#include <cmath>

constexpr int D = 1024, NB_ = 8, SEQ = 2048, CTXL = 256, DFF = 2816, DEPTH = 2;
constexpr int NLAT = NB_ * SEQ;
constexpr int NCTX = NB_ * CTXL;
constexpr int MT = NLAT + NCTX;
constexpr int NMOD = 9, MODW = NMOD * D;
constexpr int INC = 5280;
constexpr int O_AK = 0, O_AV = 128, O_BK = 256, O_BV = 384, O_CKV = 512, O_CKR = 768, O_AQ = 800, O_BQ = 1312, O_CQ = 1824, O_G = 2208;
constexpr int P1W = 2304;
constexpr int P_KA = 0, P_VA = 128, P_KB = 256, P_VB = 384, P_CKV = 512, P_CQ = 768, P_CKR = 1152, P_QA = 1280, P_QB = 1792;
constexpr float EPS = 1e-6f;
constexpr float LOG2E = 1.4426950408889634f;
constexpr float QSC64 = 0.125f * LOG2E;
constexpr float QSC96 = 0.10206207261596575f * LOG2E;

typedef unsigned short bf16_t;
typedef short bf16x8 __attribute__((ext_vector_type(8)));
typedef float f32x4 __attribute__((ext_vector_type(4)));
typedef unsigned u32x4 __attribute__((ext_vector_type(4)));
typedef unsigned u32x2 __attribute__((ext_vector_type(2)));

constexpr size_t WS_CTL = 0;
constexpr size_t WS_MOD = 1u << 20;
constexpr size_t WS_ROPE_HD = WS_MOD + (size_t)DEPTH * 9 * MODW * 4;
constexpr size_t WS_ROPE_C = WS_ROPE_HD + (size_t)SEQ * 32 * 2 * 4;
constexpr size_t WS_ROWSS = WS_ROPE_C + (size_t)SEQ * 16 * 2 * 4;
constexpr size_t WS_Z = WS_ROWSS + (size_t)MT * 12 * 4;
constexpr size_t WS_H = WS_Z + (size_t)NCTX * D * 4;
constexpr size_t WS_RA = WS_H + (size_t)MT * D * 2;
constexpr size_t RA_BYTES = (size_t)MT * 3072 * 2;
constexpr size_t WS_P1 = WS_RA + RA_BYTES;
constexpr size_t WS_YC = WS_P1 + (size_t)MT * P1W * 2;
constexpr size_t WS_W = WS_YC + (size_t)MT * 512 * 2;
constexpr size_t WS_END = WS_W + 52u * 1024 * 1024;
constexpr size_t RA_QC = 0, RA_KC = (size_t)MT * 768 * 2, RA_KVR = 2 * (size_t)MT * 768 * 2;

struct Params {
    const float* in[29];
    float* out;
    unsigned char* ws;
    float invf_hd[16];
    float invf_c[8];
    int ph_lo, ph_hi;
};

__device__ __forceinline__ float bf2f(bf16_t v) { return __uint_as_float((unsigned)v << 16); }
__device__ __forceinline__ bf16_t f2bf(float f) { unsigned u = __float_as_uint(f); return (bf16_t)((u + 0x7fffu + ((u >> 16) & 1u)) >> 16); }
__device__ __forceinline__ unsigned pk2(float lo, float hi) { return (unsigned)f2bf(lo) | ((unsigned)f2bf(hi) << 16); }
__device__ __forceinline__ float sigmoidf_(float v) { return 1.0f / (1.0f + __expf(-v)); }
__device__ __forceinline__ int row_mb(int r) { return r < NLAT ? (r >> 11) : 8; }

__device__ __forceinline__ int lane_id() { int l; asm volatile("v_mbcnt_lo_u32_b32 %0, -1, 0\n\tv_mbcnt_hi_u32_b32 %0, -1, %0" : "=v"(l)); return l; }
#define PH_IDS(c) const int lane_ = lane_id(); const int tid_ = (c).wave * 64 + lane_; (void)tid_
struct Ctx {
    const Params* p;
    int wave, wg, nwg;
    unsigned char* ws;
    float* mod; float* rope_hd; float* rope_c; float* rowss; float* Z; bf16_t* H; bf16_t* ACT; bf16_t* QC; bf16_t* KC; bf16_t* KVR; bf16_t* G; bf16_t* P1; bf16_t* YC;
};
__device__ __forceinline__ void ctx_init(Ctx& c, const Params* p, int wg, int nwg) {
    c.p = p; c.wave = __builtin_amdgcn_readfirstlane((int)threadIdx.x >> 6); c.wg = wg; c.nwg = nwg;
    unsigned char* ws = p->ws; c.ws = ws;
    c.mod = (float*)(ws + WS_MOD); c.rope_hd = (float*)(ws + WS_ROPE_HD); c.rope_c = (float*)(ws + WS_ROPE_C); c.rowss = (float*)(ws + WS_ROWSS);
    c.Z = (float*)(ws + WS_Z); c.H = (bf16_t*)(ws + WS_H); c.ACT = (bf16_t*)(ws + WS_RA);
    c.QC = (bf16_t*)(ws + WS_RA + RA_QC); c.KC = (bf16_t*)(ws + WS_RA + RA_KC); c.KVR = (bf16_t*)(ws + WS_RA + RA_KVR); c.G = (bf16_t*)(ws + WS_RA);
    c.P1 = (bf16_t*)(ws + WS_P1); c.YC = (bf16_t*)(ws + WS_YC);
}
__device__ __forceinline__ const float* xin_row(const Ctx& c, int r, bool from_input) {
    if (from_input) return r < NLAT ? c.p->in[0] + (size_t)r * D : c.p->in[2] + (size_t)(r - NLAT) * D;
    return r < NLAT ? c.p->out + (size_t)r * D : c.Z + (size_t)(r - NLAT) * D;
}
__device__ __forceinline__ float* xout_row(const Ctx& c, int r) { return r < NLAT ? c.p->out + (size_t)r * D : c.Z + (size_t)(r - NLAT) * D; }

__device__ __forceinline__ void sincos_d(double x, float& s, float& c) {
    const double TWO_PI = 6.283185307179586476925286766559;
    const double k = rint(x * (1.0 / TWO_PI)); const double r = x - k * TWO_PI; const double r2 = r * r;
    double ts = r, ss = r, tc = 1.0, sc = 1.0;
    for (int n = 1; n <= 15; ++n) { ts *= -r2 / (double)((2 * n) * (2 * n + 1)); ss += ts; tc *= -r2 / (double)((2 * n - 1) * (2 * n)); sc += tc; }
    s = (float)ss; c = (float)sc;
}
__device__ __forceinline__ void phase_mod(Ctx& c, float* lds) {
    PH_IDS(c);
    const Params* p = c.p;
    float* cond = lds;
    float* red = lds + 9 * 1024;
    for (int i = tid_; i < 9 * 1024; i += 512) { const int mb = i >> 10, k = i & 1023; const float v = mb < 8 ? p->in[1][mb * 1024 + k] : p->in[3][k]; cond[i] = v * sigmoidf_(v); }
    __syncthreads();
    const int ks = tid_ >> 6, cc = tid_ & 63;
    for (int u = c.wg; u < DEPTH * MODW / 64; u += c.nwg) {
        const int n0 = u * 64, l = n0 / MODW, nn = n0 % MODW;
        float acc[9];
#pragma unroll
        for (int m = 0; m < 9; ++m) acc[m] = 0.f;
        const float* w = p->in[4] + ((size_t)l * D + ks * 128) * MODW + nn + cc;
#pragma unroll 8
        for (int k = 0; k < 128; ++k) { const float wv = w[(size_t)k * MODW];
#pragma unroll
            for (int m = 0; m < 9; ++m) acc[m] += cond[m * 1024 + ks * 128 + k] * wv; }
#pragma unroll
        for (int m = 0; m < 9; ++m) red[(ks * 9 + m) * 64 + cc] = acc[m];
        __syncthreads();
        for (int o = tid_; o < 9 * 64; o += 512) { const int m = o >> 6, c2 = o & 63; float s = 0.f;
#pragma unroll
            for (int k2 = 0; k2 < 8; ++k2) s += red[(k2 * 9 + m) * 64 + c2];
            c.mod[((size_t)l * 9 + m) * MODW + nn + c2] = s + p->in[5][(size_t)l * MODW + nn + c2]; }
        __syncthreads();
    }
    const int gt = c.wg * 512 + tid_, ngt = c.nwg * 512;
    for (int i = gt; i < SEQ * 48; i += ngt) {
        const int s = i / 48, j = i % 48; const int row = s >> 6, col = s & 63; float sn, cs;
        if (j < 32) { const double ang = (double)(j < 16 ? row : col) * (double)p->invf_hd[j & 15]; sincos_d(ang, sn, cs); c.rope_hd[(s * 32 + j) * 2] = cs; c.rope_hd[(s * 32 + j) * 2 + 1] = sn; }
        else { const int jj = j - 32; const double ang = (double)(jj < 8 ? row : col) * (double)p->invf_c[jj & 7]; sincos_d(ang, sn, cs); c.rope_c[(s * 16 + jj) * 2] = cs; c.rope_c[(s * 16 + jj) * 2 + 1] = sn; }
    }
}

__device__ __forceinline__ float wave_sum(float v) {
#pragma unroll
    for (int o = 1; o < 64; o <<= 1) v += __shfl_xor(v, o);
    return v;
}
__device__ __forceinline__ void phase_norm(Ctx& c, int l, const float* gain, int shift_idx, int rows, bool from_input) {
    PH_IDS(c);
    const int gw = c.wg * 8 + c.wave, ngw = c.nwg * 8;
    for (int r = gw; r < rows; r += ngw) {
        const f32x4* xr = (const f32x4*)xin_row(c, r, from_input) + lane_;
        f32x4 v[4]; float s = 0.f;
#pragma unroll
        for (int j = 0; j < 4; ++j) { v[j] = xr[64 * j]; s += (v[j].x * v[j].x + v[j].y * v[j].y) + (v[j].z * v[j].z + v[j].w * v[j].w); }
        const float rstd = 1.0f / sqrtf(wave_sum(s) * (1.0f / D) + EPS);
        const float* md = c.mod + ((size_t)l * 9 + row_mb(r)) * MODW;
        unsigned long long* o8 = (unsigned long long*)(c.H + (size_t)r * D) + lane_;
#pragma unroll
        for (int j = 0; j < 4; ++j) { const int k = 4 * lane_ + 256 * j;
            const f32x4 g = *(const f32x4*)(gain + k), sh = *(const f32x4*)(md + shift_idx * D + k), sc = *(const f32x4*)(md + (shift_idx + 1) * D + k);
            const f32x4 y = v[j] * rstd * g * (sc + 1.0f) + sh;
            o8[64 * j] = (unsigned long long)pk2(y.x, y.y) | ((unsigned long long)pk2(y.z, y.w) << 32); }
    }
}

template <int NB>
__device__ __forceinline__ void naive_tile(const bf16_t* A, int lda, int K, int row0, const float* const (&wp)[NB], int ldw, const float* kscale, f32x4 (&acc)[NB], int lane) {
    const int r = lane & 15, q = lane >> 4;
    const bf16_t* ap = A + (size_t)(row0 + r) * lda + q * 8;
    for (int k0 = 0; k0 < K; k0 += 32) {
        const bf16x8 a = *(const bf16x8*)(ap + k0);
        float ks[8];
#pragma unroll
        for (int j = 0; j < 8; ++j) ks[j] = kscale ? kscale[k0 + q * 8 + j] : 1.0f;
#pragma unroll
        for (int nb = 0; nb < NB; ++nb) { bf16x8 b;
#pragma unroll
            for (int j = 0; j < 8; ++j) b[j] = (short)f2bf(wp[nb][(size_t)(k0 + q * 8 + j) * ldw + r] * ks[j]);
            acc[nb] = __builtin_amdgcn_mfma_f32_16x16x32_bf16(a, b, acc[nb], 0, 0, 0); }
    }
}
__device__ __forceinline__ float quad16_sum(float v) { v += __shfl_xor(v, 1); v += __shfl_xor(v, 2); v += __shfl_xor(v, 4); v += __shfl_xor(v, 8); return v; }

__device__ __forceinline__ void naive_ffn_up(Ctx& c, const float* w_in, int rows) {
    PH_IDS(c);
    const int gw = c.wg * 8 + c.wave, ngw = c.nwg * 8, r = lane_ & 15, q = lane_ >> 4;
    const int nu = (rows / 16) * 176;
    for (int u = gw; u < nu; u += ngw) {
        const int rt = u / 176, cg = u % 176, row0 = rt * 16, c0 = cg * 16;
        const float* wp[2] = {w_in + c0, w_in + DFF + c0};
        f32x4 acc[2] = {{0.f, 0.f, 0.f, 0.f}, {0.f, 0.f, 0.f, 0.f}};
        naive_tile<2>(c.H, D, D, row0, wp, 2 * DFF, nullptr, acc, lane_);
#pragma unroll
        for (int i = 0; i < 4; ++i) { const float g = acc[0][i], up = acc[1][i]; c.ACT[(size_t)(row0 + q * 4 + i) * DFF + c0 + r] = f2bf(g * sigmoidf_(g) * up); }
    }
}
__device__ __forceinline__ void naive_res(Ctx& c, int l, const bf16_t* A, int lda, int K, const float* W, float coef, int gi, int rows, bool from_input) {
    PH_IDS(c);
    const int gw = c.wg * 8 + c.wave, ngw = c.nwg * 8, r = lane_ & 15, q = lane_ >> 4;
    const int nu = (rows / 16) * 16;
    for (int u = gw; u < nu; u += ngw) {
        const int rt = u / 16, cg = u % 16, row0 = rt * 16, c0 = cg * 64;
        const float* wp[4] = {W + c0, W + c0 + 16, W + c0 + 32, W + c0 + 48};
        f32x4 acc[4];
#pragma unroll
        for (int nb = 0; nb < 4; ++nb) acc[nb] = (f32x4){0.f, 0.f, 0.f, 0.f};
        naive_tile<4>(A, lda, K, row0, wp, D, nullptr, acc, lane_);
#pragma unroll
        for (int i = 0; i < 4; ++i) { const int row = row0 + q * 4 + i; const float* md = c.mod + ((size_t)l * 9 + row_mb(row)) * MODW + gi * D;
            const float* bi = xin_row(c, row, from_input); float* bo = xout_row(c, row);
#pragma unroll
            for (int nb = 0; nb < 4; ++nb) { const int cc = c0 + nb * 16 + r; bo[cc] = bi[cc] + coef * md[cc] * acc[nb][i]; } }
    }
}
__device__ __forceinline__ void naive_inproj(Ctx& c, int l, int rows) {
    PH_IDS(c);
    const Params* p = c.p;
    const int gw = c.wg * 8 + c.wave, ngw = c.nwg * 8, r = lane_ & 15, q = lane_ >> 4;
    const float* W = p->in[10] + (size_t)l * D * INC;
    const int nu = (rows / 16) * 36;
    for (int u = gw; u < nu; u += ngw) {
        const int rt = u / 36, g = u % 36, row0 = rt * 16;
        if (g == 19) continue;
        int src, dst, kind;
        if (g < 2) { src = O_AK + 64 * g; dst = P_KA + 64 * g; kind = 1; }
        else if (g < 4) { src = O_AV + 64 * (g - 2); dst = P_VA + 64 * (g - 2); kind = 0; }
        else if (g < 6) { src = O_BK + 64 * (g - 4); dst = P_KB + 64 * (g - 4); kind = 2; }
        else if (g < 8) { src = O_BV + 64 * (g - 6); dst = P_VB + 64 * (g - 6); kind = 0; }
        else if (g < 12) { src = O_CKV + 64 * (g - 8); dst = P_CKV + 64 * (g - 8); kind = 0; }
        else if (g < 18) { src = O_CQ + 64 * (g - 12); dst = P_CQ + 64 * (g - 12); kind = 0; }
        else if (g == 18) { src = O_CKR; dst = P_CKR; kind = 0; }
        else if (g < 28) { src = O_AQ + 64 * (g - 20); dst = P_QA + 64 * (g - 20); kind = 3; }
        else { src = O_BQ + 64 * (g - 28); dst = P_QB + 64 * (g - 28); kind = 4; }
        const float* wp[4] = {W + src, W + src + 16, W + src + (g == 18 ? 0 : 32), W + src + (g == 18 ? 0 : 48)};
        f32x4 acc[4];
#pragma unroll
        for (int nb = 0; nb < 4; ++nb) acc[nb] = (f32x4){0.f, 0.f, 0.f, 0.f};
        naive_tile<4>(c.H, D, D, row0, wp, INC, nullptr, acc, lane_);
        const float* gn = kind == 1 ? p->in[12] + l * 64 : kind == 2 ? p->in[15] + l * 64 : kind == 3 ? p->in[11] + l * 64 : p->in[14] + l * 64;
#pragma unroll
        for (int i = 0; i < 4; ++i) {
            const int row = row0 + q * 4 + i;
            bf16_t* o = c.P1 + (size_t)row * P1W + dst;
            if (kind == 0) {
#pragma unroll
                for (int nb = 0; nb < 4; ++nb) { if (g == 18 && nb >= 2) o[nb * 16 + r] = 0; else o[nb * 16 + r] = f2bf(acc[nb][i]); }
            } else {
                float ss = 0.f;
#pragma unroll
                for (int nb = 0; nb < 4; ++nb) ss += acc[nb][i] * acc[nb][i];
                ss = quad16_sum(ss);
                const float rstd = 1.0f / sqrtf(ss * (1.0f / 64.0f) + EPS);
                const float qs = kind >= 3 ? QSC64 : 1.0f;
#pragma unroll
                for (int nb = 0; nb < 4; ++nb) { const int d = nb * 16 + r; float v = acc[nb][i] * rstd * gn[d];
                    const float pr = __shfl_xor(v, 1);
                    if (row < NLAT) { const int s = row & 2047; const float cs = c.rope_hd[(s * 32 + (d >> 1)) * 2], sn = c.rope_hd[(s * 32 + (d >> 1)) * 2 + 1];
                        v = (d & 1) ? (pr * sn + v * cs) : (v * cs - pr * sn); }
                    o[d] = f2bf(v * qs); }
            }
        }
    }
}
__device__ __forceinline__ void naive_rowss(Ctx& c, int rows) {
    PH_IDS(c);
    const int gw = c.wg * 8 + c.wave, ngw = c.nwg * 8;
    for (int r = gw; r < rows; r += ngw) {
        const bf16_t* pr = c.P1 + (size_t)r * P1W;
        float s1 = 0.f, s2 = 0.f;
        for (int k = lane_; k < 256; k += 64) { const float v = bf2f(pr[P_CKV + k]); s1 += v * v; }
        for (int k = lane_; k < 384; k += 64) { const float v = bf2f(pr[P_CQ + k]); s2 += v * v; }
        s1 = wave_sum(s1); s2 = wave_sum(s2);
        if (lane_ < 12) c.rowss[(size_t)r * 12 + lane_] = lane_ == 0 ? s1 : (lane_ == 4 ? s2 : 0.f);
    }
}
__device__ __forceinline__ float rowss_kv(const Ctx& c, int row) { const f32x4 a = *(const f32x4*)(c.rowss + (size_t)row * 12); return 1.0f / sqrtf(((a.x + a.y) + (a.z + a.w)) * (1.0f / 256.0f) + EPS); }
__device__ __forceinline__ float rowss_q(const Ctx& c, int row) { const f32x4 a = *(const f32x4*)(c.rowss + (size_t)row * 12 + 4), b = *(const f32x4*)(c.rowss + (size_t)row * 12 + 8);
    return 1.0f / sqrtf((((a.x + a.y) + (a.z + a.w)) + ((b.x + b.y) + (b.z + b.w))) * (1.0f / 384.0f) + EPS); }
__device__ __forceinline__ void naive_mla_q(Ctx& c, int l, int rows) {
    PH_IDS(c);
    const Params* p = c.p;
    const int gw = c.wg * 8 + c.wave, ngw = c.nwg * 8, r = lane_ & 15, q = lane_ >> 4;
    const float* W = p->in[17] + (size_t)l * 384 * 768; const float* gl = p->in[16] + l * 384; const float* gn = p->in[20] + l * 96;
    const int nu = (rows / 16) * 8;
    for (int u = gw; u < nu; u += ngw) {
        const int rt = u / 8, h = u % 8, row0 = rt * 16;
        const float* wp[6];
#pragma unroll
        for (int nb = 0; nb < 6; ++nb) wp[nb] = W + 96 * h + 16 * nb;
        f32x4 acc[6];
#pragma unroll
        for (int nb = 0; nb < 6; ++nb) acc[nb] = (f32x4){0.f, 0.f, 0.f, 0.f};
        naive_tile<6>(c.P1 + P_CQ, P1W, 384, row0, wp, 768, gl, acc, lane_);
#pragma unroll
        for (int i = 0; i < 4; ++i) {
            const int row = row0 + q * 4 + i; const float rq = rowss_q(c, row);
            float ss = 0.f;
#pragma unroll
            for (int nb = 0; nb < 6; ++nb) { acc[nb][i] *= rq; ss += acc[nb][i] * acc[nb][i]; }
            ss = quad16_sum(ss);
            const float rstd = 1.0f / sqrtf(ss * (1.0f / 96.0f) + EPS);
            bf16_t* o = c.QC + (size_t)row * 768 + 96 * h;
#pragma unroll
            for (int nb = 0; nb < 6; ++nb) { const int d = nb * 16 + r; float v = acc[nb][i] * rstd * gn[d];
                const float pr = __shfl_xor(v, 1);
                if (nb >= 4 && row < NLAT) { const int s = row & 2047, pi = (d - 64) >> 1; const float cs = c.rope_c[(s * 16 + pi) * 2], sn = c.rope_c[(s * 16 + pi) * 2 + 1];
                    v = (d & 1) ? (pr * sn + v * cs) : (v * cs - pr * sn); }
                o[d] = f2bf(v * QSC96); }
        }
    }
}
__device__ __forceinline__ void naive_mla_kv(Ctx& c, int l, int rows) {
    PH_IDS(c);
    const Params* p = c.p;
    const int gw = c.wg * 8 + c.wave, ngw = c.nwg * 8, r = lane_ & 15, q = lane_ >> 4;
    const float* W = p->in[19] + (size_t)l * 256 * 1024; const float* gl = p->in[18] + l * 256; const float* gn = p->in[21] + l * 96;
    const int nu = (rows / 16) * 8;
    for (int u = gw; u < nu; u += ngw) {
        const int rt = u / 8, h = u % 8, row0 = rt * 16;
        const float* wp[8];
#pragma unroll
        for (int nb = 0; nb < 8; ++nb) wp[nb] = W + 128 * h + 16 * nb;
        f32x4 acc[8];
#pragma unroll
        for (int nb = 0; nb < 8; ++nb) acc[nb] = (f32x4){0.f, 0.f, 0.f, 0.f};
        naive_tile<8>(c.P1 + P_CKV, P1W, 256, row0, wp, 1024, gl, acc, lane_);
#pragma unroll
        for (int i = 0; i < 4; ++i) {
            const int row = row0 + q * 4 + i; const float rk = rowss_kv(c, row);
            const float kr0 = bf2f(c.P1[(size_t)row * P1W + P_CKR + r]), kr1 = bf2f(c.P1[(size_t)row * P1W + P_CKR + 16 + r]);
            float ss = kr0 * kr0 + kr1 * kr1;
#pragma unroll
            for (int nb = 0; nb < 4; ++nb) { acc[nb][i] *= rk; ss += acc[nb][i] * acc[nb][i]; }
            ss = quad16_sum(ss);
            const float rstd = 1.0f / sqrtf(ss * (1.0f / 96.0f) + EPS);
            bf16_t* o = c.KC + (size_t)row * 768 + 96 * h;
#pragma unroll
            for (int nb = 0; nb < 4; ++nb) { const int d = nb * 16 + r; o[d] = f2bf(acc[nb][i] * rstd * gn[d]); }
#pragma unroll
            for (int nb = 0; nb < 2; ++nb) { const int d = 64 + nb * 16 + r; float v = (nb == 0 ? kr0 : kr1) * rstd * gn[d];
                const float pr = __shfl_xor(v, 1);
                if (row < NLAT) { const int s = row & 2047, pi = (d - 64) >> 1; const float cs = c.rope_c[(s * 16 + pi) * 2], sn = c.rope_c[(s * 16 + pi) * 2 + 1];
                    v = (d & 1) ? (pr * sn + v * cs) : (v * cs - pr * sn); }
                o[d] = f2bf(v); }
            bf16_t* ov = c.KVR + (size_t)row * 1024 + 128 * h + 64;
#pragma unroll
            for (int nb = 0; nb < 4; ++nb) ov[nb * 16 + r] = f2bf(acc[4 + nb][i] * rk);
        }
    }
}
__device__ __forceinline__ void naive_gates(Ctx& c, int l, int rows) {
    PH_IDS(c);
    const int gw = c.wg * 8 + c.wave, ngw = c.nwg * 8, r = lane_ & 15, q = lane_ >> 4;
    const float* W = c.p->in[10] + (size_t)l * D * INC + O_G;
    const int nu = (rows / 16) * 48;
    for (int u = gw; u < nu; u += ngw) {
        const int rt = u / 48, cg = u % 48, row0 = rt * 16, c0 = cg * 64;
        const float* wp[4] = {W + c0, W + c0 + 16, W + c0 + 32, W + c0 + 48};
        f32x4 acc[4];
#pragma unroll
        for (int nb = 0; nb < 4; ++nb) acc[nb] = (f32x4){0.f, 0.f, 0.f, 0.f};
        naive_tile<4>(c.H, D, D, row0, wp, INC, nullptr, acc, lane_);
#pragma unroll
        for (int i = 0; i < 4; ++i)
#pragma unroll
            for (int nb = 0; nb < 4; ++nb) c.G[(size_t)(row0 + q * 4 + i) * 3072 + c0 + nb * 16 + r] = f2bf(sigmoidf_(acc[nb][i]));
    }
}
__device__ __forceinline__ void naive_merge(Ctx& c, int l, int rows) {
    PH_IDS(c);
    const Params* p = c.p;
    const int gw = c.wg * 8 + c.wave, ngw = c.nwg * 8, r = lane_ & 15, q = lane_ >> 4;
    const int nu = (rows / 16) * 16;
    for (int u = gw; u < nu; u += ngw) {
        const int rt = u / 16, cg = u % 16, row0 = rt * 16, c0 = cg * 64;
        float tot[4][4];
#pragma unroll
        for (int nb = 0; nb < 4; ++nb)
#pragma unroll
            for (int i = 0; i < 4; ++i) tot[nb][i] = 0.f;
#pragma unroll
        for (int br = 0; br < 3; ++br) {
            const float* W = p->in[22 + br] + (size_t)l * 512 * D;
            const float* wp[4] = {W + c0, W + c0 + 16, W + c0 + 32, W + c0 + 48};
            f32x4 acc[4];
#pragma unroll
            for (int nb = 0; nb < 4; ++nb) acc[nb] = (f32x4){0.f, 0.f, 0.f, 0.f};
            const bf16_t* A = br == 0 ? c.P1 + P_QA : (br == 1 ? c.P1 + P_QB : c.YC);
            naive_tile<4>(A, br == 2 ? 512 : P1W, 512, row0, wp, D, nullptr, acc, lane_);
#pragma unroll
            for (int i = 0; i < 4; ++i)
#pragma unroll
                for (int nb = 0; nb < 4; ++nb) tot[nb][i] += bf2f(c.G[(size_t)(row0 + q * 4 + i) * 3072 + br * 1024 + c0 + nb * 16 + r]) * acc[nb][i];
        }
#pragma unroll
        for (int i = 0; i < 4; ++i)
#pragma unroll
            for (int nb = 0; nb < 4; ++nb) c.H[(size_t)(row0 + q * 4 + i) * D + c0 + nb * 16 + r] = f2bf(tot[nb][i]);
    }
}

template <int DQK>
__device__ __forceinline__ void naive_attn_keys(const bf16_t* Kb, int kpitch, const bf16_t* Vb, int vpitch, int k_lo, int k_hi, int srow, int window, const float (&qv)[DQK], float& m, float& l, float (&o)[64]) {
    for (int j = k_lo; j < k_hi; ++j) {
        const bf16_t* kr = Kb + (size_t)j * kpitch;
        float s = 0.f;
#pragma unroll
        for (int d8 = 0; d8 < DQK / 8; ++d8) { const bf16x8 kk = *(const bf16x8*)(kr + d8 * 8);
#pragma unroll
            for (int e = 0; e < 8; ++e) s += qv[d8 * 8 + e] * bf2f((bf16_t)kk[e]); }
        const bool ok = window < 0 || (j - srow <= window && srow - j <= window);
        if (ok) {
            const float mn = fmaxf(m, s); const float f = exp2f(m - mn), pp = exp2f(s - mn);
            l = l * f + pp; m = mn;
            const bf16_t* vr = Vb + (size_t)j * vpitch;
#pragma unroll
            for (int d8 = 0; d8 < 8; ++d8) { const bf16x8 vv = *(const bf16x8*)(vr + d8 * 8);
#pragma unroll
                for (int e = 0; e < 8; ++e) o[d8 * 8 + e] = o[d8 * 8 + e] * f + pp * bf2f((bf16_t)vv[e]); }
        }
    }
}
__device__ __forceinline__ void naive_attn(Ctx& c, int l, int row_lo, int row_hi) {
    PH_IDS(c);
    const Params* p = c.p;
    const int gw = c.wg * 8 + c.wave, ngw = c.nwg * 8;
    const int nrw = (row_hi - row_lo) / 64;
    for (int u = gw; u < nrw * 24; u += ngw) {
        const int br = u / (nrw * 8), rem = u % (nrw * 8), h = rem / nrw, rw = rem % nrw;
        const int row = row_lo + rw * 64 + lane_;
        const bool lat = row < NLAT; const int b = lat ? (row >> 11) : ((row - NLAT) >> 8); const int s = row & 2047;
        const int crow0 = NLAT + b * CTXL, lrow0 = b * SEQ;
        float o[64];
#pragma unroll
        for (int d = 0; d < 64; ++d) o[d] = 0.f;
        float m = -1e30f, lsum = 0.f;
        if (br == 2) {
            float qv[96];
            const bf16_t* qp = c.QC + (size_t)row * 768 + 96 * h;
#pragma unroll
            for (int d8 = 0; d8 < 12; ++d8) { const bf16x8 t = *(const bf16x8*)(qp + d8 * 8);
#pragma unroll
                for (int e = 0; e < 8; ++e) qv[d8 * 8 + e] = bf2f((bf16_t)t[e]); }
            naive_attn_keys<96>(c.KC + (size_t)crow0 * 768 + 96 * h, 768, c.KVR + (size_t)crow0 * 1024 + 128 * h + 64, 1024, 0, CTXL, 0, -1, qv, m, lsum, o);
            if (lat) naive_attn_keys<96>(c.KC + (size_t)lrow0 * 768 + 96 * h, 768, c.KVR + (size_t)lrow0 * 1024 + 128 * h + 64, 1024, 0, SEQ, 0, -1, qv, m, lsum, o);
            const float inv = 1.0f / lsum; bf16_t* op = c.YC + (size_t)row * 512 + 64 * h;
#pragma unroll
            for (int d8 = 0; d8 < 8; ++d8) { u32x4 w; w.x = pk2(o[d8 * 8] * inv, o[d8 * 8 + 1] * inv); w.y = pk2(o[d8 * 8 + 2] * inv, o[d8 * 8 + 3] * inv); w.z = pk2(o[d8 * 8 + 4] * inv, o[d8 * 8 + 5] * inv); w.w = pk2(o[d8 * 8 + 6] * inv, o[d8 * 8 + 7] * inv); *(u32x4*)(op + d8 * 8) = w; }
        } else {
            float qv[64];
            const int qoff = br == 0 ? P_QA : P_QB, koff = (br == 0 ? P_KA : P_KB) + 64 * (h >> 2), voff = (br == 0 ? P_VA : P_VB) + 64 * (h >> 2);
            bf16_t* qp = c.P1 + (size_t)row * P1W + qoff + 64 * h;
#pragma unroll
            for (int d8 = 0; d8 < 8; ++d8) { const bf16x8 t = *(const bf16x8*)(qp + d8 * 8);
#pragma unroll
                for (int e = 0; e < 8; ++e) qv[d8 * 8 + e] = bf2f((bf16_t)t[e]); }
            if (br == 0) { m = p->in[13][l * 8 + h] * LOG2E; lsum = 1.0f; }
            naive_attn_keys<64>(c.P1 + (size_t)crow0 * P1W + koff, P1W, c.P1 + (size_t)crow0 * P1W + voff, P1W, 0, CTXL, 0, -1, qv, m, lsum, o);
            if (lat) {
                if (br == 0) { const int s0 = __builtin_amdgcn_readfirstlane(s) & ~63; const int klo = s0 - 128 < 0 ? 0 : s0 - 128, khi = s0 + 63 + 128 + 1 > SEQ ? SEQ : s0 + 63 + 128 + 1;
                    naive_attn_keys<64>(c.P1 + (size_t)lrow0 * P1W + koff, P1W, c.P1 + (size_t)lrow0 * P1W + voff, P1W, klo, khi, s, 128, qv, m, lsum, o); }
                else naive_attn_keys<64>(c.P1 + (size_t)lrow0 * P1W + koff, P1W, c.P1 + (size_t)lrow0 * P1W + voff, P1W, 0, SEQ, 0, -1, qv, m, lsum, o);
            }
            const float inv = 1.0f / lsum;
#pragma unroll
            for (int d8 = 0; d8 < 8; ++d8) { u32x4 w; w.x = pk2(o[d8 * 8] * inv, o[d8 * 8 + 1] * inv); w.y = pk2(o[d8 * 8 + 2] * inv, o[d8 * 8 + 3] * inv); w.z = pk2(o[d8 * 8 + 4] * inv, o[d8 * 8 + 5] * inv); w.w = pk2(o[d8 * 8 + 6] * inv, o[d8 * 8 + 7] * inv); *(u32x4*)(qp + d8 * 8) = w; }
        }
    }
}

constexpr size_t WO_F1IN = 0;
constexpr size_t WO_F1OUT = WO_F1IN + (size_t)5632 * 1024 * 2;
constexpr size_t WO_F2IN = WO_F1OUT + (size_t)1024 * 2816 * 2;
constexpr size_t WO_F2OUT = WO_F2IN + (size_t)5632 * 1024 * 2;
constexpr size_t WO_P1 = WO_F2OUT + (size_t)1024 * 2816 * 2;
constexpr size_t WO_G = WO_P1 + (size_t)2304 * 1024 * 2;
constexpr size_t WO_UQ = WO_G + (size_t)3072 * 1024 * 2;
constexpr size_t WO_UKV = WO_UQ + (size_t)768 * 384 * 2;
constexpr size_t WO_BR = WO_UKV + (size_t)1024 * 256 * 2;
constexpr size_t WO_OUT = WO_BR + (size_t)3 * 1024 * 512 * 2;
constexpr size_t WO_END = WO_OUT + (size_t)1024 * 1024 * 2;
static_assert(WO_END <= 52u * 1024 * 1024, "weight region");
#define LAS __attribute__((address_space(3)))
#define GAS __attribute__((address_space(1)))

__device__ __forceinline__ void conv_item(const float* W, int ldw, int K, int srccol, const float* kgain, bf16_t* WT, int dstrow0, int k0, LAS float* scr, int lane) {
    if (srccol >= 0) {
#pragma unroll 8
        for (int i = 0; i < 32; ++i) { const int kk = 2 * i + (lane >> 5); float v = W[(size_t)(k0 + kk) * ldw + srccol + (lane & 31)]; if (kgain) v *= kgain[k0 + kk]; scr[kk * 33 + (lane & 31)] = v; }
    } else {
#pragma unroll 8
        for (int i = 0; i < 32; ++i) { const int kk = 2 * i + (lane >> 5); scr[kk * 33 + (lane & 31)] = 0.f; }
    }
    asm volatile("s_waitcnt lgkmcnt(0)" ::: "memory");
    const int cidx = lane & 7;
#pragma unroll
    for (int j = 0; j < 4; ++j) { const int n = (lane >> 3) + 8 * j; const LAS float* sp = scr + (8 * cidx) * 33 + n;
        u32x4 o; o.x = pk2(sp[0 * 33], sp[1 * 33]); o.y = pk2(sp[2 * 33], sp[3 * 33]); o.z = pk2(sp[4 * 33], sp[5 * 33]); o.w = pk2(sp[6 * 33], sp[7 * 33]);
        *(u32x4*)(WT + (size_t)(dstrow0 + n) * K + k0 + 8 * cidx) = o; }
    asm volatile("s_waitcnt lgkmcnt(0)" ::: "memory");
}
__device__ __forceinline__ int p1_srccol(int nb) {
    const int t = nb >> 3, p32 = nb & 7;
    const int Lh = 64 * (p32 & 3) + 32 * (p32 >> 2), Lr = 32 * p32;
    switch (t) {
    case 0: return Lh < 128 ? O_AK + Lh : O_AV + (Lh - 128);
    case 1: return Lh < 128 ? O_BK + Lh : O_BV + (Lh - 128);
    case 2: return O_CKV + Lr;
    case 3: return O_CQ + Lr;
    case 4: return Lr < 128 ? O_CQ + 256 + Lr : (Lr == 128 ? O_CKR : -1);
    case 5: case 6: return O_AQ + 256 * (t - 5) + Lh;
    default: return O_BQ + 256 * (t - 7) + Lh;
    }
}
__device__ __forceinline__ void phase_convert(Ctx& c, int l, unsigned char* lds) {
    PH_IDS(c);
    const Params* p = c.p;
    LAS float* scr = (LAS float*)((LAS unsigned char*)lds + c.wave * 16384);
    unsigned char* wb = c.ws + WS_W;
    const int gw = c.wg * 8 + c.wave, ngw = c.nwg * 8;
    constexpr int NIT[12] = {16 * 176, 44 * 32, 16 * 176, 44 * 32, 16 * 72, 16 * 96, 6 * 24, 4 * 32, 8 * 32, 8 * 32, 8 * 32, 16 * 32};
    int total = 0;
#pragma unroll
    for (int i = 0; i < 12; ++i) total += NIT[i];
    for (int it = gw; it < total; it += ngw) {
        int r = it, mi = 0;
#pragma unroll
        for (int i = 0; i < 11; ++i) if (mi == i && r >= NIT[i]) { r -= NIT[i]; mi = i + 1; }
        const float* W; int ldw, K, nblk; bf16_t* WT; const float* kg = nullptr;
        switch (mi) {
        case 0: W = p->in[7] + (size_t)l * D * 2 * DFF; ldw = 2 * DFF; K = D; nblk = 176; WT = (bf16_t*)(wb + WO_F1IN); break;
        case 1: W = p->in[8] + (size_t)l * DFF * D; ldw = D; K = DFF; nblk = 32; WT = (bf16_t*)(wb + WO_F1OUT); break;
        case 2: W = p->in[27] + (size_t)l * D * 2 * DFF; ldw = 2 * DFF; K = D; nblk = 176; WT = (bf16_t*)(wb + WO_F2IN); break;
        case 3: W = p->in[28] + (size_t)l * DFF * D; ldw = D; K = DFF; nblk = 32; WT = (bf16_t*)(wb + WO_F2OUT); break;
        case 4: W = p->in[10] + (size_t)l * D * INC; ldw = INC; K = D; nblk = 72; WT = (bf16_t*)(wb + WO_P1); break;
        case 5: W = p->in[10] + (size_t)l * D * INC; ldw = INC; K = D; nblk = 96; WT = (bf16_t*)(wb + WO_G); break;
        case 6: W = p->in[17] + (size_t)l * 384 * 768; ldw = 768; K = 384; nblk = 24; WT = (bf16_t*)(wb + WO_UQ); kg = p->in[16] + l * 384; break;
        case 7: W = p->in[19] + (size_t)l * 256 * 1024; ldw = 1024; K = 256; nblk = 32; WT = (bf16_t*)(wb + WO_UKV); kg = p->in[18] + l * 256; break;
        case 8: case 9: case 10: W = p->in[22 + (mi - 8)] + (size_t)l * 512 * D; ldw = D; K = 512; nblk = 32; WT = (bf16_t*)(wb + WO_BR) + (size_t)(mi - 8) * 1024 * 512; break;
        default: W = p->in[25] + (size_t)l * D * D; ldw = D; K = D; nblk = 32; WT = (bf16_t*)(wb + WO_OUT); break;
        }
        const int kb = r / nblk, nb = r % nblk;
        int sc;
        if (mi == 0 || mi == 2) { const int j = nb >> 3, w = nb & 7; sc = w < 4 ? 128 * j + 32 * w : DFF + 128 * j + 32 * (w - 4); }
        else if (mi == 4) sc = p1_srccol(nb);
        else if (mi == 5) sc = O_G + 32 * nb;
        else sc = 32 * nb;
        conv_item(W, ldw, K, sc, kg, WT, 32 * nb, 64 * kb, scr, lane_);
    }
}

namespace pg8 {
constexpr int BM = 256, BK = 64, HALF = 128, HTB = HALF * BK * 2, STAGE_BYTES = 8 * HTB, NXCD = 8, WGM = 8;
__host__ __device__ __forceinline__ int lds_byte(int r, int c) { const int st = (r >> 4) * 2 + (c >> 5), rr = r & 15, cc = c & 31, ob = rr * 64 + cc * 2; return st * 1024 + (ob ^ (((ob >> 9) & 1) << 5)); }
__host__ __device__ __forceinline__ void stage_rc(int b, int& R, int& C) { const int st = b / 1024, sb = b % 1024, swz = sb ^ (((sb >> 9) & 1) << 5); R = (st >> 1) * 16 + swz / 64; C = (st & 1) * 32 + (swz % 64) / 2; }
__host__ __device__ __forceinline__ int perm32(int rho) { const int n = rho >> 4, i = rho & 15; return 8 * (i >> 2) + 4 * n + (i & 3); }
struct Unit { int pm, pn; };
struct Gemm { const bf16_t* A; const bf16_t* Bt; int M, N, K, lda; };
struct StaticOrder {
    int nM, nN, nwg, G, c;
    __device__ void init(int M, int N, int G_, int c_) { nM = M / BM; nN = N / BM; nwg = nM * nN; G = G_; c = c_; }
    __device__ bool next(int i, Unit& u) const {
        const long L = (long)i * G + c; if (L >= nwg) return false;
        int wgid = (int)L; { const int q = nwg / NXCD, r = nwg % NXCD, xcd = wgid % NXCD, off = wgid / NXCD; wgid = (xcd < r ? xcd * (q + 1) : r * (q + 1) + (xcd - r) * q) + off; }
        const int nig = WGM * nN, gid = wgid / nig, fm = gid * WGM, gsz = (nM - fm) < WGM ? (nM - fm) : WGM;
        u.pm = fm + ((wgid % nig) % gsz); u.pn = (wgid % nig) / gsz; return true;
    }
};
typedef float f32x2_t __attribute__((ext_vector_type(2))); typedef __bf16 bf16x2_t __attribute__((ext_vector_type(2)));
__device__ __forceinline__ unsigned cvt_pk_bf16(float lo, float hi) { f32x2_t v = {lo, hi}; bf16x2_t b = __builtin_convertvector(v, bf16x2_t); return __builtin_bit_cast(unsigned, b); }
__device__ __forceinline__ u32x4 pack8(const f32x4& a, const f32x4& b) { u32x4 w; w.x = cvt_pk_bf16(a[0], a[1]); w.y = cvt_pk_bf16(a[2], a[3]); w.z = cvt_pk_bf16(b[0], b[1]); w.w = cvt_pk_bf16(b[2], b[3]); return w; }
__device__ __forceinline__ float fast_sigmoid(float v) { return __builtin_amdgcn_rcpf(1.0f + __builtin_amdgcn_exp2f(-LOG2E * v)); }

typedef f32x4 Acc[2][2][4][2];

template <class Epi, class Sched, bool ALIGN_EPI>
__device__ __forceinline__ void gemm_phase(LAS unsigned char* lds, int wave, const Gemm g, const Sched& S, const Epi& E) {
    const int lane = lane_id(), wid = wave, tid = wid * 64 + lane, wr = wid >> 2, wc = wid & 3, fr = lane & 15, fq = lane >> 4;
    const int K = g.K, nt = K / BK, lda = g.lda;
    unsigned voffA[2], voffB[2];
#pragma unroll
    for (int i = 0; i < 2; ++i) { int R, C; stage_rc(tid * 16 + i * 8192, R, C); const int Rb = Epi::PERM ? ((R & ~31) + perm32(R & 31)) : R;
        voffA[i] = (unsigned)(R * lda + C) * 2u; voffB[i] = (unsigned)(Rb * K + C) * 2u; }
    const size_t kstep = (size_t)(BK * 2);
    const size_t hstepA = (size_t)HALF * lda * 2, hstepB = (size_t)HALF * K * 2;
    const size_t tstepA = 2 * hstepA, tstepB = 2 * hstepB;
    const unsigned ldsw = (unsigned)wid * 1024u;
    const int aoff = lds_byte(wr * 64 + fr, fq * 8), boff = lds_byte(wc * 32 + fr, fq * 8);
#define PG8_SA(b, h) (((b) * 2 + (h)) * HTB)
#define PG8_SB(b, h) ((4 + (b) * 2 + (h)) * HTB)
#define PG8_STAGE(bufoff, gbase, voff) do { _Pragma("unroll") for (int _i = 0; _i < 2; ++_i) \
        __builtin_amdgcn_global_load_lds((const unsigned*)((const char*)(gbase) + (voff)[_i]), (LAS unsigned*)(lds + (bufoff) + ldsw + _i * 8192), 16, 0, 0); } while (0)
#define PG8_LDA(dst, b, h) do { _Pragma("unroll") for (int m = 0; m < 4; ++m) _Pragma("unroll") for (int k = 0; k < 2; ++k) dst[m][k] = *(const LAS bf16x8*)(lds + PG8_SA(b, h) + aoff + m * 2048 + k * 1024); } while (0)
#define PG8_LDB(dst, b, h) do { _Pragma("unroll") for (int n = 0; n < 2; ++n) _Pragma("unroll") for (int k = 0; k < 2; ++k) dst[n][k] = *(const LAS bf16x8*)(lds + PG8_SB(b, h) + boff + n * 2048 + k * 1024); } while (0)
#define PG8_MMA(ai, bj, At, Bt) do { __builtin_amdgcn_s_setprio(1); _Pragma("unroll") for (int m = 0; m < 4; ++m) _Pragma("unroll") for (int n = 0; n < 2; ++n) _Pragma("unroll") for (int k = 0; k < 2; ++k) \
        acc[ai][bj][m][n] = __builtin_amdgcn_mfma_f32_16x16x32_bf16(Bt[n][k], At[m][k], acc[ai][bj][m][n], 0, 0, 0); __builtin_amdgcn_s_setprio(0); } while (0)
#define PG8_WAIT_V(n) asm volatile("s_waitcnt vmcnt(" #n ")" ::: "memory")
#define PG8_WAIT_L(n) asm volatile("s_waitcnt lgkmcnt(" #n ")" ::: "memory")
#define PG8_BAR __builtin_amdgcn_s_barrier()
#define PG8_SCHED __builtin_amdgcn_sched_barrier(0)
    Unit cur, nxt; int ui = 0;
    if (!S.next(0, cur)) return;
    Acc acc;
#pragma unroll
    for (int a = 0; a < 2; ++a)
#pragma unroll
        for (int b = 0; b < 2; ++b)
#pragma unroll
            for (int m = 0; m < 4; ++m)
#pragma unroll
                for (int n = 0; n < 2; ++n) acc[a][b][m][n] = (f32x4){0.f, 0.f, 0.f, 0.f};
    bf16x8 At[4][2], B0[2][2], B1[2][2];
    const char* cA = (const char*)g.A + (size_t)cur.pm * tstepA; const char* cB = (const char*)g.Bt + (size_t)cur.pn * tstepB;
    PG8_STAGE(PG8_SB(0, 0), cB, voffB); PG8_STAGE(PG8_SB(0, 1), cB + hstepB, voffB); PG8_STAGE(PG8_SA(0, 0), cA, voffA); PG8_STAGE(PG8_SA(0, 1), cA + hstepA, voffA);
    if (wr == 1) PG8_BAR;
    PG8_WAIT_V(2); PG8_BAR;
    PG8_STAGE(PG8_SB(1, 0), cB + kstep, voffB); PG8_STAGE(PG8_SA(1, 0), cA + kstep, voffA); PG8_STAGE(PG8_SB(1, 1), cB + hstepB + kstep, voffB);
    PG8_WAIT_V(6); PG8_BAR;
    for (;;) {
        const bool has_next = S.next(ui + 1, nxt);
        const char* nA = has_next ? (const char*)g.A + (size_t)nxt.pm * tstepA : cA; const char* nB = has_next ? (const char*)g.Bt + (size_t)nxt.pn * tstepB : cB;
#pragma unroll 1
        for (int t = 0; t < nt; t += 2) {
            const bool last = (t == nt - 2);
            const char* a1 = cA + (size_t)(t + 1) * kstep;
            const char* a2 = last ? nA : cA + (size_t)(t + 2) * kstep; const char* b2 = last ? nB : cB + (size_t)(t + 2) * kstep;
            const char* a3 = a2 + kstep; const char* b3 = b2 + kstep;
            PG8_LDB(B0, 0, 0); PG8_LDB(B1, 0, 1); PG8_SCHED; PG8_LDA(At, 0, 0); PG8_STAGE(PG8_SA(1, 1), a1 + hstepA, voffA);
            PG8_WAIT_V(8); PG8_WAIT_L(0); PG8_BAR; PG8_MMA(0, 0, At, B0); PG8_MMA(0, 1, At, B1); PG8_BAR; PG8_SCHED;
            PG8_LDA(At, 0, 1); PG8_STAGE(PG8_SB(0, 0), b2, voffB); PG8_STAGE(PG8_SB(0, 1), b2 + hstepB, voffB); PG8_STAGE(PG8_SA(0, 0), a2, voffA);
            PG8_WAIT_V(8); PG8_WAIT_L(0); PG8_BAR; PG8_MMA(1, 0, At, B0); PG8_MMA(1, 1, At, B1); PG8_BAR; PG8_SCHED;
            PG8_LDB(B0, 1, 0); PG8_LDB(B1, 1, 1); PG8_SCHED; PG8_LDA(At, 1, 0); PG8_STAGE(PG8_SA(0, 1), a2 + hstepA, voffA);
            PG8_WAIT_V(8); PG8_WAIT_L(0); PG8_BAR; PG8_MMA(0, 0, At, B0); PG8_MMA(0, 1, At, B1); PG8_BAR; PG8_SCHED;
            PG8_LDA(At, 1, 1); PG8_STAGE(PG8_SB(1, 0), b3, voffB); PG8_STAGE(PG8_SB(1, 1), b3 + hstepB, voffB); PG8_STAGE(PG8_SA(1, 0), a3, voffA);
            PG8_WAIT_V(8); PG8_WAIT_L(0); PG8_BAR; PG8_MMA(1, 0, At, B0); PG8_MMA(1, 1, At, B1); PG8_BAR; PG8_SCHED;
        }
        if constexpr (ALIGN_EPI) { if (wr == 0) PG8_BAR; }
        { int fr_ = fr, fq_ = fq; asm volatile("" : "+v"(fr_), "+v"(fq_));
          E(acc, cur, wr, wc, fr_, fq_); }
        if (!has_next) break;
#pragma unroll
        for (int a = 0; a < 2; ++a)
#pragma unroll
            for (int b = 0; b < 2; ++b)
#pragma unroll
                for (int m = 0; m < 4; ++m)
#pragma unroll
                    for (int n = 0; n < 2; ++n) acc[a][b][m][n] = (f32x4){0.f, 0.f, 0.f, 0.f};
        cur = nxt; cA = nA; cB = nB; ++ui;
        if constexpr (ALIGN_EPI) { if (wr == 1) PG8_BAR; }
    }
    PG8_WAIT_V(0);
    if constexpr (!ALIGN_EPI) { if (wr == 0) PG8_BAR; }
    PG8_BAR;
#undef PG8_SA
#undef PG8_SB
#undef PG8_STAGE
#undef PG8_LDA
#undef PG8_LDB
#undef PG8_MMA
#undef PG8_WAIT_V
#undef PG8_WAIT_L
#undef PG8_BAR
#undef PG8_SCHED
}

struct EpiSwiGLU {
    static constexpr bool PERM = true;
    bf16_t* ACT;
    __device__ __forceinline__ void operator()(const Acc& acc, const Unit& u, int wr, int wc, int fr, int fq) const {
        const int row0 = u.pm * BM + wr * 64 + fr, col0 = u.pn * 128 + wc * 32 + 8 * fq;
#pragma unroll
        for (int ai = 0; ai < 2; ++ai)
#pragma unroll
            for (int m = 0; m < 4; ++m) {
                f32x4 o[2];
#pragma unroll
                for (int n = 0; n < 2; ++n) { const f32x4 gt = acc[ai][0][m][n], up = acc[ai][1][m][n];
#pragma unroll
                    for (int e = 0; e < 4; ++e) o[n][e] = gt[e] * fast_sigmoid(gt[e]) * up[e]; }
                *(u32x4*)(ACT + (size_t)(row0 + ai * HALF + m * 16) * DFF + col0) = pack8(o[0], o[1]);
            }
    }
};
struct EpiRes {
    static constexpr bool PERM = false;
    const float* base_lat; const float* base_ctx; float* out_lat; float* out_ctx; const float* modl; int gi; float coef;
    __device__ __forceinline__ void operator()(const Acc& acc, const Unit& u, int wr, int wc, int fr, int fq) const {
        const bool lat = u.pm < NLAT / BM; const int pmr = lat ? u.pm : u.pm - NLAT / BM;
        const float* bp = (lat ? base_lat : base_ctx) + (size_t)pmr * BM * D; float* op = (lat ? out_lat : out_ctx) + (size_t)pmr * BM * D;
        const float* md = modl + (size_t)(lat ? (u.pm >> 3) : 8) * MODW + gi * D;
        const int col0 = u.pn * BM + wc * 32 + 4 * fq;
        f32x4 mv[2][2];
#pragma unroll
        for (int bj = 0; bj < 2; ++bj)
#pragma unroll
            for (int n = 0; n < 2; ++n) mv[bj][n] = *(const f32x4*)(md + col0 + bj * HALF + n * 16) * coef;
#pragma unroll
        for (int ai = 0; ai < 2; ++ai)
#pragma unroll
            for (int m = 0; m < 4; ++m) { const size_t off = (size_t)(ai * HALF + wr * 64 + m * 16 + fr) * D + col0;
#pragma unroll
                for (int bj = 0; bj < 2; ++bj)
#pragma unroll
                    for (int n = 0; n < 2; ++n) { const f32x4 bs = *(const f32x4*)(bp + off + bj * HALF + n * 16); *(f32x4*)(op + off + bj * HALF + n * 16) = bs + mv[bj][n] * acc[ai][bj][m][n]; }
                if (m & 1) asm volatile("" ::: "memory"); }
    }
};
struct EpiInProj {
    static constexpr bool PERM = true;
    bf16_t* P1; float* rowss; const float* rope; const float* gqa; const float* gka; const float* gqb; const float* gkb;
    __device__ __forceinline__ void operator()(const Acc& acc, const Unit& u, int wr, int wc, int fr, int fq) const {
        const int pn = u.pn; const bool lat = u.pm < NLAT / BM;
        const int row0 = u.pm * BM + wr * 64 + fr;
        if (pn >= 2 && pn <= 4) {
            const int dstc = (pn == 2 ? P_CKV : (pn == 3 ? P_CQ : P_CQ + 256)) + wc * 32 + 8 * fq;
#pragma unroll
            for (int ai = 0; ai < 2; ++ai)
#pragma unroll
                for (int m = 0; m < 4; ++m) { const int row = row0 + ai * HALF + m * 16; float ss = 0.f;
#pragma unroll
                    for (int bj = 0; bj < 2; ++bj) { const f32x4 v0 = acc[ai][bj][m][0], v1 = acc[ai][bj][m][1];
                        *(u32x4*)(P1 + (size_t)row * P1W + dstc + bj * HALF) = pack8(v0, v1);
                        if (bj == 0 || pn != 4) ss += ((v0[0] * v0[0] + v0[1] * v0[1]) + (v0[2] * v0[2] + v0[3] * v0[3])) + ((v1[0] * v1[0] + v1[1] * v1[1]) + (v1[2] * v1[2] + v1[3] * v1[3])); }
                    ss += __shfl_xor(ss, 16); ss += __shfl_xor(ss, 32);
                    if (fq == 0) rowss[(size_t)row * 12 + (pn - 2) * 4 + wc] = ss; }
            return;
        }
        int dst; const float* gn = nullptr; float qs = 1.0f;
        if (pn == 0) { if (wc < 2) { dst = P_KA + 64 * wc; gn = gka; } else dst = P_VA + 64 * (wc - 2); }
        else if (pn == 1) { if (wc < 2) { dst = P_KB + 64 * wc; gn = gkb; } else dst = P_VB + 64 * (wc - 2); }
        else if (pn <= 6) { dst = P_QA + 64 * (4 * (pn - 5) + wc); gn = gqa; qs = QSC64; }
        else { dst = P_QB + 64 * (4 * (pn - 7) + wc); gn = gqb; qs = QSC64; }
        dst += 8 * fq;
        if (gn == nullptr) {
#pragma unroll
            for (int ai = 0; ai < 2; ++ai)
#pragma unroll
                for (int m = 0; m < 4; ++m) { const int row = row0 + ai * HALF + m * 16;
#pragma unroll
                    for (int bj = 0; bj < 2; ++bj) *(u32x4*)(P1 + (size_t)row * P1W + dst + 32 * bj) = pack8(acc[ai][bj][m][0], acc[ai][bj][m][1]); }
            return;
        }
        f32x4 gv[2][2];
#pragma unroll
        for (int bj = 0; bj < 2; ++bj)
#pragma unroll
            for (int n = 0; n < 2; ++n) gv[bj][n] = *(const f32x4*)(gn + 32 * bj + 8 * fq + 4 * n) * qs;
#pragma unroll
        for (int ai = 0; ai < 2; ++ai)
#pragma unroll
            for (int m = 0; m < 4; ++m) { const int row = row0 + ai * HALF + m * 16; float ss = 0.f;
#pragma unroll
                for (int bj = 0; bj < 2; ++bj)
#pragma unroll
                    for (int n = 0; n < 2; ++n) { const f32x4 v = acc[ai][bj][m][n]; ss += (v[0] * v[0] + v[1] * v[1]) + (v[2] * v[2] + v[3] * v[3]); }
                ss += __shfl_xor(ss, 16); ss += __shfl_xor(ss, 32);
                const float rstd = __builtin_amdgcn_rsqf(ss * (1.0f / 64.0f) + EPS);
                const float* rp = rope + (size_t)(row & 2047) * 64;
#pragma unroll
                for (int bj = 0; bj < 2; ++bj) { f32x4 o[2];
#pragma unroll
                    for (int n = 0; n < 2; ++n) { const f32x4 v = acc[ai][bj][m][n] * rstd * gv[bj][n];
                        if (lat) { const f32x4 cs = *(const f32x4*)(rp + (16 * bj + 4 * fq + 2 * n) * 2);
                            o[n][0] = v[0] * cs[0] - v[1] * cs[1]; o[n][1] = v[0] * cs[1] + v[1] * cs[0]; o[n][2] = v[2] * cs[2] - v[3] * cs[3]; o[n][3] = v[2] * cs[3] + v[3] * cs[2]; }
                        else o[n] = v; }
                    *(u32x4*)(P1 + (size_t)row * P1W + dst + 32 * bj) = pack8(o[0], o[1]); }
            }
    }
};
template <int WHICH  > struct EpiMlaUp {
    static constexpr bool PERM = true;
    bf16_t* O; const float* rowss;
    __device__ __forceinline__ void operator()(const Acc& acc, const Unit& u, int wr, int wc, int fr, int fq) const {
        constexpr int PITCH = WHICH == 0 ? 768 : 1024;
        const int row0 = u.pm * BM + wr * 64 + fr, col0 = u.pn * BM + wc * 32 + 8 * fq;
#pragma unroll
        for (int ai = 0; ai < 2; ++ai)
#pragma unroll
            for (int m = 0; m < 4; ++m) { const int row = row0 + ai * HALF + m * 16; float r;
                if (WHICH == 0) { const f32x4 a = *(const f32x4*)(rowss + (size_t)row * 12 + 4), b = *(const f32x4*)(rowss + (size_t)row * 12 + 8); r = __builtin_amdgcn_rsqf((((a.x + a.y) + (a.z + a.w)) + ((b.x + b.y) + (b.z + b.w))) * (1.0f / 384.0f) + EPS); }
                else { const f32x4 a = *(const f32x4*)(rowss + (size_t)row * 12); r = __builtin_amdgcn_rsqf(((a.x + a.y) + (a.z + a.w)) * (1.0f / 256.0f) + EPS); }
#pragma unroll
                for (int bj = 0; bj < 2; ++bj) *(u32x4*)(O + (size_t)row * PITCH + col0 + bj * HALF) = pack8(acc[ai][bj][m][0] * r, acc[ai][bj][m][1] * r);
                asm volatile("" ::: "memory"); }
    }
};
struct EpiSigmoid {
    static constexpr bool PERM = true;
    bf16_t* G;
    __device__ __forceinline__ void operator()(const Acc& acc, const Unit& u, int wr, int wc, int fr, int fq) const {
        const int row0 = u.pm * BM + wr * 64 + fr, col0 = u.pn * BM + wc * 32 + 8 * fq;
#pragma unroll
        for (int ai = 0; ai < 2; ++ai)
#pragma unroll
            for (int m = 0; m < 4; ++m)
#pragma unroll
                for (int bj = 0; bj < 2; ++bj) { f32x4 o[2];
#pragma unroll
                    for (int n = 0; n < 2; ++n)
#pragma unroll
                        for (int e = 0; e < 4; ++e) o[n][e] = fast_sigmoid(acc[ai][bj][m][n][e]);
                    *(u32x4*)(G + (size_t)(row0 + ai * HALF + m * 16) * 3072 + col0 + bj * HALF) = pack8(o[0], o[1]); }
    }
};
template <int Z> struct EpiMerge {
    static constexpr bool PERM = true;
    bf16_t* Mm; const bf16_t* G;
    __device__ __forceinline__ void operator()(const Acc& acc, const Unit& u, int wr, int wc, int fr, int fq) const {
        const int row0 = u.pm * BM + wr * 64 + fr, col0 = u.pn * BM + wc * 32 + 8 * fq;
#pragma unroll
        for (int ai = 0; ai < 2; ++ai)
#pragma unroll
            for (int m = 0; m < 4; ++m)
#pragma unroll
                for (int bj = 0; bj < 2; ++bj) { const size_t row = (size_t)(row0 + ai * HALF + m * 16);
                    const u32x4 gw = *(const u32x4*)(G + row * 3072 + Z * 1024 + col0 + bj * HALF);
                    u32x4 mw = (u32x4){0u, 0u, 0u, 0u}; if (Z > 0) mw = *(const u32x4*)(Mm + row * D + col0 + bj * HALF);
                    f32x4 o[2];
#pragma unroll
                    for (int n = 0; n < 2; ++n)
#pragma unroll
                        for (int e2 = 0; e2 < 2; ++e2) { const unsigned gg = gw[2 * n + e2], mm = mw[2 * n + e2];
                            o[n][2 * e2] = __uint_as_float(mm << 16) + __uint_as_float(gg << 16) * acc[ai][bj][m][n][2 * e2];
                            o[n][2 * e2 + 1] = __uint_as_float(mm & 0xffff0000u) + __uint_as_float(gg & 0xffff0000u) * acc[ai][bj][m][n][2 * e2 + 1]; }
                    *(u32x4*)(Mm + row * D + col0 + bj * HALF) = pack8(o[0], o[1]); }
    }
};
}

__device__ __forceinline__ void phase_mla_norm(Ctx& c, int l, int rows_q, int rows_k) {
    PH_IDS(c);
    const Params* p = c.p;
    const int gw = c.wg * 8 + c.wave, ngw = c.nwg * 8, h = lane_ >> 3, j = lane_ & 7;
    const float* gq = p->in[20] + l * 96 + 12 * j; const float* gk = p->in[21] + l * 96 + 12 * j;
    float gqv[12], gkv[12];
#pragma unroll
    for (int i = 0; i < 12; ++i) { gqv[i] = gq[i] * QSC96; gkv[i] = gk[i]; }
    for (int r = gw; r < rows_k; r += ngw) {
        const bool lat = r < NLAT; const int s = r & 2047;
#pragma unroll
        for (int which = 0; which < 2; ++which) {
            if (which == 0 && r >= rows_q) continue;
            float v[12];
            if (which == 0) { const u32x2* qp = (const u32x2*)(c.QC + (size_t)r * 768 + 96 * h + 12 * j);
#pragma unroll
                for (int i = 0; i < 3; ++i) { const u32x2 w = qp[i]; v[4 * i] = __uint_as_float(w.x << 16); v[4 * i + 1] = __uint_as_float(w.x & 0xffff0000u); v[4 * i + 2] = __uint_as_float(w.y << 16); v[4 * i + 3] = __uint_as_float(w.y & 0xffff0000u); } }
            else {
#pragma unroll
                for (int i = 0; i < 3; ++i) { const int d = 12 * j + 4 * i;
                    const bf16_t* src = d < 64 ? c.KVR + (size_t)r * 1024 + 128 * h + d : c.P1 + (size_t)r * P1W + P_CKR + (d - 64);
                    const u32x2 w = *(const u32x2*)src; v[4 * i] = __uint_as_float(w.x << 16); v[4 * i + 1] = __uint_as_float(w.x & 0xffff0000u); v[4 * i + 2] = __uint_as_float(w.y << 16); v[4 * i + 3] = __uint_as_float(w.y & 0xffff0000u); } }
            float ss = 0.f;
#pragma unroll
            for (int i = 0; i < 12; ++i) ss += v[i] * v[i];
            ss += __shfl_xor(ss, 1); ss += __shfl_xor(ss, 2); ss += __shfl_xor(ss, 4);
            const float rstd = 1.0f / sqrtf(ss * (1.0f / 96.0f) + EPS);
#pragma unroll
            for (int i = 0; i < 12; ++i) v[i] *= rstd * (which == 0 ? gqv[i] : gkv[i]);
            if (lat) {
#pragma unroll
                for (int i = 0; i < 6; ++i) { const int d = 12 * j + 2 * i;
                    if (d >= 64) { const float cs = c.rope_c[(s * 16 + ((d - 64) >> 1)) * 2], sn = c.rope_c[(s * 16 + ((d - 64) >> 1)) * 2 + 1];
                        const float x0 = v[2 * i], x1 = v[2 * i + 1]; v[2 * i] = x0 * cs - x1 * sn; v[2 * i + 1] = x0 * sn + x1 * cs; } }
            }
            u32x2* op = (u32x2*)((which == 0 ? c.QC : c.KC) + (size_t)r * 768 + 96 * h + 12 * j);
#pragma unroll
            for (int i = 0; i < 3; ++i) { u32x2 w; w.x = pk2(v[4 * i], v[4 * i + 1]); w.y = pk2(v[4 * i + 2], v[4 * i + 3]); op[i] = w; }
        }
    }
}

__device__ __forceinline__ void fast_ffn_up(Ctx& c, unsigned char* lds, size_t wo, int rows) {
    pg8::Gemm g{c.H, (const bf16_t*)(c.ws + WS_W + wo), rows, 2 * DFF, D, D}; pg8::StaticOrder S; S.init(rows, 2 * DFF, c.nwg, c.wg);
    pg8::EpiSwiGLU E{c.ACT};
    pg8::gemm_phase<pg8::EpiSwiGLU, pg8::StaticOrder, true>((LAS unsigned char*)lds, c.wave, g, S, E);
}
__device__ __forceinline__ void fast_res(Ctx& c, unsigned char* lds, int l, const bf16_t* A, int K, size_t wo, float coef, int gi, int rows, bool from_input) {
    pg8::Gemm g{A, (const bf16_t*)(c.ws + WS_W + wo), rows, D, K, K}; pg8::StaticOrder S; S.init(rows, D, c.nwg, c.wg);
    pg8::EpiRes E{from_input ? c.p->in[0] : c.p->out, from_input ? c.p->in[2] : c.Z, c.p->out, c.Z, c.mod + (size_t)l * 9 * MODW, gi, coef};
    pg8::gemm_phase<pg8::EpiRes, pg8::StaticOrder, true>((LAS unsigned char*)lds, c.wave, g, S, E);
}
__device__ __forceinline__ void fast_inproj(Ctx& c, unsigned char* lds, int l, int rows) {
    const Params* p = c.p;
    pg8::Gemm g{c.H, (const bf16_t*)(c.ws + WS_W + WO_P1), rows, P1W, D, D}; pg8::StaticOrder S; S.init(rows, P1W, c.nwg, c.wg);
    pg8::EpiInProj E{c.P1, c.rowss, c.rope_hd, p->in[11] + l * 64, p->in[12] + l * 64, p->in[14] + l * 64, p->in[15] + l * 64};
    pg8::gemm_phase<pg8::EpiInProj, pg8::StaticOrder, true>((LAS unsigned char*)lds, c.wave, g, S, E);
}
__device__ __forceinline__ void fast_mla_up(Ctx& c, unsigned char* lds, int rows_q, int rows_k) {
    { pg8::Gemm g{c.P1 + P_CQ, (const bf16_t*)(c.ws + WS_W + WO_UQ), rows_q, 768, 384, P1W}; pg8::StaticOrder S; S.init(rows_q, 768, c.nwg, c.wg);
      pg8::EpiMlaUp<0> E{c.QC, c.rowss}; pg8::gemm_phase<pg8::EpiMlaUp<0>, pg8::StaticOrder, true>((LAS unsigned char*)lds, c.wave, g, S, E); }
    { pg8::Gemm g{c.P1 + P_CKV, (const bf16_t*)(c.ws + WS_W + WO_UKV), rows_k, 1024, 256, P1W}; pg8::StaticOrder S; S.init(rows_k, 1024, c.nwg, c.wg);
      pg8::EpiMlaUp<1> E{c.KVR, c.rowss}; pg8::gemm_phase<pg8::EpiMlaUp<1>, pg8::StaticOrder, true>((LAS unsigned char*)lds, c.wave, g, S, E); }
}
__device__ __forceinline__ void fast_gates(Ctx& c, unsigned char* lds, int rows) {
    pg8::Gemm g{c.H, (const bf16_t*)(c.ws + WS_W + WO_G), rows, 3072, D, D}; pg8::StaticOrder S; S.init(rows, 3072, c.nwg, c.wg);
    pg8::EpiSigmoid E{c.G};
    pg8::gemm_phase<pg8::EpiSigmoid, pg8::StaticOrder, true>((LAS unsigned char*)lds, c.wave, g, S, E);
}
__device__ __forceinline__ void fast_merge(Ctx& c, unsigned char* lds, int rows) {
    pg8::StaticOrder S; S.init(rows, D, c.nwg, c.wg);
    { pg8::Gemm g{c.P1 + P_QA, (const bf16_t*)(c.ws + WS_W + WO_BR), rows, D, 512, P1W}; pg8::EpiMerge<0> E{c.H, c.G}; pg8::gemm_phase<pg8::EpiMerge<0>, pg8::StaticOrder, true>((LAS unsigned char*)lds, c.wave, g, S, E); }
    { pg8::Gemm g{c.P1 + P_QB, (const bf16_t*)(c.ws + WS_W + WO_BR) + (size_t)1024 * 512, rows, D, 512, P1W}; pg8::EpiMerge<1> E{c.H, c.G}; pg8::gemm_phase<pg8::EpiMerge<1>, pg8::StaticOrder, true>((LAS unsigned char*)lds, c.wave, g, S, E); }
    { pg8::Gemm g{c.YC, (const bf16_t*)(c.ws + WS_W + WO_BR) + (size_t)2 * 1024 * 512, rows, D, 512, 512}; pg8::EpiMerge<2> E{c.H, c.G}; pg8::gemm_phase<pg8::EpiMerge<2>, pg8::StaticOrder, true>((LAS unsigned char*)lds, c.wave, g, S, E); }
}

constexpr int CW_BAR = 4096;
constexpr int MISC_OFF = 131072 + 320;
#define XB_TMO      128
#define XB_XCNT(j)  (256  + 64 * (j))
#define XB_XSUB(j)  (1280 + 64 * (j))
#define XB_XGEN(j)  (2304 + 64 * (j))
#define XB_TOP      3328
#define XB_TOPGEN   3392
#define XCD_BAR_WORDS 3456
#define XB_SPIN_CAP (1u << 18)
__device__ __forceinline__ unsigned xb_ld(unsigned* p)              { return __hip_atomic_load(p, __ATOMIC_RELAXED, __HIP_MEMORY_SCOPE_AGENT); }
__device__ __forceinline__ unsigned xb_add(unsigned* p, unsigned v) { return __hip_atomic_fetch_add(p, v, __ATOMIC_RELAXED, __HIP_MEMORY_SCOPE_AGENT); }
__device__ __forceinline__ unsigned xb_xcc_id() { return (unsigned)__builtin_amdgcn_s_getreg((3 << 11) | 20) & 0xFu; }
#define XB_SPIN(cond, bar) do { unsigned _sp = 0; while (cond) { __builtin_amdgcn_s_sleep(1); \
    if ((++_sp & 255u) == 0u) { if (xb_ld(&(bar)[XB_TMO])) break; if (_sp > XB_SPIN_CAP) { atomicAdd(&(bar)[XB_TMO], 1u); break; } } } } while (0)
struct XcdBarrier { unsigned* bar; unsigned x; volatile LAS unsigned* st; };
__device__ __forceinline__ void xcd_barrier_complete(unsigned* bar, unsigned x, unsigned& nloc, unsigned& nx) {
    const unsigned G = gridDim.x * gridDim.y * gridDim.z;
    unsigned sum, cnt, mine, sp = 0u;
    for (;;) {
        sum = 0u; cnt = 0u; mine = 0u;
#pragma unroll
        for (unsigned j = 0; j < 16; ++j) { const unsigned cc = xb_ld(&bar[XB_XCNT(j)]); sum += cc; cnt += (cc > 0u) ? 1u : 0u; mine = (j == x) ? cc : mine; }
        if (sum == G) break;
        __builtin_amdgcn_s_sleep(1);
        if ((++sp & 255u) == 0u) { if (xb_ld(&bar[XB_TMO])) break; if (sp > XB_SPIN_CAP) { atomicAdd(&bar[XB_TMO], 1u); break; } }
    }
    nloc = mine > 0u ? mine : 1u; nx = cnt > 0u ? cnt : 1u;
}
__device__ __forceinline__ void xcd_barrier(const XcdBarrier& b, int wave) {
    asm volatile("s_waitcnt vmcnt(0)" ::: "memory");
    __syncthreads();
    if (wave == 0 && lane_id() == 0) {
        unsigned* bar = b.bar;
        __builtin_amdgcn_s_waitcnt(0);
        unsigned nloc = b.st[0], nx = b.st[1];
        if (nloc == 0u) { xcd_barrier_complete(bar, b.x, nloc, nx); b.st[0] = nloc; b.st[1] = nx; }
        const unsigned old = xb_add(&bar[XB_XSUB(b.x)], 1u);
        const unsigned gen = old / nloc;
        if (old + 1u == (gen + 1u) * nloc) {
            __builtin_amdgcn_fence(__ATOMIC_RELEASE, "agent");
            asm volatile("s_waitcnt vmcnt(0)" ::: "memory");
            const unsigned og = xb_add(&bar[XB_TOP], 1u);
            const unsigned tg = og / nx;
            if (og + 1u == (tg + 1u) * nx) xb_add(&bar[XB_TOPGEN], 1u);
            else XB_SPIN(xb_ld(&bar[XB_TOPGEN]) == tg, bar);
            __builtin_amdgcn_fence(__ATOMIC_ACQUIRE, "agent");
            xb_add(&bar[XB_XGEN(b.x)], 1u);
            asm volatile("s_waitcnt vmcnt(0)" ::: "memory");
        } else {
            XB_SPIN(xb_ld(&bar[XB_XGEN(b.x)]) == gen, bar);
            __builtin_amdgcn_fence(__ATOMIC_ACQUIRE, "agent");
            asm volatile("s_waitcnt vmcnt(0)" ::: "memory");
        }
    }
    __syncthreads();
}

template <int S> __device__ __forceinline__ void run_stage(Ctx& c, int l, unsigned char* lds) {
    const Params* p = c.p;
    const bool last = l == DEPTH - 1;
    const int rows_all = MT, rows_mix = last ? NLAT : MT;
    if constexpr (S == -1) phase_mod(c, (float*)lds);
    if constexpr (S == 0) phase_norm(c, l, p->in[6] + l * D, 0, rows_all, l == 0);
    if constexpr (S == 1) naive_ffn_up(c, p->in[7] + (size_t)l * D * 2 * DFF, rows_all);
    if constexpr (S == 2) naive_res(c, l, c.ACT, DFF, DFF, p->in[8] + (size_t)l * DFF * D, 0.5f, 2, rows_all, l == 0);
    if constexpr (S == 3) phase_norm(c, l, p->in[9] + l * D, 3, rows_all, false);
    if constexpr (S == 4) naive_inproj(c, l, rows_all);
    if constexpr (S == 5) naive_rowss(c, rows_all);
    if constexpr (S == 6) { naive_mla_q(c, l, rows_mix); naive_mla_kv(c, l, rows_all); }
    if constexpr (S == 7) naive_attn(c, l, 0, rows_mix);
    if constexpr (S == 8) naive_gates(c, l, rows_mix);
    if constexpr (S == 9) naive_merge(c, l, rows_mix);
    if constexpr (S == 10) naive_res(c, l, c.H, D, D, p->in[25] + (size_t)l * D * D, 1.0f, 5, rows_mix, false);
    if constexpr (S == 11) phase_norm(c, l, p->in[26] + l * D, 6, rows_mix, false);
    if constexpr (S == 12) naive_ffn_up(c, p->in[27] + (size_t)l * D * 2 * DFF, rows_mix);
    if constexpr (S == 13) naive_res(c, l, c.ACT, DFF, DFF, p->in[28] + (size_t)l * DFF * D, 0.5f, 8, rows_mix, false);
    if constexpr (S == 20) phase_convert(c, l, lds);
    if constexpr (S == 21) fast_ffn_up(c, lds, WO_F1IN, rows_all);
    if constexpr (S == 22) fast_res(c, lds, l, c.ACT, DFF, WO_F1OUT, 0.5f, 2, rows_all, l == 0);
    if constexpr (S == 24) fast_inproj(c, lds, l, rows_all);
    if constexpr (S == 26) fast_mla_up(c, lds, rows_mix, rows_all);
    if constexpr (S == 27) phase_mla_norm(c, l, rows_mix, rows_all);
    if constexpr (S == 28) fast_gates(c, lds, rows_mix);
    if constexpr (S == 29) fast_merge(c, lds, rows_mix);
    if constexpr (S == 30) fast_res(c, lds, l, c.H, D, WO_OUT, 1.0f, 5, rows_mix, false);
    if constexpr (S == 32) fast_ffn_up(c, lds, WO_F2IN, rows_mix);
    if constexpr (S == 33) fast_res(c, lds, l, c.ACT, DFF, WO_F2OUT, 0.5f, 8, rows_mix, false);
}
template <int S> __global__ void __launch_bounds__(512, 2) k_stage(Params prm, int l) {
    extern __shared__ __attribute__((aligned(16))) unsigned char lds[];
    Ctx c; ctx_init(c, &prm, blockIdx.x, gridDim.x);
    run_stage<S>(c, l, lds);
}
constexpr int LDS_NAIVE = 65536, LDS_FAST = 147456;
#ifndef MULTI
#define MULTI 0
#endif
__global__ void __launch_bounds__(512, 2) mega_kernel(Params prm) {
    extern __shared__ __attribute__((aligned(16))) unsigned char lds[];
    Ctx c; ctx_init(c, &prm, blockIdx.x, gridDim.x);
    volatile LAS unsigned* MISC = (volatile LAS unsigned*)((LAS unsigned char*)lds + MISC_OFF);
    { const int ln = lane_id(); if (c.wave == 0 && ln < 32) MISC[ln] = 0u; }
    __syncthreads();
    XcdBarrier bar; bar.bar = (unsigned*)(prm.ws + WS_CTL) + CW_BAR; bar.x = xb_xcc_id(); bar.st = MISC + 8;
    if (c.wave == 0 && lane_id() == 0) (void)xb_add(&bar.bar[XB_XCNT(bar.x)], 1u);
#define GRID_BAR() xcd_barrier(bar, c.wave)
    run_stage<-1>(c, 0, lds); __syncthreads(); run_stage<20>(c, 0, lds); GRID_BAR();
#pragma unroll 1
    for (int l = 0; l < DEPTH; ++l) {
        if (l > 0) run_stage<20>(c, l, lds);
        run_stage<0>(c, l, lds); GRID_BAR();
        run_stage<21>(c, l, lds); GRID_BAR();
        run_stage<22>(c, l, lds); GRID_BAR();
        run_stage<3>(c, l, lds); GRID_BAR();
        run_stage<24>(c, l, lds); GRID_BAR();
        run_stage<26>(c, l, lds); GRID_BAR();
        run_stage<27>(c, l, lds); GRID_BAR();
        run_stage<7>(c, l, lds); GRID_BAR();
        run_stage<28>(c, l, lds); GRID_BAR();
        run_stage<29>(c, l, lds); GRID_BAR();
        run_stage<30>(c, l, lds); GRID_BAR();
        run_stage<11>(c, l, lds); GRID_BAR();
        run_stage<32>(c, l, lds); GRID_BAR();
        run_stage<33>(c, l, lds); if (l + 1 < DEPTH) GRID_BAR();
    }
#undef GRID_BAR
}
static int g_cus = 0;
template <int S> static void launch_stage(const Params& p, int l, hipStream_t stream) {
    constexpr bool fast = S >= 20;
    static int inited = 0;
    if (!inited) { (void)hipFuncSetAttribute((const void*)k_stage<S>, hipFuncAttributeMaxDynamicSharedMemorySize, fast ? LDS_FAST : LDS_NAIVE); inited = 1; }
    hipLaunchKernelGGL(k_stage<S>, dim3(fast ? g_cus : 1024), dim3(512), fast ? LDS_FAST : LDS_NAIVE, stream, p, l);
}
#ifndef FASTMASK
#define FASTMASK 0xffff
#endif
template <int BIT, int SF, int SN> static void launch_sel(const Params& p, int l, hipStream_t stream) { if constexpr ((FASTMASK >> BIT) & 1) launch_stage<SF>(p, l, stream); else launch_stage<SN>(p, l, stream); }

extern "C" void kernel_launch(void* const* d_in, const int* in_sizes, int n_in, void* d_out, int out_size, void* d_ws, size_t ws_size, hipStream_t stream) {
    if (n_in != 29 || out_size != NLAT * D || ws_size < WS_END) { fprintf(stderr, "kernel_launch: unexpected shapes (n_in %d out %d ws %zu need %zu)\n", n_in, out_size, ws_size, (size_t)WS_END); return; }
    if (!g_cus) { int dev = 0; (void)hipGetDevice(&dev); (void)hipDeviceGetAttribute(&g_cus, hipDeviceAttributeMultiprocessorCount, dev); if (g_cus <= 0) g_cus = 256;
        (void)hipFuncSetAttribute((const void*)mega_kernel, hipFuncAttributeMaxDynamicSharedMemorySize, LDS_FAST); }
    Params p{};
    for (int i = 0; i < 29; ++i) p.in[i] = (const float*)d_in[i];
    p.out = (float*)d_out; p.ws = (unsigned char*)d_ws;
    for (int f = 0; f < 16; ++f) p.invf_hd[f] = (float)pow(10000.0, -(double)f / 16.0);
    for (int f = 0; f < 8; ++f) p.invf_c[f] = (float)pow(10000.0, -(double)f / 8.0);
    (void)hipMemsetAsync((char*)d_ws + WS_CTL, 0, 1u << 20, stream);
#if !MULTI
    hipLaunchKernelGGL(mega_kernel, dim3(g_cus), dim3(512), LDS_FAST, stream, p);
#else
    launch_stage<-1>(p, 0, stream);
    for (int l = 0; l < DEPTH; ++l) {
        launch_stage<20>(p, l, stream);
        launch_stage<0>(p, l, stream);
        launch_sel<0, 21, 1>(p, l, stream);
        launch_sel<1, 22, 2>(p, l, stream);
        launch_stage<3>(p, l, stream);
        launch_sel<2, 24, 4>(p, l, stream);
        if constexpr (!((FASTMASK >> 2) & 1)) launch_stage<5>(p, l, stream);
        if constexpr ((FASTMASK >> 3) & 1) { launch_stage<26>(p, l, stream); launch_stage<27>(p, l, stream); } else launch_stage<6>(p, l, stream);
        launch_stage<7>(p, l, stream);
        launch_sel<4, 28, 8>(p, l, stream);
        launch_sel<5, 29, 9>(p, l, stream);
        launch_sel<6, 30, 10>(p, l, stream);
        launch_stage<11>(p, l, stream);
        launch_sel<7, 32, 12>(p, l, stream);
        launch_sel<8, 33, 13>(p, l, stream);
    }
#endif
}
```

```cpp
#include <hip/hip_runtime.h>
#include <cstdio>
#include <cstdint>
#include <cmath>

constexpr int D = 1024, NB_ = 8, SEQ = 2048, CTXL = 256, DFF = 2816, DEPTH = 2;
constexpr int NLAT = NB_ * SEQ;
constexpr int NCTX = NB_ * CTXL;
constexpr int MT = NLAT + NCTX;
constexpr int NMOD = 9, MODW = NMOD * D;
constexpr int INC = 5280;
constexpr int O_AK = 0, O_AV = 128, O_BK = 256, O_BV = 384, O_CKV = 512, O_CKR = 768, O_AQ = 800, O_BQ = 1312, O_CQ = 1824, O_G = 2208;
constexpr int P1W = 2304;
constexpr int P_KA = 0, P_VA = 128, P_KB = 256, P_VB = 384, P_CKV = 512, P_CQ = 768, P_CKR = 1152, P_QA = 1280, P_QB = 1792;
constexpr float EPS = 1e-6f;
constexpr float LOG2E = 1.4426950408889634f;
constexpr float QSC64 = 0.125f * LOG2E;
constexpr float QSC96 = 0.10206207261596575f * LOG2E;

typedef unsigned short bf16_t;
typedef short bf16x8 __attribute__((ext_vector_type(8)));
typedef float f32x4 __attribute__((ext_vector_type(4)));
typedef unsigned u32x4 __attribute__((ext_vector_type(4)));
typedef unsigned u32x2 __attribute__((ext_vector_type(2)));

constexpr size_t WS_CTL = 0;
constexpr size_t WS_MOD = 1u << 20;
constexpr size_t WS_ROPE_HD = WS_MOD + (size_t)DEPTH * 9 * MODW * 4;
constexpr size_t WS_ROPE_C = WS_ROPE_HD + (size_t)SEQ * 32 * 2 * 4;
constexpr size_t WS_ROWSS = WS_ROPE_C + (size_t)SEQ * 16 * 2 * 4;
constexpr size_t WS_Z = WS_ROWSS + (size_t)MT * 12 * 4;
constexpr size_t WS_H = WS_Z + (size_t)NCTX * D * 4;
constexpr size_t WS_RA = WS_H + (size_t)MT * D * 2;
constexpr size_t RA_BYTES = (size_t)MT * 3072 * 2;
constexpr size_t WS_P1 = WS_RA + RA_BYTES;
constexpr size_t WS_YC = WS_P1 + (size_t)MT * P1W * 2;
constexpr size_t WS_W = WS_YC + (size_t)MT * 512 * 2;
constexpr size_t WS_END = WS_W + 52u * 1024 * 1024;
constexpr size_t RA_QC = 0, RA_KC = (size_t)MT * 768 * 2, RA_KVR = 2 * (size_t)MT * 768 * 2;

struct Params {
    const float* in[29];
    float* out;
    unsigned char* ws;
    float invf_hd[16];
    float invf_c[8];
    int ph_lo, ph_hi;
};

__device__ __forceinline__ float bf2f(bf16_t v) { return __uint_as_float((unsigned)v << 16); }
__device__ __forceinline__ bf16_t f2bf(float f) { unsigned u = __float_as_uint(f); return (bf16_t)((u + 0x7fffu + ((u >> 16) & 1u)) >> 16); }
__device__ __forceinline__ unsigned pk2(float lo, float hi) { return (unsigned)f2bf(lo) | ((unsigned)f2bf(hi) << 16); }
__device__ __forceinline__ float sigmoidf_(float v) { return 1.0f / (1.0f + __expf(-v)); }
__device__ __forceinline__ int row_mb(int r) { return r < NLAT ? (r >> 11) : 8; }

__device__ __forceinline__ int lane_id() { int l; asm volatile("v_mbcnt_lo_u32_b32 %0, -1, 0\n\tv_mbcnt_hi_u32_b32 %0, -1, %0" : "=v"(l)); return l; }
#define PH_IDS(c) const int lane_ = lane_id(); const int tid_ = (c).wave * 64 + lane_; (void)tid_
struct Ctx {
    const Params* p;
    int wave, wg, nwg;
    unsigned char* ws;
    float* mod; float* rope_hd; float* rope_c; float* rowss; float* Z; bf16_t* H; bf16_t* ACT; bf16_t* QC; bf16_t* KC; bf16_t* KVR; bf16_t* G; bf16_t* P1; bf16_t* YC;
};
__device__ __forceinline__ void ctx_init(Ctx& c, const Params* p, int wg, int nwg) {
    c.p = p; c.wave = __builtin_amdgcn_readfirstlane((int)threadIdx.x >> 6); c.wg = wg; c.nwg = nwg;
    unsigned char* ws = p->ws; c.ws = ws;
    c.mod = (float*)(ws + WS_MOD); c.rope_hd = (float*)(ws + WS_ROPE_HD); c.rope_c = (float*)(ws + WS_ROPE_C); c.rowss = (float*)(ws + WS_ROWSS);
    c.Z = (float*)(ws + WS_Z); c.H = (bf16_t*)(ws + WS_H); c.ACT = (bf16_t*)(ws + WS_RA);
    c.QC = (bf16_t*)(ws + WS_RA + RA_QC); c.KC = (bf16_t*)(ws + WS_RA + RA_KC); c.KVR = (bf16_t*)(ws + WS_RA + RA_KVR); c.G = (bf16_t*)(ws + WS_RA);
    c.P1 = (bf16_t*)(ws + WS_P1); c.YC = (bf16_t*)(ws + WS_YC);
}
__device__ __forceinline__ const float* xin_row(const Ctx& c, int r, bool from_input) {
    if (from_input) return r < NLAT ? c.p->in[0] + (size_t)r * D : c.p->in[2] + (size_t)(r - NLAT) * D;
    return r < NLAT ? c.p->out + (size_t)r * D : c.Z + (size_t)(r - NLAT) * D;
}
__device__ __forceinline__ float* xout_row(const Ctx& c, int r) { return r < NLAT ? c.p->out + (size_t)r * D : c.Z + (size_t)(r - NLAT) * D; }

__device__ __forceinline__ void sincos_d(double x, float& s, float& c) {
    const double TWO_PI = 6.283185307179586476925286766559;
    const double k = rint(x * (1.0 / TWO_PI)); const double r = x - k * TWO_PI; const double r2 = r * r;
    double ts = r, ss = r, tc = 1.0, sc = 1.0;
    for (int n = 1; n <= 15; ++n) { ts *= -r2 / (double)((2 * n) * (2 * n + 1)); ss += ts; tc *= -r2 / (double)((2 * n - 1) * (2 * n)); sc += tc; }
    s = (float)ss; c = (float)sc;
}
__device__ __forceinline__ void phase_mod(Ctx& c, float* lds) {
    PH_IDS(c);
    const Params* p = c.p;
    float* cond = lds;
    float* red = lds + 9 * 1024;
    for (int i = tid_; i < 9 * 1024; i += 512) { const int mb = i >> 10, k = i & 1023; const float v = mb < 8 ? p->in[1][mb * 1024 + k] : p->in[3][k]; cond[i] = v * sigmoidf_(v); }
    __syncthreads();
    const int ks = tid_ >> 6, cc = tid_ & 63;
    for (int u = c.wg; u < DEPTH * MODW / 64; u += c.nwg) {
        const int n0 = u * 64, l = n0 / MODW, nn = n0 % MODW;
        float acc[9];
#pragma unroll
        for (int m = 0; m < 9; ++m) acc[m] = 0.f;
        const float* w = p->in[4] + ((size_t)l * D + ks * 128) * MODW + nn + cc;
#pragma unroll 8
        for (int k = 0; k < 128; ++k) { const float wv = w[(size_t)k * MODW];
#pragma unroll
            for (int m = 0; m < 9; ++m) acc[m] += cond[m * 1024 + ks * 128 + k] * wv; }
#pragma unroll
        for (int m = 0; m < 9; ++m) red[(ks * 9 + m) * 64 + cc] = acc[m];
        __syncthreads();
        for (int o = tid_; o < 9 * 64; o += 512) { const int m = o >> 6, c2 = o & 63; float s = 0.f;
#pragma unroll
            for (int k2 = 0; k2 < 8; ++k2) s += red[(k2 * 9 + m) * 64 + c2];
            c.mod[((size_t)l * 9 + m) * MODW + nn + c2] = s + p->in[5][(size_t)l * MODW + nn + c2]; }
        __syncthreads();
    }
    const int gt = c.wg * 512 + tid_, ngt = c.nwg * 512;
    for (int i = gt; i < SEQ * 48; i += ngt) {
        const int s = i / 48, j = i % 48; const int row = s >> 6, col = s & 63; float sn, cs;
        if (j < 32) { const double ang = (double)(j < 16 ? row : col) * (double)p->invf_hd[j & 15]; sincos_d(ang, sn, cs); c.rope_hd[(s * 32 + j) * 2] = cs; c.rope_hd[(s * 32 + j) * 2 + 1] = sn; }
        else { const int jj = j - 32; const double ang = (double)(jj < 8 ? row : col) * (double)p->invf_c[jj & 7]; sincos_d(ang, sn, cs); c.rope_c[(s * 16 + jj) * 2] = cs; c.rope_c[(s * 16 + jj) * 2 + 1] = sn; }
    }
}

__device__ __forceinline__ float wave_sum(float v) {
#pragma unroll
    for (int o = 1; o < 64; o <<= 1) v += __shfl_xor(v, o);
    return v;
}
__device__ __forceinline__ void phase_norm(Ctx& c, int l, const float* gain, int shift_idx, int rows, bool from_input) {
    PH_IDS(c);
    const int gw = c.wg * 8 + c.wave, ngw = c.nwg * 8;
    for (int r = gw; r < rows; r += ngw) {
        const f32x4* xr = (const f32x4*)xin_row(c, r, from_input) + lane_;
        f32x4 v[4]; float s = 0.f;
#pragma unroll
        for (int j = 0; j < 4; ++j) { v[j] = xr[64 * j]; s += (v[j].x * v[j].x + v[j].y * v[j].y) + (v[j].z * v[j].z + v[j].w * v[j].w); }
        const float rstd = 1.0f / sqrtf(wave_sum(s) * (1.0f / D) + EPS);
        const float* md = c.mod + ((size_t)l * 9 + row_mb(r)) * MODW;
        unsigned long long* o8 = (unsigned long long*)(c.H + (size_t)r * D) + lane_;
#pragma unroll
        for (int j = 0; j < 4; ++j) { const int k = 4 * lane_ + 256 * j;
            const f32x4 g = *(const f32x4*)(gain + k), sh = *(const f32x4*)(md + shift_idx * D + k), sc = *(const f32x4*)(md + (shift_idx + 1) * D + k);
            const f32x4 y = v[j] * rstd * g * (sc + 1.0f) + sh;
            o8[64 * j] = (unsigned long long)pk2(y.x, y.y) | ((unsigned long long)pk2(y.z, y.w) << 32); }
    }
}

template <int NB>
__device__ __forceinline__ void naive_tile(const bf16_t* A, int lda, int K, int row0, const float* const (&wp)[NB], int ldw, const float* kscale, f32x4 (&acc)[NB], int lane) {
    const int r = lane & 15, q = lane >> 4;
    const bf16_t* ap = A + (size_t)(row0 + r) * lda + q * 8;
    for (int k0 = 0; k0 < K; k0 += 32) {
        const bf16x8 a = *(const bf16x8*)(ap + k0);
        float ks[8];
#pragma unroll
        for (int j = 0; j < 8; ++j) ks[j] = kscale ? kscale[k0 + q * 8 + j] : 1.0f;
#pragma unroll
        for (int nb = 0; nb < NB; ++nb) { bf16x8 b;
#pragma unroll
            for (int j = 0; j < 8; ++j) b[j] = (short)f2bf(wp[nb][(size_t)(k0 + q * 8 + j) * ldw + r] * ks[j]);
            acc[nb] = __builtin_amdgcn_mfma_f32_16x16x32_bf16(a, b, acc[nb], 0, 0, 0); }
    }
}
__device__ __forceinline__ float quad16_sum(float v) { v += __shfl_xor(v, 1); v += __shfl_xor(v, 2); v += __shfl_xor(v, 4); v += __shfl_xor(v, 8); return v; }

__device__ __forceinline__ void naive_ffn_up(Ctx& c, const float* w_in, int rows) {
    PH_IDS(c);
    const int gw = c.wg * 8 + c.wave, ngw = c.nwg * 8, r = lane_ & 15, q = lane_ >> 4;
    const int nu = (rows / 16) * 176;
    for (int u = gw; u < nu; u += ngw) {
        const int rt = u / 176, cg = u % 176, row0 = rt * 16, c0 = cg * 16;
        const float* wp[2] = {w_in + c0, w_in + DFF + c0};
        f32x4 acc[2] = {{0.f, 0.f, 0.f, 0.f}, {0.f, 0.f, 0.f, 0.f}};
        naive_tile<2>(c.H, D, D, row0, wp, 2 * DFF, nullptr, acc, lane_);
#pragma unroll
        for (int i = 0; i < 4; ++i) { const float g = acc[0][i], up = acc[1][i]; c.ACT[(size_t)(row0 + q * 4 + i) * DFF + c0 + r] = f2bf(g * sigmoidf_(g) * up); }
    }
}
__device__ __forceinline__ void naive_res(Ctx& c, int l, const bf16_t* A, int lda, int K, const float* W, float coef, int gi, int rows, bool from_input) {
    PH_IDS(c);
    const int gw = c.wg * 8 + c.wave, ngw = c.nwg * 8, r = lane_ & 15, q = lane_ >> 4;
    const int nu = (rows / 16) * 16;
    for (int u = gw; u < nu; u += ngw) {
        const int rt = u / 16, cg = u % 16, row0 = rt * 16, c0 = cg * 64;
        const float* wp[4] = {W + c0, W + c0 + 16, W + c0 + 32, W + c0 + 48};
        f32x4 acc[4];
#pragma unroll
        for (int nb = 0; nb < 4; ++nb) acc[nb] = (f32x4){0.f, 0.f, 0.f, 0.f};
        naive_tile<4>(A, lda, K, row0, wp, D, nullptr, acc, lane_);
#pragma unroll
        for (int i = 0; i < 4; ++i) { const int row = row0 + q * 4 + i; const float* md = c.mod + ((size_t)l * 9 + row_mb(row)) * MODW + gi * D;
            const float* bi = xin_row(c, row, from_input); float* bo = xout_row(c, row);
#pragma unroll
            for (int nb = 0; nb < 4; ++nb) { const int cc = c0 + nb * 16 + r; bo[cc] = bi[cc] + coef * md[cc] * acc[nb][i]; } }
    }
}
__device__ __forceinline__ void naive_inproj(Ctx& c, int l, int rows) {
    PH_IDS(c);
    const Params* p = c.p;
    const int gw = c.wg * 8 + c.wave, ngw = c.nwg * 8, r = lane_ & 15, q = lane_ >> 4;
    const float* W = p->in[10] + (size_t)l * D * INC;
    const int nu = (rows / 16) * 36;
    for (int u = gw; u < nu; u += ngw) {
        const int rt = u / 36, g = u % 36, row0 = rt * 16;
        if (g == 19) continue;
        int src, dst, kind;
        if (g < 2) { src = O_AK + 64 * g; dst = P_KA + 64 * g; kind = 1; }
        else if (g < 4) { src = O_AV + 64 * (g - 2); dst = P_VA + 64 * (g - 2); kind = 0; }
        else if (g < 6) { src = O_BK + 64 * (g - 4); dst = P_KB + 64 * (g - 4); kind = 2; }
        else if (g < 8) { src = O_BV + 64 * (g - 6); dst = P_VB + 64 * (g - 6); kind = 0; }
        else if (g < 12) { src = O_CKV + 64 * (g - 8); dst = P_CKV + 64 * (g - 8); kind = 0; }
        else if (g < 18) { src = O_CQ + 64 * (g - 12); dst = P_CQ + 64 * (g - 12); kind = 0; }
        else if (g == 18) { src = O_CKR; dst = P_CKR; kind = 0; }
        else if (g < 28) { src = O_AQ + 64 * (g - 20); dst = P_QA + 64 * (g - 20); kind = 3; }
        else { src = O_BQ + 64 * (g - 28); dst = P_QB + 64 * (g - 28); kind = 4; }
        const float* wp[4] = {W + src, W + src + 16, W + src + (g == 18 ? 0 : 32), W + src + (g == 18 ? 0 : 48)};
        f32x4 acc[4];
#pragma unroll
        for (int nb = 0; nb < 4; ++nb) acc[nb] = (f32x4){0.f, 0.f, 0.f, 0.f};
        naive_tile<4>(c.H, D, D, row0, wp, INC, nullptr, acc, lane_);
        const float* gn = kind == 1 ? p->in[12] + l * 64 : kind == 2 ? p->in[15] + l * 64 : kind == 3 ? p->in[11] + l * 64 : p->in[14] + l * 64;
#pragma unroll
        for (int i = 0; i < 4; ++i) {
            const int row = row0 + q * 4 + i;
            bf16_t* o = c.P1 + (size_t)row * P1W + dst;
            if (kind == 0) {
#pragma unroll
                for (int nb = 0; nb < 4; ++nb) { if (g == 18 && nb >= 2) o[nb * 16 + r] = 0; else o[nb * 16 + r] = f2bf(acc[nb][i]); }
            } else {
                float ss = 0.f;
#pragma unroll
                for (int nb = 0; nb < 4; ++nb) ss += acc[nb][i] * acc[nb][i];
                ss = quad16_sum(ss);
                const float rstd = 1.0f / sqrtf(ss * (1.0f / 64.0f) + EPS);
                const float qs = kind >= 3 ? QSC64 : 1.0f;
#pragma unroll
                for (int nb = 0; nb < 4; ++nb) { const int d = nb * 16 + r; float v = acc[nb][i] * rstd * gn[d];
                    const float pr = __shfl_xor(v, 1);
                    if (row < NLAT) { const int s = row & 2047; const float cs = c.rope_hd[(s * 32 + (d >> 1)) * 2], sn = c.rope_hd[(s * 32 + (d >> 1)) * 2 + 1];
                        v = (d & 1) ? (pr * sn + v * cs) : (v * cs - pr * sn); }
                    o[d] = f2bf(v * qs); }
            }
        }
    }
}
__device__ __forceinline__ void naive_rowss(Ctx& c, int rows) {
    PH_IDS(c);
    const int gw = c.wg * 8 + c.wave, ngw = c.nwg * 8;
    for (int r = gw; r < rows; r += ngw) {
        const bf16_t* pr = c.P1 + (size_t)r * P1W;
        float s1 = 0.f, s2 = 0.f;
        for (int k = lane_; k < 256; k += 64) { const float v = bf2f(pr[P_CKV + k]); s1 += v * v; }
        for (int k = lane_; k < 384; k += 64) { const float v = bf2f(pr[P_CQ + k]); s2 += v * v; }
        s1 = wave_sum(s1); s2 = wave_sum(s2);
        if (lane_ < 12) c.rowss[(size_t)r * 12 + lane_] = lane_ == 0 ? s1 : (lane_ == 4 ? s2 : 0.f);
    }
}
__device__ __forceinline__ float rowss_kv(const Ctx& c, int row) { const f32x4 a = *(const f32x4*)(c.rowss + (size_t)row * 12); return 1.0f / sqrtf(((a.x + a.y) + (a.z + a.w)) * (1.0f / 256.0f) + EPS); }
__device__ __forceinline__ float rowss_q(const Ctx& c, int row) { const f32x4 a = *(const f32x4*)(c.rowss + (size_t)row * 12 + 4), b = *(const f32x4*)(c.rowss + (size_t)row * 12 + 8);
    return 1.0f / sqrtf((((a.x + a.y) + (a.z + a.w)) + ((b.x + b.y) + (b.z + b.w))) * (1.0f / 384.0f) + EPS); }
__device__ __forceinline__ void naive_mla_q(Ctx& c, int l, int rows) {
    PH_IDS(c);
    const Params* p = c.p;
    const int gw = c.wg * 8 + c.wave, ngw = c.nwg * 8, r = lane_ & 15, q = lane_ >> 4;
    const float* W = p->in[17] + (size_t)l * 384 * 768; const float* gl = p->in[16] + l * 384; const float* gn = p->in[20] + l * 96;
    const int nu = (rows / 16) * 8;
    for (int u = gw; u < nu; u += ngw) {
        const int rt = u / 8, h = u % 8, row0 = rt * 16;
        const float* wp[6];
#pragma unroll
        for (int nb = 0; nb < 6; ++nb) wp[nb] = W + 96 * h + 16 * nb;
        f32x4 acc[6];
#pragma unroll
        for (int nb = 0; nb < 6; ++nb) acc[nb] = (f32x4){0.f, 0.f, 0.f, 0.f};
        naive_tile<6>(c.P1 + P_CQ, P1W, 384, row0, wp, 768, gl, acc, lane_);
#pragma unroll
        for (int i = 0; i < 4; ++i) {
            const int row = row0 + q * 4 + i; const float rq = rowss_q(c, row);
            float ss = 0.f;
#pragma unroll
            for (int nb = 0; nb < 6; ++nb) { acc[nb][i] *= rq; ss += acc[nb][i] * acc[nb][i]; }
            ss = quad16_sum(ss);
            const float rstd = 1.0f / sqrtf(ss * (1.0f / 96.0f) + EPS);
            bf16_t* o = c.QC + (size_t)row * 768 + 96 * h;
#pragma unroll
            for (int nb = 0; nb < 6; ++nb) { const int d = nb * 16 + r; float v = acc[nb][i] * rstd * gn[d];
                const float pr = __shfl_xor(v, 1);
                if (nb >= 4 && row < NLAT) { const int s = row & 2047, pi = (d - 64) >> 1; const float cs = c.rope_c[(s * 16 + pi) * 2], sn = c.rope_c[(s * 16 + pi) * 2 + 1];
                    v = (d & 1) ? (pr * sn + v * cs) : (v * cs - pr * sn); }
                o[d] = f2bf(v * QSC96); }
        }
    }
}
__device__ __forceinline__ void naive_mla_kv(Ctx& c, int l, int rows) {
    PH_IDS(c);
    const Params* p = c.p;
    const int gw = c.wg * 8 + c.wave, ngw = c.nwg * 8, r = lane_ & 15, q = lane_ >> 4;
    const float* W = p->in[19] + (size_t)l * 256 * 1024; const float* gl = p->in[18] + l * 256; const float* gn = p->in[21] + l * 96;
    const int nu = (rows / 16) * 8;
    for (int u = gw; u < nu; u += ngw) {
        const int rt = u / 8, h = u % 8, row0 = rt * 16;
        const float* wp[8];
#pragma unroll
        for (int nb = 0; nb < 8; ++nb) wp[nb] = W + 128 * h + 16 * nb;
        f32x4 acc[8];
#pragma unroll
        for (int nb = 0; nb < 8; ++nb) acc[nb] = (f32x4){0.f, 0.f, 0.f, 0.f};
        naive_tile<8>(c.P1 + P_CKV, P1W, 256, row0, wp, 1024, gl, acc, lane_);
#pragma unroll
        for (int i = 0; i < 4; ++i) {
            const int row = row0 + q * 4 + i; const float rk = rowss_kv(c, row);
            const float kr0 = bf2f(c.P1[(size_t)row * P1W + P_CKR + r]), kr1 = bf2f(c.P1[(size_t)row * P1W + P_CKR + 16 + r]);
            float ss = kr0 * kr0 + kr1 * kr1;
#pragma unroll
            for (int nb = 0; nb < 4; ++nb) { acc[nb][i] *= rk; ss += acc[nb][i] * acc[nb][i]; }
            ss = quad16_sum(ss);
            const float rstd = 1.0f / sqrtf(ss * (1.0f / 96.0f) + EPS);
            bf16_t* o = c.KC + (size_t)row * 768 + 96 * h;
#pragma unroll
            for (int nb = 0; nb < 4; ++nb) { const int d = nb * 16 + r; o[d] = f2bf(acc[nb][i] * rstd * gn[d]); }
#pragma unroll
            for (int nb = 0; nb < 2; ++nb) { const int d = 64 + nb * 16 + r; float v = (nb == 0 ? kr0 : kr1) * rstd * gn[d];
                const float pr = __shfl_xor(v, 1);
                if (row < NLAT) { const int s = row & 2047, pi = (d - 64) >> 1; const float cs = c.rope_c[(s * 16 + pi) * 2], sn = c.rope_c[(s * 16 + pi) * 2 + 1];
                    v = (d & 1) ? (pr * sn + v * cs) : (v * cs - pr * sn); }
                o[d] = f2bf(v); }
            bf16_t* ov = c.KVR + (size_t)row * 1024 + 128 * h + 64;
#pragma unroll
            for (int nb = 0; nb < 4; ++nb) ov[nb * 16 + r] = f2bf(acc[4 + nb][i] * rk);
        }
    }
}
__device__ __forceinline__ void naive_gates(Ctx& c, int l, int rows) {
    PH_IDS(c);
    const int gw = c.wg * 8 + c.wave, ngw = c.nwg * 8, r = lane_ & 15, q = lane_ >> 4;
    const float* W = c.p->in[10] + (size_t)l * D * INC + O_G;
    const int nu = (rows / 16) * 48;
    for (int u = gw; u < nu; u += ngw) {
        const int rt = u / 48, cg = u % 48, row0 = rt * 16, c0 = cg * 64;
        const float* wp[4] = {W + c0, W + c0 + 16, W + c0 + 32, W + c0 + 48};
        f32x4 acc[4];
#pragma unroll
        for (int nb = 0; nb < 4; ++nb) acc[nb] = (f32x4){0.f, 0.f, 0.f, 0.f};
        naive_tile<4>(c.H, D, D, row0, wp, INC, nullptr, acc, lane_);
#pragma unroll
        for (int i = 0; i < 4; ++i)
#pragma unroll
            for (int nb = 0; nb < 4; ++nb) c.G[(size_t)(row0 + q * 4 + i) * 3072 + c0 + nb * 16 + r] = f2bf(sigmoidf_(acc[nb][i]));
    }
}
__device__ __forceinline__ void naive_merge(Ctx& c, int l, int rows) {
    PH_IDS(c);
    const Params* p = c.p;
    const int gw = c.wg * 8 + c.wave, ngw = c.nwg * 8, r = lane_ & 15, q = lane_ >> 4;
    const int nu = (rows / 16) * 16;
    for (int u = gw; u < nu; u += ngw) {
        const int rt = u / 16, cg = u % 16, row0 = rt * 16, c0 = cg * 64;
        float tot[4][4];
#pragma unroll
        for (int nb = 0; nb < 4; ++nb)
#pragma unroll
            for (int i = 0; i < 4; ++i) tot[nb][i] = 0.f;
#pragma unroll
        for (int br = 0; br < 3; ++br) {
            const float* W = p->in[22 + br] + (size_t)l * 512 * D;
            const float* wp[4] = {W + c0, W + c0 + 16, W + c0 + 32, W + c0 + 48};
            f32x4 acc[4];
#pragma unroll
            for (int nb = 0; nb < 4; ++nb) acc[nb] = (f32x4){0.f, 0.f, 0.f, 0.f};
            const bf16_t* A = br == 0 ? c.P1 + P_QA : (br == 1 ? c.P1 + P_QB : c.YC);
            naive_tile<4>(A, br == 2 ? 512 : P1W, 512, row0, wp, D, nullptr, acc, lane_);
#pragma unroll
            for (int i = 0; i < 4; ++i)
#pragma unroll
                for (int nb = 0; nb < 4; ++nb) tot[nb][i] += bf2f(c.G[(size_t)(row0 + q * 4 + i) * 3072 + br * 1024 + c0 + nb * 16 + r]) * acc[nb][i];
        }
#pragma unroll
        for (int i = 0; i < 4; ++i)
#pragma unroll
            for (int nb = 0; nb < 4; ++nb) c.H[(size_t)(row0 + q * 4 + i) * D + c0 + nb * 16 + r] = f2bf(tot[nb][i]);
    }
}

template <int DQK>
__device__ __forceinline__ void naive_attn_keys(const bf16_t* Kb, int kpitch, const bf16_t* Vb, int vpitch, int k_lo, int k_hi, int srow, int window, const float (&qv)[DQK], float& m, float& l, float (&o)[64]) {
    for (int j = k_lo; j < k_hi; ++j) {
        const bf16_t* kr = Kb + (size_t)j * kpitch;
        float s = 0.f;
#pragma unroll
        for (int d8 = 0; d8 < DQK / 8; ++d8) { const bf16x8 kk = *(const bf16x8*)(kr + d8 * 8);
#pragma unroll
            for (int e = 0; e < 8; ++e) s += qv[d8 * 8 + e] * bf2f((bf16_t)kk[e]); }
        const bool ok = window < 0 || (j - srow <= window && srow - j <= window);
        if (ok) {
            const float mn = fmaxf(m, s); const float f = exp2f(m - mn), pp = exp2f(s - mn);
            l = l * f + pp; m = mn;
            const bf16_t* vr = Vb + (size_t)j * vpitch;
#pragma unroll
            for (int d8 = 0; d8 < 8; ++d8) { const bf16x8 vv = *(const bf16x8*)(vr + d8 * 8);
#pragma unroll
                for (int e = 0; e < 8; ++e) o[d8 * 8 + e] = o[d8 * 8 + e] * f + pp * bf2f((bf16_t)vv[e]); }
        }
    }
}
__device__ __forceinline__ void naive_attn(Ctx& c, int l, int row_lo, int row_hi) {
    PH_IDS(c);
    const Params* p = c.p;
    const int gw = c.wg * 8 + c.wave, ngw = c.nwg * 8;
    const int nrw = (row_hi - row_lo) / 64;
    for (int u = gw; u < nrw * 24; u += ngw) {
        const int br = u / (nrw * 8), rem = u % (nrw * 8), h = rem / nrw, rw = rem % nrw;
        const int row = row_lo + rw * 64 + lane_;
        const bool lat = row < NLAT; const int b = lat ? (row >> 11) : ((row - NLAT) >> 8); const int s = row & 2047;
        const int crow0 = NLAT + b * CTXL, lrow0 = b * SEQ;
        float o[64];
#pragma unroll
        for (int d = 0; d < 64; ++d) o[d] = 0.f;
        float m = -1e30f, lsum = 0.f;
        if (br == 2) {
            float qv[96];
            const bf16_t* qp = c.QC + (size_t)row * 768 + 96 * h;
#pragma unroll
            for (int d8 = 0; d8 < 12; ++d8) { const bf16x8 t = *(const bf16x8*)(qp + d8 * 8);
#pragma unroll
                for (int e = 0; e < 8; ++e) qv[d8 * 8 + e] = bf2f((bf16_t)t[e]); }
            naive_attn_keys<96>(c.KC + (size_t)crow0 * 768 + 96 * h, 768, c.KVR + (size_t)crow0 * 1024 + 128 * h + 64, 1024, 0, CTXL, 0, -1, qv, m, lsum, o);
            if (lat) naive_attn_keys<96>(c.KC + (size_t)lrow0 * 768 + 96 * h, 768, c.KVR + (size_t)lrow0 * 1024 + 128 * h + 64, 1024, 0, SEQ, 0, -1, qv, m, lsum, o);
            const float inv = 1.0f / lsum; bf16_t* op = c.YC + (size_t)row * 512 + 64 * h;
#pragma unroll
            for (int d8 = 0; d8 < 8; ++d8) { u32x4 w; w.x = pk2(o[d8 * 8] * inv, o[d8 * 8 + 1] * inv); w.y = pk2(o[d8 * 8 + 2] * inv, o[d8 * 8 + 3] * inv); w.z = pk2(o[d8 * 8 + 4] * inv, o[d8 * 8 + 5] * inv); w.w = pk2(o[d8 * 8 + 6] * inv, o[d8 * 8 + 7] * inv); *(u32x4*)(op + d8 * 8) = w; }
        } else {
            float qv[64];
            const int qoff = br == 0 ? P_QA : P_QB, koff = (br == 0 ? P_KA : P_KB) + 64 * (h >> 2), voff = (br == 0 ? P_VA : P_VB) + 64 * (h >> 2);
            bf16_t* qp = c.P1 + (size_t)row * P1W + qoff + 64 * h;
#pragma unroll
            for (int d8 = 0; d8 < 8; ++d8) { const bf16x8 t = *(const bf16x8*)(qp + d8 * 8);
#pragma unroll
                for (int e = 0; e < 8; ++e) qv[d8 * 8 + e] = bf2f((bf16_t)t[e]); }
            if (br == 0) { m = p->in[13][l * 8 + h] * LOG2E; lsum = 1.0f; }
            naive_attn_keys<64>(c.P1 + (size_t)crow0 * P1W + koff, P1W, c.P1 + (size_t)crow0 * P1W + voff, P1W, 0, CTXL, 0, -1, qv, m, lsum, o);
            if (lat) {
                if (br == 0) { const int s0 = __builtin_amdgcn_readfirstlane(s) & ~63; const int klo = s0 - 128 < 0 ? 0 : s0 - 128, khi = s0 + 63 + 128 + 1 > SEQ ? SEQ : s0 + 63 + 128 + 1;
                    naive_attn_keys<64>(c.P1 + (size_t)lrow0 * P1W + koff, P1W, c.P1 + (size_t)lrow0 * P1W + voff, P1W, klo, khi, s, 128, qv, m, lsum, o); }
                else naive_attn_keys<64>(c.P1 + (size_t)lrow0 * P1W + koff, P1W, c.P1 + (size_t)lrow0 * P1W + voff, P1W, 0, SEQ, 0, -1, qv, m, lsum, o);
            }
            const float inv = 1.0f / lsum;
#pragma unroll
            for (int d8 = 0; d8 < 8; ++d8) { u32x4 w; w.x = pk2(o[d8 * 8] * inv, o[d8 * 8 + 1] * inv); w.y = pk2(o[d8 * 8 + 2] * inv, o[d8 * 8 + 3] * inv); w.z = pk2(o[d8 * 8 + 4] * inv, o[d8 * 8 + 5] * inv); w.w = pk2(o[d8 * 8 + 6] * inv, o[d8 * 8 + 7] * inv); *(u32x4*)(qp + d8 * 8) = w; }
        }
    }
}

constexpr size_t WO_F1IN = 0;
constexpr size_t WO_F1OUT = WO_F1IN + (size_t)5632 * 1024 * 2;
constexpr size_t WO_F2IN = WO_F1OUT + (size_t)1024 * 2816 * 2;
constexpr size_t WO_F2OUT = WO_F2IN + (size_t)5632 * 1024 * 2;
constexpr size_t WO_P1 = WO_F2OUT + (size_t)1024 * 2816 * 2;
constexpr size_t WO_G = WO_P1 + (size_t)2304 * 1024 * 2;
constexpr size_t WO_UQ = WO_G + (size_t)3072 * 1024 * 2;
constexpr size_t WO_UKV = WO_UQ + (size_t)768 * 384 * 2;
constexpr size_t WO_BR = WO_UKV + (size_t)1024 * 256 * 2;
constexpr size_t WO_OUT = WO_BR + (size_t)3 * 1024 * 512 * 2;
constexpr size_t WO_END = WO_OUT + (size_t)1024 * 1024 * 2;
static_assert(WO_END <= 52u * 1024 * 1024, "weight region");
#define LAS __attribute__((address_space(3)))
#define GAS __attribute__((address_space(1)))

__device__ __forceinline__ void conv_item(const float* W, int ldw, int K, int srccol, const float* kgain, bf16_t* WT, int dstrow0, int k0, LAS float* scr, int lane) {
    if (srccol >= 0) {
#pragma unroll 8
        for (int i = 0; i < 32; ++i) { const int kk = 2 * i + (lane >> 5); float v = W[(size_t)(k0 + kk) * ldw + srccol + (lane & 31)]; if (kgain) v *= kgain[k0 + kk]; scr[kk * 33 + (lane & 31)] = v; }
    } else {
#pragma unroll 8
        for (int i = 0; i < 32; ++i) { const int kk = 2 * i + (lane >> 5); scr[kk * 33 + (lane & 31)] = 0.f; }
    }
    asm volatile("s_waitcnt lgkmcnt(0)" ::: "memory");
    const int cidx = lane & 7;
#pragma unroll
    for (int j = 0; j < 4; ++j) { const int n = (lane >> 3) + 8 * j; const LAS float* sp = scr + (8 * cidx) * 33 + n;
        u32x4 o; o.x = pk2(sp[0 * 33], sp[1 * 33]); o.y = pk2(sp[2 * 33], sp[3 * 33]); o.z = pk2(sp[4 * 33], sp[5 * 33]); o.w = pk2(sp[6 * 33], sp[7 * 33]);
        *(u32x4*)(WT + (size_t)(dstrow0 + n) * K + k0 + 8 * cidx) = o; }
    asm volatile("s_waitcnt lgkmcnt(0)" ::: "memory");
}
__device__ __forceinline__ int p1_srccol(int nb) {
    const int t = nb >> 3, p32 = nb & 7;
    const int Lh = 64 * (p32 & 3) + 32 * (p32 >> 2), Lr = 32 * p32;
    switch (t) {
    case 0: return Lh < 128 ? O_AK + Lh : O_AV + (Lh - 128);
    case 1: return Lh < 128 ? O_BK + Lh : O_BV + (Lh - 128);
    case 2: return O_CKV + Lr;
    case 3: return O_CQ + Lr;
    case 4: return Lr < 128 ? O_CQ + 256 + Lr : (Lr == 128 ? O_CKR : -1);
    case 5: case 6: return O_AQ + 256 * (t - 5) + Lh;
    default: return O_BQ + 256 * (t - 7) + Lh;
    }
}
__device__ __forceinline__ void phase_convert(Ctx& c, int l, unsigned char* lds) {
    PH_IDS(c);
    const Params* p = c.p;
    LAS float* scr = (LAS float*)((LAS unsigned char*)lds + c.wave * 16384);
    unsigned char* wb = c.ws + WS_W;
    const int gw = c.wg * 8 + c.wave, ngw = c.nwg * 8;
    constexpr int NIT[12] = {16 * 176, 44 * 32, 16 * 176, 44 * 32, 16 * 72, 16 * 96, 6 * 24, 4 * 32, 8 * 32, 8 * 32, 8 * 32, 16 * 32};
    int total = 0;
#pragma unroll
    for (int i = 0; i < 12; ++i) total += NIT[i];
    for (int it = gw; it < total; it += ngw) {
        int r = it, mi = 0;
#pragma unroll
        for (int i = 0; i < 11; ++i) if (mi == i && r >= NIT[i]) { r -= NIT[i]; mi = i + 1; }
        const float* W; int ldw, K, nblk; bf16_t* WT; const float* kg = nullptr;
        switch (mi) {
        case 0: W = p->in[7] + (size_t)l * D * 2 * DFF; ldw = 2 * DFF; K = D; nblk = 176; WT = (bf16_t*)(wb + WO_F1IN); break;
        case 1: W = p->in[8] + (size_t)l * DFF * D; ldw = D; K = DFF; nblk = 32; WT = (bf16_t*)(wb + WO_F1OUT); break;
        case 2: W = p->in[27] + (size_t)l * D * 2 * DFF; ldw = 2 * DFF; K = D; nblk = 176; WT = (bf16_t*)(wb + WO_F2IN); break;
        case 3: W = p->in[28] + (size_t)l * DFF * D; ldw = D; K = DFF; nblk = 32; WT = (bf16_t*)(wb + WO_F2OUT); break;
        case 4: W = p->in[10] + (size_t)l * D * INC; ldw = INC; K = D; nblk = 72; WT = (bf16_t*)(wb + WO_P1); break;
        case 5: W = p->in[10] + (size_t)l * D * INC; ldw = INC; K = D; nblk = 96; WT = (bf16_t*)(wb + WO_G); break;
        case 6: W = p->in[17] + (size_t)l * 384 * 768; ldw = 768; K = 384; nblk = 24; WT = (bf16_t*)(wb + WO_UQ); kg = p->in[16] + l * 384; break;
        case 7: W = p->in[19] + (size_t)l * 256 * 1024; ldw = 1024; K = 256; nblk = 32; WT = (bf16_t*)(wb + WO_UKV); kg = p->in[18] + l * 256; break;
        case 8: case 9: case 10: W = p->in[22 + (mi - 8)] + (size_t)l * 512 * D; ldw = D; K = 512; nblk = 32; WT = (bf16_t*)(wb + WO_BR) + (size_t)(mi - 8) * 1024 * 512; break;
        default: W = p->in[25] + (size_t)l * D * D; ldw = D; K = D; nblk = 32; WT = (bf16_t*)(wb + WO_OUT); break;
        }
        const int kb = r / nblk, nb = r % nblk;
        int sc;
        if (mi == 0 || mi == 2) { const int j = nb >> 3, w = nb & 7; sc = w < 4 ? 128 * j + 32 * w : DFF + 128 * j + 32 * (w - 4); }
        else if (mi == 4) sc = p1_srccol(nb);
        else if (mi == 5) sc = O_G + 32 * nb;
        else sc = 32 * nb;
        conv_item(W, ldw, K, sc, kg, WT, 32 * nb, 64 * kb, scr, lane_);
    }
}

namespace pg8 {
constexpr int BM = 256, BK = 64, HALF = 128, HTB = HALF * BK * 2, STAGE_BYTES = 8 * HTB, NXCD = 8, WGM = 8;
__host__ __device__ __forceinline__ int lds_byte(int r, int c) { const int st = (r >> 4) * 2 + (c >> 5), rr = r & 15, cc = c & 31, ob = rr * 64 + cc * 2; return st * 1024 + (ob ^ (((ob >> 9) & 1) << 5)); }
__host__ __device__ __forceinline__ void stage_rc(int b, int& R, int& C) { const int st = b / 1024, sb = b % 1024, swz = sb ^ (((sb >> 9) & 1) << 5); R = (st >> 1) * 16 + swz / 64; C = (st & 1) * 32 + (swz % 64) / 2; }
__host__ __device__ __forceinline__ int perm32(int rho) { const int n = rho >> 4, i = rho & 15; return 8 * (i >> 2) + 4 * n + (i & 3); }
struct Unit { int pm, pn; };
struct Gemm { const bf16_t* A; const bf16_t* Bt; int M, N, K, lda; };
struct StaticOrder {
    int nM, nN, nwg, G, c;
    __device__ void init(int M, int N, int G_, int c_) { nM = M / BM; nN = N / BM; nwg = nM * nN; G = G_; c = c_; }
    __device__ bool next(int i, Unit& u) const {
        const long L = (long)i * G + c; if (L >= nwg) return false;
        int wgid = (int)L; { const int q = nwg / NXCD, r = nwg % NXCD, xcd = wgid % NXCD, off = wgid / NXCD; wgid = (xcd < r ? xcd * (q + 1) : r * (q + 1) + (xcd - r) * q) + off; }
        const int nig = WGM * nN, gid = wgid / nig, fm = gid * WGM, gsz = (nM - fm) < WGM ? (nM - fm) : WGM;
        u.pm = fm + ((wgid % nig) % gsz); u.pn = (wgid % nig) / gsz; return true;
    }
};
typedef float f32x2_t __attribute__((ext_vector_type(2))); typedef __bf16 bf16x2_t __attribute__((ext_vector_type(2)));
__device__ __forceinline__ unsigned cvt_pk_bf16(float lo, float hi) { f32x2_t v = {lo, hi}; bf16x2_t b = __builtin_convertvector(v, bf16x2_t); return __builtin_bit_cast(unsigned, b); }
__device__ __forceinline__ u32x4 pack8(const f32x4& a, const f32x4& b) { u32x4 w; w.x = cvt_pk_bf16(a[0], a[1]); w.y = cvt_pk_bf16(a[2], a[3]); w.z = cvt_pk_bf16(b[0], b[1]); w.w = cvt_pk_bf16(b[2], b[3]); return w; }
__device__ __forceinline__ float fast_sigmoid(float v) { return __builtin_amdgcn_rcpf(1.0f + __builtin_amdgcn_exp2f(-LOG2E * v)); }

typedef f32x4 Acc[2][2][4][2];

template <class Epi, class Sched, bool ALIGN_EPI>
__device__ __forceinline__ void gemm_phase(LAS unsigned char* lds, int wave, const Gemm g, const Sched& S, const Epi& E) {
    const int lane = lane_id(), wid = wave, tid = wid * 64 + lane, wr = wid >> 2, wc = wid & 3, fr = lane & 15, fq = lane >> 4;
    const int K = g.K, nt = K / BK, lda = g.lda;
    unsigned voffA[2], voffB[2];
#pragma unroll
    for (int i = 0; i < 2; ++i) { int R, C; stage_rc(tid * 16 + i * 8192, R, C); const int Rb = Epi::PERM ? ((R & ~31) + perm32(R & 31)) : R;
        voffA[i] = (unsigned)(R * lda + C) * 2u; voffB[i] = (unsigned)(Rb * K + C) * 2u; }
    const size_t kstep = (size_t)(BK * 2);
    const size_t hstepA = (size_t)HALF * lda * 2, hstepB = (size_t)HALF * K * 2;
    const size_t tstepA = 2 * hstepA, tstepB = 2 * hstepB;
    const unsigned ldsw = (unsigned)wid * 1024u;
    const int aoff = lds_byte(wr * 64 + fr, fq * 8), boff = lds_byte(wc * 32 + fr, fq * 8);
#define PG8_SA(b, h) (((b) * 2 + (h)) * HTB)
#define PG8_SB(b, h) ((4 + (b) * 2 + (h)) * HTB)
#define PG8_STAGE(bufoff, gbase, voff) do { _Pragma("unroll") for (int _i = 0; _i < 2; ++_i) \
        __builtin_amdgcn_global_load_lds((const unsigned*)((const char*)(gbase) + (voff)[_i]), (LAS unsigned*)(lds + (bufoff) + ldsw + _i * 8192), 16, 0, 0); } while (0)
#define PG8_LDA(dst, b, h) do { _Pragma("unroll") for (int m = 0; m < 4; ++m) _Pragma("unroll") for (int k = 0; k < 2; ++k) dst[m][k] = *(const LAS bf16x8*)(lds + PG8_SA(b, h) + aoff + m * 2048 + k * 1024); } while (0)
#define PG8_LDB(dst, b, h) do { _Pragma("unroll") for (int n = 0; n < 2; ++n) _Pragma("unroll") for (int k = 0; k < 2; ++k) dst[n][k] = *(const LAS bf16x8*)(lds + PG8_SB(b, h) + boff + n * 2048 + k * 1024); } while (0)
#define PG8_MMA(ai, bj, At, Bt) do { __builtin_amdgcn_s_setprio(1); _Pragma("unroll") for (int m = 0; m < 4; ++m) _Pragma("unroll") for (int n = 0; n < 2; ++n) _Pragma("unroll") for (int k = 0; k < 2; ++k) \
        acc[ai][bj][m][n] = __builtin_amdgcn_mfma_f32_16x16x32_bf16(Bt[n][k], At[m][k], acc[ai][bj][m][n], 0, 0, 0); __builtin_amdgcn_s_setprio(0); } while (0)
#define PG8_WAIT_V(n) asm volatile("s_waitcnt vmcnt(" #n ")" ::: "memory")
#define PG8_WAIT_L(n) asm volatile("s_waitcnt lgkmcnt(" #n ")" ::: "memory")
#define PG8_BAR __builtin_amdgcn_s_barrier()
#define PG8_SCHED __builtin_amdgcn_sched_barrier(0)
    Unit cur, nxt; int ui = 0;
    if (!S.next(0, cur)) return;
    Acc acc;
#pragma unroll
    for (int a = 0; a < 2; ++a)
#pragma unroll
        for (int b = 0; b < 2; ++b)
#pragma unroll
            for (int m = 0; m < 4; ++m)
#pragma unroll
                for (int n = 0; n < 2; ++n) acc[a][b][m][n] = (f32x4){0.f, 0.f, 0.f, 0.f};
    bf16x8 At[4][2], B0[2][2], B1[2][2];
    const char* cA = (const char*)g.A + (size_t)cur.pm * tstepA; const char* cB = (const char*)g.Bt + (size_t)cur.pn * tstepB;
    PG8_STAGE(PG8_SB(0, 0), cB, voffB); PG8_STAGE(PG8_SB(0, 1), cB + hstepB, voffB); PG8_STAGE(PG8_SA(0, 0), cA, voffA); PG8_STAGE(PG8_SA(0, 1), cA + hstepA, voffA);
    if (wr == 1) PG8_BAR;
    PG8_WAIT_V(2); PG8_BAR;
    PG8_STAGE(PG8_SB(1, 0), cB + kstep, voffB); PG8_STAGE(PG8_SA(1, 0), cA + kstep, voffA); PG8_STAGE(PG8_SB(1, 1), cB + hstepB + kstep, voffB);
    PG8_WAIT_V(6); PG8_BAR;
    for (;;) {
        const bool has_next = S.next(ui + 1, nxt);
        const char* nA = has_next ? (const char*)g.A + (size_t)nxt.pm * tstepA : cA; const char* nB = has_next ? (const char*)g.Bt + (size_t)nxt.pn * tstepB : cB;
#pragma unroll 1
        for (int t = 0; t < nt; t += 2) {
            const bool last = (t == nt - 2);
            const char* a1 = cA + (size_t)(t + 1) * kstep;
            const char* a2 = last ? nA : cA + (size_t)(t + 2) * kstep; const char* b2 = last ? nB : cB + (size_t)(t + 2) * kstep;
            const char* a3 = a2 + kstep; const char* b3 = b2 + kstep;
            PG8_LDB(B0, 0, 0); PG8_LDB(B1, 0, 1); PG8_SCHED; PG8_LDA(At, 0, 0); PG8_STAGE(PG8_SA(1, 1), a1 + hstepA, voffA);
            PG8_WAIT_V(8); PG8_WAIT_L(0); PG8_BAR; PG8_MMA(0, 0, At, B0); PG8_MMA(0, 1, At, B1); PG8_BAR; PG8_SCHED;
            PG8_LDA(At, 0, 1); PG8_STAGE(PG8_SB(0, 0), b2, voffB); PG8_STAGE(PG8_SB(0, 1), b2 + hstepB, voffB); PG8_STAGE(PG8_SA(0, 0), a2, voffA);
            PG8_WAIT_V(8); PG8_WAIT_L(0); PG8_BAR; PG8_MMA(1, 0, At, B0); PG8_MMA(1, 1, At, B1); PG8_BAR; PG8_SCHED;
            PG8_LDB(B0, 1, 0); PG8_LDB(B1, 1, 1); PG8_SCHED; PG8_LDA(At, 1, 0); PG8_STAGE(PG8_SA(0, 1), a2 + hstepA, voffA);
            PG8_WAIT_V(8); PG8_WAIT_L(0); PG8_BAR; PG8_MMA(0, 0, At, B0); PG8_MMA(0, 1, At, B1); PG8_BAR; PG8_SCHED;
            PG8_LDA(At, 1, 1); PG8_STAGE(PG8_SB(1, 0), b3, voffB); PG8_STAGE(PG8_SB(1, 1), b3 + hstepB, voffB); PG8_STAGE(PG8_SA(1, 0), a3, voffA);
            PG8_WAIT_V(8); PG8_WAIT_L(0); PG8_BAR; PG8_MMA(1, 0, At, B0); PG8_MMA(1, 1, At, B1); PG8_BAR; PG8_SCHED;
        }
        if constexpr (ALIGN_EPI) { if (wr == 0) PG8_BAR; }
        { int fr_ = fr, fq_ = fq; asm volatile("" : "+v"(fr_), "+v"(fq_));
          E(acc, cur, wr, wc, fr_, fq_); }
        if (!has_next) break;
#pragma unroll
        for (int a = 0; a < 2; ++a)
#pragma unroll
            for (int b = 0; b < 2; ++b)
#pragma unroll
                for (int m = 0; m < 4; ++m)
#pragma unroll
                    for (int n = 0; n < 2; ++n) acc[a][b][m][n] = (f32x4){0.f, 0.f, 0.f, 0.f};
        cur = nxt; cA = nA; cB = nB; ++ui;
        if constexpr (ALIGN_EPI) { if (wr == 1) PG8_BAR; }
    }
    PG8_WAIT_V(0);
    if constexpr (!ALIGN_EPI) { if (wr == 0) PG8_BAR; }
    PG8_BAR;
#undef PG8_SA
#undef PG8_SB
#undef PG8_STAGE
#undef PG8_LDA
#undef PG8_LDB
#undef PG8_MMA
#undef PG8_WAIT_V
#undef PG8_WAIT_L
#undef PG8_BAR
#undef PG8_SCHED
}

struct EpiSwiGLU {
    static constexpr bool PERM = true;
    bf16_t* ACT;
    __device__ __forceinline__ void operator()(const Acc& acc, const Unit& u, int wr, int wc, int fr, int fq) const {
        const int row0 = u.pm * BM + wr * 64 + fr, col0 = u.pn * 128 + wc * 32 + 8 * fq;
#pragma unroll
        for (int ai = 0; ai < 2; ++ai)
#pragma unroll
            for (int m = 0; m < 4; ++m) {
                f32x4 o[2];
#pragma unroll
                for (int n = 0; n < 2; ++n) { const f32x4 gt = acc[ai][0][m][n], up = acc[ai][1][m][n];
#pragma unroll
                    for (int e = 0; e < 4; ++e) o[n][e] = gt[e] * fast_sigmoid(gt[e]) * up[e]; }
                *(u32x4*)(ACT + (size_t)(row0 + ai * HALF + m * 16) * DFF + col0) = pack8(o[0], o[1]);
            }
    }
};
struct EpiRes {
    static constexpr bool PERM = false;
    const float* base_lat; const float* base_ctx; float* out_lat; float* out_ctx; const float* modl; int gi; float coef;
    __device__ __forceinline__ void operator()(const Acc& acc, const Unit& u, int wr, int wc, int fr, int fq) const {
        const bool lat = u.pm < NLAT / BM; const int pmr = lat ? u.pm : u.pm - NLAT / BM;
        const float* bp = (lat ? base_lat : base_ctx) + (size_t)pmr * BM * D; float* op = (lat ? out_lat : out_ctx) + (size_t)pmr * BM * D;
        const float* md = modl + (size_t)(lat ? (u.pm >> 3) : 8) * MODW + gi * D;
        const int col0 = u.pn * BM + wc * 32 + 4 * fq;
        f32x4 mv[2][2];
#pragma unroll
        for (int bj = 0; bj < 2; ++bj)
#pragma unroll
            for (int n = 0; n < 2; ++n) mv[bj][n] = *(const f32x4*)(md + col0 + bj * HALF + n * 16) * coef;
#pragma unroll
        for (int ai = 0; ai < 2; ++ai)
#pragma unroll
            for (int m = 0; m < 4; ++m) { const size_t off = (size_t)(ai * HALF + wr * 64 + m * 16 + fr) * D + col0;
#pragma unroll
                for (int bj = 0; bj < 2; ++bj)
#pragma unroll
                    for (int n = 0; n < 2; ++n) { const f32x4 bs = *(const f32x4*)(bp + off + bj * HALF + n * 16); *(f32x4*)(op + off + bj * HALF + n * 16) = bs + mv[bj][n] * acc[ai][bj][m][n]; }
                if (m & 1) asm volatile("" ::: "memory"); }
    }
};
struct EpiInProj {
    static constexpr bool PERM = true;
    bf16_t* P1; float* rowss; const float* rope; const float* gqa; const float* gka; const float* gqb; const float* gkb;
    __device__ __forceinline__ void operator()(const Acc& acc, const Unit& u, int wr, int wc, int fr, int fq) const {
        const int pn = u.pn; const bool lat = u.pm < NLAT / BM;
        const int row0 = u.pm * BM + wr * 64 + fr;
        if (pn >= 2 && pn <= 4) {
            const int dstc = (pn == 2 ? P_CKV : (pn == 3 ? P_CQ : P_CQ + 256)) + wc * 32 + 8 * fq;
#pragma unroll
            for (int ai = 0; ai < 2; ++ai)
#pragma unroll
                for (int m = 0; m < 4; ++m) { const int row = row0 + ai * HALF + m * 16; float ss = 0.f;
#pragma unroll
                    for (int bj = 0; bj < 2; ++bj) { const f32x4 v0 = acc[ai][bj][m][0], v1 = acc[ai][bj][m][1];
                        *(u32x4*)(P1 + (size_t)row * P1W + dstc + bj * HALF) = pack8(v0, v1);
                        if (bj == 0 || pn != 4) ss += ((v0[0] * v0[0] + v0[1] * v0[1]) + (v0[2] * v0[2] + v0[3] * v0[3])) + ((v1[0] * v1[0] + v1[1] * v1[1]) + (v1[2] * v1[2] + v1[3] * v1[3])); }
                    ss += __shfl_xor(ss, 16); ss += __shfl_xor(ss, 32);
                    if (fq == 0) rowss[(size_t)row * 12 + (pn - 2) * 4 + wc] = ss; }
            return;
        }
        int dst; const float* gn = nullptr; float qs = 1.0f;
        if (pn == 0) { if (wc < 2) { dst = P_KA + 64 * wc; gn = gka; } else dst = P_VA + 64 * (wc - 2); }
        else if (pn == 1) { if (wc < 2) { dst = P_KB + 64 * wc; gn = gkb; } else dst = P_VB + 64 * (wc - 2); }
        else if (pn <= 6) { dst = P_QA + 64 * (4 * (pn - 5) + wc); gn = gqa; qs = QSC64; }
        else { dst = P_QB + 64 * (4 * (pn - 7) + wc); gn = gqb; qs = QSC64; }
        dst += 8 * fq;
        if (gn == nullptr) {
#pragma unroll
            for (int ai = 0; ai < 2; ++ai)
#pragma unroll
                for (int m = 0; m < 4; ++m) { const int row = row0 + ai * HALF + m * 16;
#pragma unroll
                    for (int bj = 0; bj < 2; ++bj) *(u32x4*)(P1 + (size_t)row * P1W + dst + 32 * bj) = pack8(acc[ai][bj][m][0], acc[ai][bj][m][1]); }
            return;
        }
        f32x4 gv[2][2];
#pragma unroll
        for (int bj = 0; bj < 2; ++bj)
#pragma unroll
            for (int n = 0; n < 2; ++n) gv[bj][n] = *(const f32x4*)(gn + 32 * bj + 8 * fq + 4 * n) * qs;
#pragma unroll
        for (int ai = 0; ai < 2; ++ai)
#pragma unroll
            for (int m = 0; m < 4; ++m) { const int row = row0 + ai * HALF + m * 16; float ss = 0.f;
#pragma unroll
                for (int bj = 0; bj < 2; ++bj)
#pragma unroll
                    for (int n = 0; n < 2; ++n) { const f32x4 v = acc[ai][bj][m][n]; ss += (v[0] * v[0] + v[1] * v[1]) + (v[2] * v[2] + v[3] * v[3]); }
                ss += __shfl_xor(ss, 16); ss += __shfl_xor(ss, 32);
                const float rstd = __builtin_amdgcn_rsqf(ss * (1.0f / 64.0f) + EPS);
                const float* rp = rope + (size_t)(row & 2047) * 64;
#pragma unroll
                for (int bj = 0; bj < 2; ++bj) { f32x4 o[2];
#pragma unroll
                    for (int n = 0; n < 2; ++n) { const f32x4 v = acc[ai][bj][m][n] * rstd * gv[bj][n];
                        if (lat) { const f32x4 cs = *(const f32x4*)(rp + (16 * bj + 4 * fq + 2 * n) * 2);
                            o[n][0] = v[0] * cs[0] - v[1] * cs[1]; o[n][1] = v[0] * cs[1] + v[1] * cs[0]; o[n][2] = v[2] * cs[2] - v[3] * cs[3]; o[n][3] = v[2] * cs[3] + v[3] * cs[2]; }
                        else o[n] = v; }
                    *(u32x4*)(P1 + (size_t)row * P1W + dst + 32 * bj) = pack8(o[0], o[1]); }
            }
    }
};
template <int WHICH  > struct EpiMlaUp {
    static constexpr bool PERM = true;
    bf16_t* O; const float* rowss;
    __device__ __forceinline__ void operator()(const Acc& acc, const Unit& u, int wr, int wc, int fr, int fq) const {
        constexpr int PITCH = WHICH == 0 ? 768 : 1024;
        const int row0 = u.pm * BM + wr * 64 + fr, col0 = u.pn * BM + wc * 32 + 8 * fq;
#pragma unroll
        for (int ai = 0; ai < 2; ++ai)
#pragma unroll
            for (int m = 0; m < 4; ++m) { const int row = row0 + ai * HALF + m * 16; float r;
                if (WHICH == 0) { const f32x4 a = *(const f32x4*)(rowss + (size_t)row * 12 + 4), b = *(const f32x4*)(rowss + (size_t)row * 12 + 8); r = __builtin_amdgcn_rsqf((((a.x + a.y) + (a.z + a.w)) + ((b.x + b.y) + (b.z + b.w))) * (1.0f / 384.0f) + EPS); }
                else { const f32x4 a = *(const f32x4*)(rowss + (size_t)row * 12); r = __builtin_amdgcn_rsqf(((a.x + a.y) + (a.z + a.w)) * (1.0f / 256.0f) + EPS); }
#pragma unroll
                for (int bj = 0; bj < 2; ++bj) *(u32x4*)(O + (size_t)row * PITCH + col0 + bj * HALF) = pack8(acc[ai][bj][m][0] * r, acc[ai][bj][m][1] * r);
                asm volatile("" ::: "memory"); }
    }
};
struct EpiSigmoid {
    static constexpr bool PERM = true;
    bf16_t* G;
    __device__ __forceinline__ void operator()(const Acc& acc, const Unit& u, int wr, int wc, int fr, int fq) const {
        const int row0 = u.pm * BM + wr * 64 + fr, col0 = u.pn * BM + wc * 32 + 8 * fq;
#pragma unroll
        for (int ai = 0; ai < 2; ++ai)
#pragma unroll
            for (int m = 0; m < 4; ++m)
#pragma unroll
                for (int bj = 0; bj < 2; ++bj) { f32x4 o[2];
#pragma unroll
                    for (int n = 0; n < 2; ++n)
#pragma unroll
                        for (int e = 0; e < 4; ++e) o[n][e] = fast_sigmoid(acc[ai][bj][m][n][e]);
                    *(u32x4*)(G + (size_t)(row0 + ai * HALF + m * 16) * 3072 + col0 + bj * HALF) = pack8(o[0], o[1]); }
    }
};
template <int Z> struct EpiMerge {
    static constexpr bool PERM = true;
    bf16_t* Mm; const bf16_t* G;
    __device__ __forceinline__ void operator()(const Acc& acc, const Unit& u, int wr, int wc, int fr, int fq) const {
        const int row0 = u.pm * BM + wr * 64 + fr, col0 = u.pn * BM + wc * 32 + 8 * fq;
#pragma unroll
        for (int ai = 0; ai < 2; ++ai)
#pragma unroll
            for (int m = 0; m < 4; ++m)
#pragma unroll
                for (int bj = 0; bj < 2; ++bj) { const size_t row = (size_t)(row0 + ai * HALF + m * 16);
                    const u32x4 gw = *(const u32x4*)(G + row * 3072 + Z * 1024 + col0 + bj * HALF);
                    u32x4 mw = (u32x4){0u, 0u, 0u, 0u}; if (Z > 0) mw = *(const u32x4*)(Mm + row * D + col0 + bj * HALF);
                    f32x4 o[2];
#pragma unroll
                    for (int n = 0; n < 2; ++n)
#pragma unroll
                        for (int e2 = 0; e2 < 2; ++e2) { const unsigned gg = gw[2 * n + e2], mm = mw[2 * n + e2];
                            o[n][2 * e2] = __uint_as_float(mm << 16) + __uint_as_float(gg << 16) * acc[ai][bj][m][n][2 * e2];
                            o[n][2 * e2 + 1] = __uint_as_float(mm & 0xffff0000u) + __uint_as_float(gg & 0xffff0000u) * acc[ai][bj][m][n][2 * e2 + 1]; }
                    *(u32x4*)(Mm + row * D + col0 + bj * HALF) = pack8(o[0], o[1]); }
    }
};
}

__device__ __forceinline__ void phase_mla_norm(Ctx& c, int l, int rows_q, int rows_k) {
    PH_IDS(c);
    const Params* p = c.p;
    const int gw = c.wg * 8 + c.wave, ngw = c.nwg * 8, h = lane_ >> 3, j = lane_ & 7;
    const float* gq = p->in[20] + l * 96 + 12 * j; const float* gk = p->in[21] + l * 96 + 12 * j;
    float gqv[12], gkv[12];
#pragma unroll
    for (int i = 0; i < 12; ++i) { gqv[i] = gq[i] * QSC96; gkv[i] = gk[i]; }
    for (int r = gw; r < rows_k; r += ngw) {
        const bool lat = r < NLAT; const int s = r & 2047;
#pragma unroll
        for (int which = 0; which < 2; ++which) {
            if (which == 0 && r >= rows_q) continue;
            float v[12];
            if (which == 0) { const u32x2* qp = (const u32x2*)(c.QC + (size_t)r * 768 + 96 * h + 12 * j);
#pragma unroll
                for (int i = 0; i < 3; ++i) { const u32x2 w = qp[i]; v[4 * i] = __uint_as_float(w.x << 16); v[4 * i + 1] = __uint_as_float(w.x & 0xffff0000u); v[4 * i + 2] = __uint_as_float(w.y << 16); v[4 * i + 3] = __uint_as_float(w.y & 0xffff0000u); } }
            else {
#pragma unroll
                for (int i = 0; i < 3; ++i) { const int d = 12 * j + 4 * i;
                    const bf16_t* src = d < 64 ? c.KVR + (size_t)r * 1024 + 128 * h + d : c.P1 + (size_t)r * P1W + P_CKR + (d - 64);
                    const u32x2 w = *(const u32x2*)src; v[4 * i] = __uint_as_float(w.x << 16); v[4 * i + 1] = __uint_as_float(w.x & 0xffff0000u); v[4 * i + 2] = __uint_as_float(w.y << 16); v[4 * i + 3] = __uint_as_float(w.y & 0xffff0000u); } }
            float ss = 0.f;
#pragma unroll
            for (int i = 0; i < 12; ++i) ss += v[i] * v[i];
            ss += __shfl_xor(ss, 1); ss += __shfl_xor(ss, 2); ss += __shfl_xor(ss, 4);
            const float rstd = 1.0f / sqrtf(ss * (1.0f / 96.0f) + EPS);
#pragma unroll
            for (int i = 0; i < 12; ++i) v[i] *= rstd * (which == 0 ? gqv[i] : gkv[i]);
            if (lat) {
#pragma unroll
                for (int i = 0; i < 6; ++i) { const int d = 12 * j + 2 * i;
                    if (d >= 64) { const float cs = c.rope_c[(s * 16 + ((d - 64) >> 1)) * 2], sn = c.rope_c[(s * 16 + ((d - 64) >> 1)) * 2 + 1];
                        const float x0 = v[2 * i], x1 = v[2 * i + 1]; v[2 * i] = x0 * cs - x1 * sn; v[2 * i + 1] = x0 * sn + x1 * cs; } }
            }
            u32x2* op = (u32x2*)((which == 0 ? c.QC : c.KC) + (size_t)r * 768 + 96 * h + 12 * j);
#pragma unroll
            for (int i = 0; i < 3; ++i) { u32x2 w; w.x = pk2(v[4 * i], v[4 * i + 1]); w.y = pk2(v[4 * i + 2], v[4 * i + 3]); op[i] = w; }
        }
    }
}

__device__ __forceinline__ void fast_ffn_up(Ctx& c, unsigned char* lds, size_t wo, int rows) {
    pg8::Gemm g{c.H, (const bf16_t*)(c.ws + WS_W + wo), rows, 2 * DFF, D, D}; pg8::StaticOrder S; S.init(rows, 2 * DFF, c.nwg, c.wg);
    pg8::EpiSwiGLU E{c.ACT};
    pg8::gemm_phase<pg8::EpiSwiGLU, pg8::StaticOrder, true>((LAS unsigned char*)lds, c.wave, g, S, E);
}
__device__ __forceinline__ void fast_res(Ctx& c, unsigned char* lds, int l, const bf16_t* A, int K, size_t wo, float coef, int gi, int rows, bool from_input) {
    pg8::Gemm g{A, (const bf16_t*)(c.ws + WS_W + wo), rows, D, K, K}; pg8::StaticOrder S; S.init(rows, D, c.nwg, c.wg);
    pg8::EpiRes E{from_input ? c.p->in[0] : c.p->out, from_input ? c.p->in[2] : c.Z, c.p->out, c.Z, c.mod + (size_t)l * 9 * MODW, gi, coef};
    pg8::gemm_phase<pg8::EpiRes, pg8::StaticOrder, true>((LAS unsigned char*)lds, c.wave, g, S, E);
}
__device__ __forceinline__ void fast_inproj(Ctx& c, unsigned char* lds, int l, int rows) {
    const Params* p = c.p;
    pg8::Gemm g{c.H, (const bf16_t*)(c.ws + WS_W + WO_P1), rows, P1W, D, D}; pg8::StaticOrder S; S.init(rows, P1W, c.nwg, c.wg);
    pg8::EpiInProj E{c.P1, c.rowss, c.rope_hd, p->in[11] + l * 64, p->in[12] + l * 64, p->in[14] + l * 64, p->in[15] + l * 64};
    pg8::gemm_phase<pg8::EpiInProj, pg8::StaticOrder, true>((LAS unsigned char*)lds, c.wave, g, S, E);
}
__device__ __forceinline__ void fast_mla_up(Ctx& c, unsigned char* lds, int rows_q, int rows_k) {
    { pg8::Gemm g{c.P1 + P_CQ, (const bf16_t*)(c.ws + WS_W + WO_UQ), rows_q, 768, 384, P1W}; pg8::StaticOrder S; S.init(rows_q, 768, c.nwg, c.wg);
      pg8::EpiMlaUp<0> E{c.QC, c.rowss}; pg8::gemm_phase<pg8::EpiMlaUp<0>, pg8::StaticOrder, true>((LAS unsigned char*)lds, c.wave, g, S, E); }
    { pg8::Gemm g{c.P1 + P_CKV, (const bf16_t*)(c.ws + WS_W + WO_UKV), rows_k, 1024, 256, P1W}; pg8::StaticOrder S; S.init(rows_k, 1024, c.nwg, c.wg);
      pg8::EpiMlaUp<1> E{c.KVR, c.rowss}; pg8::gemm_phase<pg8::EpiMlaUp<1>, pg8::StaticOrder, true>((LAS unsigned char*)lds, c.wave, g, S, E); }
}
__device__ __forceinline__ void fast_gates(Ctx& c, unsigned char* lds, int rows) {
    pg8::Gemm g{c.H, (const bf16_t*)(c.ws + WS_W + WO_G), rows, 3072, D, D}; pg8::StaticOrder S; S.init(rows, 3072, c.nwg, c.wg);
    pg8::EpiSigmoid E{c.G};
    pg8::gemm_phase<pg8::EpiSigmoid, pg8::StaticOrder, true>((LAS unsigned char*)lds, c.wave, g, S, E);
}
__device__ __forceinline__ void fast_merge(Ctx& c, unsigned char* lds, int rows) {
    pg8::StaticOrder S; S.init(rows, D, c.nwg, c.wg);
    { pg8::Gemm g{c.P1 + P_QA, (const bf16_t*)(c.ws + WS_W + WO_BR), rows, D, 512, P1W}; pg8::EpiMerge<0> E{c.H, c.G}; pg8::gemm_phase<pg8::EpiMerge<0>, pg8::StaticOrder, true>((LAS unsigned char*)lds, c.wave, g, S, E); }
    { pg8::Gemm g{c.P1 + P_QB, (const bf16_t*)(c.ws + WS_W + WO_BR) + (size_t)1024 * 512, rows, D, 512, P1W}; pg8::EpiMerge<1> E{c.H, c.G}; pg8::gemm_phase<pg8::EpiMerge<1>, pg8::StaticOrder, true>((LAS unsigned char*)lds, c.wave, g, S, E); }
    { pg8::Gemm g{c.YC, (const bf16_t*)(c.ws + WS_W + WO_BR) + (size_t)2 * 1024 * 512, rows, D, 512, 512}; pg8::EpiMerge<2> E{c.H, c.G}; pg8::gemm_phase<pg8::EpiMerge<2>, pg8::StaticOrder, true>((LAS unsigned char*)lds, c.wave, g, S, E); }
}

namespace fa {
typedef float f32x16 __attribute__((ext_vector_type(16)));
typedef short s16x4 __attribute__((ext_vector_type(4)));
typedef short v4i16_t __attribute__((ext_vector_type(4)));
constexpr int KBUF = 12288, VBUF = 8192, SLOT = KBUF + VBUF;
constexpr int OFF_WS = 2 * SLOT, OFF_OST = OFF_WS + 2048, LDS_TOTAL = OFF_OST + 8 * 4096;
constexpr float THR = 8.0f;
__device__ __forceinline__ int crow(int r, int hi) { return (r & 3) + 8 * (r >> 2) + 4 * hi; }
__device__ __forceinline__ s16x4 vtr(const LAS unsigned char* p) { return __builtin_bit_cast(s16x4, __builtin_amdgcn_ds_read_tr16_b64_v4i16((LAS v4i16_t*)p)); }
__device__ __forceinline__ unsigned cvtpk(float lo, float hi) { return pg8::cvt_pk_bf16(lo, hi); }
struct UnitDesc {
    const bf16_t* Q; bf16_t* O;
    const bf16_t* Kc; const bf16_t* Vc;
    const bf16_t* Kl; const bf16_t* Vl;
    int qpitch, opitch, kpitch, vpitch, nt_ctx, nt_lat;
    int qoff;
    float sinkl;
};
template <int DQK, bool WIN, bool SINK>
__device__ __forceinline__ void attn_unit(const UnitDesc& u, LAS unsigned char* lds, int wid) {
    const int lane = lane_id(), r32 = lane & 31, hi = lane >> 5;
    constexpr int ND = DQK / 16, NCH = DQK / 8;
    const int NT = u.nt_ctx + u.nt_lat;
    LAS float* wsf = (LAS float*)(lds + OFF_WS) + wid * 64;
    auto issue = [&](int t, int s) {
        const bool ctx = t < u.nt_ctx; const int tt = ctx ? t : t - u.nt_ctx;
        const bf16_t* Kt = (ctx ? u.Kc : u.Kl) + (size_t)tt * 64 * u.kpitch; const bf16_t* Vt = (ctx ? u.Vc : u.Vl) + (size_t)tt * 64 * u.vpitch;
        for (int cc = wid; cc < NCH; cc += 8)
            __builtin_amdgcn_global_load_lds((const unsigned*)(Kt + (size_t)lane * u.kpitch + cc * 8), (LAS unsigned*)(lds + s * SLOT + cc * 1024), 16, 0, 0);
        __builtin_amdgcn_global_load_lds((const unsigned*)(Vt + (size_t)(16 * (wid & 3) + (lane >> 2)) * u.vpitch + (wid >> 2) * 32 + (lane & 3) * 8), (LAS unsigned*)(lds + s * SLOT + KBUF + wid * 1024), 16, 0, 0);
    };
    issue(0, 0);
    bf16x8 qr[ND];
    { const bf16_t* qp = u.Q + (size_t)(wid * 32 + r32) * u.qpitch + hi * 8;
#pragma unroll
      for (int d0 = 0; d0 < ND; ++d0) qr[d0] = *(const bf16x8*)(qp + d0 * 16); }
    f32x16 o[2]; o[0] = f32x16{}; o[1] = f32x16{};
    f32x16 negm = f32x16{};
    float m = 0.f, l = 0.f;
    const int qi = u.qoff + wid * 32;
    asm volatile("s_waitcnt vmcnt(0)\n\ts_barrier" ::: "memory");
    const int koff = hi * 1024 + r32 * 16;
    const int voff = KBUF + ((lane >> 4) & 1) * 32 + (lane & 3) * 8 + (4 * hi + ((lane & 15) >> 2)) * 64;
#pragma unroll 1
    for (int t = 0; t < NT; ++t) {
        const int s = t & 1;
        if (t + 1 < NT) issue(t + 1, s ^ 1);
        bool skip = false; bool need_mask = false; int jb = 0;
        if (WIN && t >= u.nt_ctx) { jb = (t - u.nt_ctx) * 64;
            skip = (jb > qi + 31 + 128) || (jb + 63 < qi - 128);
            need_mask = !((jb + 63 - qi <= 128) && (qi + 31 - jb <= 128)); }
        if (!skip) {
            const LAS unsigned char* kb = lds + s * SLOT + koff;
            f32x16 p0 = negm, p1 = negm;
#pragma unroll
            for (int d0 = 0; d0 < ND; ++d0) { const bf16x8 b0 = *(const LAS bf16x8*)(kb + d0 * 2048), b1 = *(const LAS bf16x8*)(kb + d0 * 2048 + 512);
                p0 = __builtin_amdgcn_mfma_f32_32x32x16_bf16(b0, qr[d0], p0, 0, 0, 0); p1 = __builtin_amdgcn_mfma_f32_32x32x16_bf16(b1, qr[d0], p1, 0, 0, 0); }
            if (WIN && need_mask) { const int q = qi + r32;
#pragma unroll
                for (int r = 0; r < 16; ++r) { const int d0_ = jb + crow(r, hi) - q, d1_ = d0_ + 32;
                    if (d0_ > 128 || d0_ < -128) p0[r] = -INFINITY; if (d1_ > 128 || d1_ < -128) p1[r] = -INFINITY; } }
            float rm = fmaxf(p0[0], p1[0]);
#pragma unroll
            for (int r = 1; r < 16; ++r) rm = fmaxf(rm, fmaxf(p0[r], p1[r]));
            rm = fmaxf(rm, __shfl_xor(rm, 32));
            if (t == 0) {
                m = rm;
#pragma unroll
                for (int r = 0; r < 16; ++r) { p0[r] -= rm; p1[r] -= rm; negm[r] = -rm; }
            } else if (__any(rm > THR)) {
                const float dl = fmaxf(rm, 0.f); m += dl;
#pragma unroll
                for (int r = 0; r < 16; ++r) { p0[r] -= dl; p1[r] -= dl; negm[r] = -m; }
                const float al = __builtin_amdgcn_exp2f(-dl); l *= al;
                if (hi == 0) wsf[r32] = al;
#pragma unroll
                for (int r = 0; r < 16; ++r) { const float a = wsf[crow(r, hi)]; o[0][r] *= a; o[1][r] *= a; }
            }
            float sacc = 0.f;
#pragma unroll
            for (int r = 0; r < 16; ++r) { p0[r] = __builtin_amdgcn_exp2f(p0[r]); p1[r] = __builtin_amdgcn_exp2f(p1[r]); sacc += p0[r] + p1[r]; }
            l += sacc;
            u32x4 pw[4];
#pragma unroll
            for (int k = 0; k < 4; ++k) { pw[0][k] = cvtpk(p0[2 * k], p0[2 * k + 1]); pw[1][k] = cvtpk(p0[8 + 2 * k], p0[9 + 2 * k]); pw[2][k] = cvtpk(p1[2 * k], p1[2 * k + 1]); pw[3][k] = cvtpk(p1[8 + 2 * k], p1[9 + 2 * k]); }
            const LAS unsigned char* vp = lds + s * SLOT + voff;
#pragma unroll
            for (int d0 = 0; d0 < 2; ++d0)
#pragma unroll
                for (int ks = 0; ks < 4; ++ks) { const s16x4 lo = vtr(vp + d0 * 4096 + ks * 1024), h2 = vtr(vp + d0 * 4096 + ks * 1024 + 512);
                    const bf16x8 vf = (bf16x8){lo[0], lo[1], lo[2], lo[3], h2[0], h2[1], h2[2], h2[3]};
                    o[d0] = __builtin_amdgcn_mfma_f32_32x32x16_bf16(__builtin_bit_cast(bf16x8, pw[ks]), vf, o[d0], 0, 0, 0); }
        }
        asm volatile("s_waitcnt vmcnt(0) lgkmcnt(0)\n\ts_barrier" ::: "memory");
    }
    l += __shfl_xor(l, 32);
    if (SINK) l += __builtin_amdgcn_exp2f(u.sinkl - m);
    const float inv = 1.0f / l;
    if (hi == 0) wsf[32 + r32] = inv;
    LAS bf16_t* stg = (LAS bf16_t*)(lds + OFF_OST + wid * 4096);
#pragma unroll
    for (int r = 0; r < 16; ++r) { const int orow = crow(r, hi); const float rl = wsf[32 + orow];
        stg[orow * 64 + r32] = f2bf(o[0][r] * rl); stg[orow * 64 + 32 + r32] = f2bf(o[1][r] * rl); }
    bf16_t* Ow = u.O + (size_t)(wid * 32) * u.opitch;
#pragma unroll
    for (int i = 0; i < 4; ++i) { const int row = i * 8 + (lane >> 3), ch = lane & 7; const u32x4 v = *(const LAS u32x4*)(stg + row * 64 + ch * 8); *(u32x4*)(Ow + (size_t)row * u.opitch + ch * 8) = v; }
}
}
__device__ __forceinline__ void phase_attn(Ctx& c, int l, unsigned char* lds_, bool ctx_out) {
    LAS unsigned char* lds = (LAS unsigned char*)lds_;
    const int total = 1536 + (ctx_out ? 192 : 0);
    for (int ui = c.wg; ui < total; ui += c.nwg) {
        int br, b, h, qb; bool cq;
        if (ui < 1536) { br = 2 - ui / 512; const int i = ui % 512; b = i >> 6; h = (i >> 3) & 7; qb = i & 7; cq = false; }
        else { const int j = ui - 1536; br = 2 - j / 64; const int i = j % 64; b = i >> 3; h = i & 7; qb = 0; cq = true; }
        const int qrow = cq ? NLAT + b * CTXL : b * SEQ + qb * 256, crow0 = NLAT + b * CTXL, lrow0 = b * SEQ;
        fa::UnitDesc u; u.nt_ctx = 4; u.qoff = 0; u.sinkl = 0.f;
        if (br == 2) {
            u.Q = c.QC + (size_t)qrow * 768 + 96 * h; u.qpitch = 768; u.O = c.YC + (size_t)qrow * 512 + 64 * h; u.opitch = 512;
            u.Kc = c.KC + (size_t)crow0 * 768 + 96 * h; u.Kl = c.KC + (size_t)lrow0 * 768 + 96 * h; u.kpitch = 768;
            u.Vc = c.KVR + (size_t)crow0 * 1024 + 128 * h + 64; u.Vl = c.KVR + (size_t)lrow0 * 1024 + 128 * h + 64; u.vpitch = 1024;
            u.nt_lat = cq ? 0 : 32;
            fa::attn_unit<96, false, false>(u, lds, c.wave);
        } else {
            const int qo = br == 0 ? P_QA : P_QB, ko = (br == 0 ? P_KA : P_KB) + 64 * (h >> 2), vo = (br == 0 ? P_VA : P_VB) + 64 * (h >> 2);
            bf16_t* qp = c.P1 + (size_t)qrow * P1W + qo + 64 * h;
            u.Q = qp; u.O = qp; u.qpitch = P1W; u.opitch = P1W; u.kpitch = P1W; u.vpitch = P1W;
            u.Kc = c.P1 + (size_t)crow0 * P1W + ko; u.Vc = c.P1 + (size_t)crow0 * P1W + vo;
            if (br == 1) { u.Kl = c.P1 + (size_t)lrow0 * P1W + ko; u.Vl = c.P1 + (size_t)lrow0 * P1W + vo; u.nt_lat = cq ? 0 : 32;
                fa::attn_unit<64, false, false>(u, lds, c.wave); }
            else {
                u.sinkl = c.p->in[13][l * 8 + h] * LOG2E;
                if (cq) { u.Kl = u.Kc; u.Vl = u.Vc; u.nt_lat = 0; fa::attn_unit<64, false, true>(u, lds, c.wave); }
                else { const int lt0 = 4 * qb - 2 < 0 ? 0 : 4 * qb - 2, lt1 = 4 * qb + 5 > 31 ? 31 : 4 * qb + 5;
                    u.Kl = c.P1 + (size_t)(lrow0 + 64 * lt0) * P1W + ko; u.Vl = c.P1 + (size_t)(lrow0 + 64 * lt0) * P1W + vo; u.nt_lat = lt1 - lt0 + 1; u.qoff = 256 * qb - 64 * lt0;
                    fa::attn_unit<64, true, true>(u, lds, c.wave); }
            }
        }
    }
}

constexpr int CW_BAR = 4096;
constexpr int MISC_OFF = 131072 + 320;
#define XB_TMO      128
#define XB_XCNT(j)  (256  + 64 * (j))
#define XB_XSUB(j)  (1280 + 64 * (j))
#define XB_XGEN(j)  (2304 + 64 * (j))
#define XB_TOP      3328
#define XB_TOPGEN   3392
#define XCD_BAR_WORDS 3456
#define XB_SPIN_CAP (1u << 18)
__device__ __forceinline__ unsigned xb_ld(unsigned* p)              { return __hip_atomic_load(p, __ATOMIC_RELAXED, __HIP_MEMORY_SCOPE_AGENT); }
__device__ __forceinline__ unsigned xb_add(unsigned* p, unsigned v) { return __hip_atomic_fetch_add(p, v, __ATOMIC_RELAXED, __HIP_MEMORY_SCOPE_AGENT); }
__device__ __forceinline__ unsigned xb_xcc_id() { return (unsigned)__builtin_amdgcn_s_getreg((3 << 11) | 20) & 0xFu; }
#define XB_SPIN(cond, bar) do { unsigned _sp = 0; while (cond) { __builtin_amdgcn_s_sleep(1); \
    if ((++_sp & 255u) == 0u) { if (xb_ld(&(bar)[XB_TMO])) break; if (_sp > XB_SPIN_CAP) { atomicAdd(&(bar)[XB_TMO], 1u); break; } } } } while (0)
struct XcdBarrier { unsigned* bar; unsigned x; volatile LAS unsigned* st; };
__device__ __forceinline__ void xcd_barrier_complete(unsigned* bar, unsigned x, unsigned& nloc, unsigned& nx) {
    const unsigned G = gridDim.x * gridDim.y * gridDim.z;
    unsigned sum, cnt, mine, sp = 0u;
    for (;;) {
        sum = 0u; cnt = 0u; mine = 0u;
#pragma unroll
        for (unsigned j = 0; j < 16; ++j) { const unsigned cc = xb_ld(&bar[XB_XCNT(j)]); sum += cc; cnt += (cc > 0u) ? 1u : 0u; mine = (j == x) ? cc : mine; }
        if (sum == G) break;
        __builtin_amdgcn_s_sleep(1);
        if ((++sp & 255u) == 0u) { if (xb_ld(&bar[XB_TMO])) break; if (sp > XB_SPIN_CAP) { atomicAdd(&bar[XB_TMO], 1u); break; } }
    }
    nloc = mine > 0u ? mine : 1u; nx = cnt > 0u ? cnt : 1u;
}
__device__ __forceinline__ void xcd_barrier(const XcdBarrier& b, int wave) {
    asm volatile("s_waitcnt vmcnt(0)" ::: "memory");
    __syncthreads();
    if (wave == 0 && lane_id() == 0) {
        unsigned* bar = b.bar;
        __builtin_amdgcn_s_waitcnt(0);
        unsigned nloc = b.st[0], nx = b.st[1];
        if (nloc == 0u) { xcd_barrier_complete(bar, b.x, nloc, nx); b.st[0] = nloc; b.st[1] = nx; }
        const unsigned old = xb_add(&bar[XB_XSUB(b.x)], 1u);
        const unsigned gen = old / nloc;
        if (old + 1u == (gen + 1u) * nloc) {
            __builtin_amdgcn_fence(__ATOMIC_RELEASE, "agent");
            asm volatile("s_waitcnt vmcnt(0)" ::: "memory");
            const unsigned og = xb_add(&bar[XB_TOP], 1u);
            const unsigned tg = og / nx;
            if (og + 1u == (tg + 1u) * nx) xb_add(&bar[XB_TOPGEN], 1u);
            else XB_SPIN(xb_ld(&bar[XB_TOPGEN]) == tg, bar);
            __builtin_amdgcn_fence(__ATOMIC_ACQUIRE, "agent");
            xb_add(&bar[XB_XGEN(b.x)], 1u);
            asm volatile("s_waitcnt vmcnt(0)" ::: "memory");
        } else {
            XB_SPIN(xb_ld(&bar[XB_XGEN(b.x)]) == gen, bar);
            __builtin_amdgcn_fence(__ATOMIC_ACQUIRE, "agent");
            asm volatile("s_waitcnt vmcnt(0)" ::: "memory");
        }
    }
    __syncthreads();
}

template <int S> __device__ __forceinline__ void run_stage(Ctx& c, int l, unsigned char* lds) {
    const Params* p = c.p;
    const bool last = l == DEPTH - 1;
    const int rows_all = MT, rows_mix = last ? NLAT : MT;
    if constexpr (S == -1) phase_mod(c, (float*)lds);
    if constexpr (S == 0) phase_norm(c, l, p->in[6] + l * D, 0, rows_all, l == 0);
    if constexpr (S == 1) naive_ffn_up(c, p->in[7] + (size_t)l * D * 2 * DFF, rows_all);
    if constexpr (S == 2) naive_res(c, l, c.ACT, DFF, DFF, p->in[8] + (size_t)l * DFF * D, 0.5f, 2, rows_all, l == 0);
    if constexpr (S == 3) phase_norm(c, l, p->in[9] + l * D, 3, rows_all, false);
    if constexpr (S == 4) naive_inproj(c, l, rows_all);
    if constexpr (S == 5) naive_rowss(c, rows_all);
    if constexpr (S == 6) { naive_mla_q(c, l, rows_mix); naive_mla_kv(c, l, rows_all); }
    if constexpr (S == 7) naive_attn(c, l, 0, rows_mix);
    if constexpr (S == 8) naive_gates(c, l, rows_mix);
    if constexpr (S == 9) naive_merge(c, l, rows_mix);
    if constexpr (S == 10) naive_res(c, l, c.H, D, D, p->in[25] + (size_t)l * D * D, 1.0f, 5, rows_mix, false);
    if constexpr (S == 11) phase_norm(c, l, p->in[26] + l * D, 6, rows_mix, false);
    if constexpr (S == 12) naive_ffn_up(c, p->in[27] + (size_t)l * D * 2 * DFF, rows_mix);
    if constexpr (S == 13) naive_res(c, l, c.ACT, DFF, DFF, p->in[28] + (size_t)l * DFF * D, 0.5f, 8, rows_mix, false);
    if constexpr (S == 20) phase_convert(c, l, lds);
    if constexpr (S == 21) fast_ffn_up(c, lds, WO_F1IN, rows_all);
    if constexpr (S == 22) fast_res(c, lds, l, c.ACT, DFF, WO_F1OUT, 0.5f, 2, rows_all, l == 0);
    if constexpr (S == 24) fast_inproj(c, lds, l, rows_all);
    if constexpr (S == 26) fast_mla_up(c, lds, rows_mix, rows_all);
    if constexpr (S == 27) phase_mla_norm(c, l, rows_mix, rows_all);
    if constexpr (S == 28) fast_gates(c, lds, rows_mix);
    if constexpr (S == 29) fast_merge(c, lds, rows_mix);
    if constexpr (S == 30) fast_res(c, lds, l, c.H, D, WO_OUT, 1.0f, 5, rows_mix, false);
    if constexpr (S == 32) fast_ffn_up(c, lds, WO_F2IN, rows_mix);
    if constexpr (S == 33) fast_res(c, lds, l, c.ACT, DFF, WO_F2OUT, 0.5f, 8, rows_mix, false);
    if constexpr (S == 40) phase_attn(c, l, lds, !last);
}
template <int S> __global__ void __launch_bounds__(512, 2) k_stage(Params prm, int l) {
    extern __shared__ __attribute__((aligned(16))) unsigned char lds[];
    Ctx c; ctx_init(c, &prm, blockIdx.x, gridDim.x);
    run_stage<S>(c, l, lds);
}
constexpr int LDS_NAIVE = 65536, LDS_FAST = 147456;
#ifndef MULTI
#define MULTI 0
#endif
__global__ void __launch_bounds__(512, 2) mega_kernel(Params prm) {
    extern __shared__ __attribute__((aligned(16))) unsigned char lds[];
    Ctx c; ctx_init(c, &prm, blockIdx.x, gridDim.x);
    volatile LAS unsigned* MISC = (volatile LAS unsigned*)((LAS unsigned char*)lds + MISC_OFF);
    { const int ln = lane_id(); if (c.wave == 0 && ln < 32) MISC[ln] = 0u; }
    __syncthreads();
    XcdBarrier bar; bar.bar = (unsigned*)(prm.ws + WS_CTL) + CW_BAR; bar.x = xb_xcc_id(); bar.st = MISC + 8;
    if (c.wave == 0 && lane_id() == 0) (void)xb_add(&bar.bar[XB_XCNT(bar.x)], 1u);
#define GRID_BAR() xcd_barrier(bar, c.wave)
    run_stage<-1>(c, 0, lds); __syncthreads(); run_stage<20>(c, 0, lds); GRID_BAR();
#pragma unroll 1
    for (int l = 0; l < DEPTH; ++l) {
        if (l > 0) run_stage<20>(c, l, lds);
        run_stage<0>(c, l, lds); GRID_BAR();
        run_stage<21>(c, l, lds); GRID_BAR();
        run_stage<22>(c, l, lds); GRID_BAR();
        run_stage<3>(c, l, lds); GRID_BAR();
        run_stage<24>(c, l, lds); GRID_BAR();
        run_stage<26>(c, l, lds); GRID_BAR();
        run_stage<27>(c, l, lds); GRID_BAR();
        run_stage<40>(c, l, lds); GRID_BAR();
        run_stage<28>(c, l, lds); GRID_BAR();
        run_stage<29>(c, l, lds); GRID_BAR();
        run_stage<30>(c, l, lds); GRID_BAR();
        run_stage<11>(c, l, lds); GRID_BAR();
        run_stage<32>(c, l, lds); GRID_BAR();
        run_stage<33>(c, l, lds); if (l + 1 < DEPTH) GRID_BAR();
    }
#undef GRID_BAR
}
static int g_cus = 0;
template <int S> static void launch_stage(const Params& p, int l, hipStream_t stream) {
    constexpr bool fast = S >= 20;
    static int inited = 0;
    if (!inited) { (void)hipFuncSetAttribute((const void*)k_stage<S>, hipFuncAttributeMaxDynamicSharedMemorySize, fast ? LDS_FAST : LDS_NAIVE); inited = 1; }
    hipLaunchKernelGGL(k_stage<S>, dim3(fast ? g_cus : 1024), dim3(512), fast ? LDS_FAST : LDS_NAIVE, stream, p, l);
}
#ifndef FASTMASK
#define FASTMASK 0xffff
#endif
template <int BIT, int SF, int SN> static void launch_sel(const Params& p, int l, hipStream_t stream) { if constexpr ((FASTMASK >> BIT) & 1) launch_stage<SF>(p, l, stream); else launch_stage<SN>(p, l, stream); }

extern "C" void kernel_launch(void* const* d_in, const int* in_sizes, int n_in, void* d_out, int out_size, void* d_ws, size_t ws_size, hipStream_t stream) {
    if (n_in != 29 || out_size != NLAT * D || ws_size < WS_END) { fprintf(stderr, "kernel_launch: unexpected shapes (n_in %d out %d ws %zu need %zu)\n", n_in, out_size, ws_size, (size_t)WS_END); return; }
    if (!g_cus) { int dev = 0; (void)hipGetDevice(&dev); (void)hipDeviceGetAttribute(&g_cus, hipDeviceAttributeMultiprocessorCount, dev); if (g_cus <= 0) g_cus = 256;
        (void)hipFuncSetAttribute((const void*)mega_kernel, hipFuncAttributeMaxDynamicSharedMemorySize, LDS_FAST); }
    Params p{};
    for (int i = 0; i < 29; ++i) p.in[i] = (const float*)d_in[i];
    p.out = (float*)d_out; p.ws = (unsigned char*)d_ws;
    for (int f = 0; f < 16; ++f) p.invf_hd[f] = (float)pow(10000.0, -(double)f / 16.0);
    for (int f = 0; f < 8; ++f) p.invf_c[f] = (float)pow(10000.0, -(double)f / 8.0);
    (void)hipMemsetAsync((char*)d_ws + WS_CTL, 0, 1u << 20, stream);
#if !MULTI
    hipLaunchKernelGGL(mega_kernel, dim3(g_cus), dim3(512), LDS_FAST, stream, p);
#else
    launch_stage<-1>(p, 0, stream);
    for (int l = 0; l < DEPTH; ++l) {
        launch_stage<20>(p, l, stream);
        launch_stage<0>(p, l, stream);
        launch_sel<0, 21, 1>(p, l, stream);
        launch_sel<1, 22, 2>(p, l, stream);
        launch_stage<3>(p, l, stream);
        launch_sel<2, 24, 4>(p, l, stream);
        if constexpr (!((FASTMASK >> 2) & 1)) launch_stage<5>(p, l, stream);
        if constexpr ((FASTMASK >> 3) & 1) { launch_stage<26>(p, l, stream); launch_stage<27>(p, l, stream); } else launch_stage<6>(p, l, stream);
        launch_sel<9, 40, 7>(p, l, stream);
        launch_sel<4, 28, 8>(p, l, stream);
        launch_sel<5, 29, 9>(p, l, stream);
        launch_sel<6, 30, 10>(p, l, stream);
        launch_stage<11>(p, l, stream);
        launch_sel<7, 32, 12>(p, l, stream);
        launch_sel<8, 33, 13>(p, l, stream);
    }
#endif
}
```

```cpp
#include <hip/hip_runtime.h>
#include <cstdio>
#include <cstdint>
#include <cmath>

constexpr int D = 1024, NB_ = 8, SEQ = 2048, CTXL = 256, DFF = 2816, DEPTH = 2;
constexpr int NLAT = NB_ * SEQ;
constexpr int NCTX = NB_ * CTXL;
constexpr int MT = NLAT + NCTX;
constexpr int NMOD = 9, MODW = NMOD * D;
constexpr int INC = 5280;
constexpr int O_AK = 0, O_AV = 128, O_BK = 256, O_BV = 384, O_CKV = 512, O_CKR = 768, O_AQ = 800, O_BQ = 1312, O_CQ = 1824, O_G = 2208;
constexpr int P1W = 2304;
constexpr int P_KA = 0, P_VA = 128, P_KB = 256, P_VB = 384, P_CKV = 512, P_CQ = 768, P_CKR = 1152, P_QA = 1280, P_QB = 1792;
constexpr int P_YC = 768;
constexpr float EPS = 1e-6f;
constexpr float LOG2E = 1.4426950408889634f;
constexpr float LN2 = 0.6931471805599453f;
constexpr float QSC64 = 0.125f * LOG2E;
constexpr float QSC96 = 0.10206207261596575f * LOG2E;

typedef unsigned short bf16_t;
typedef short bf16x8 __attribute__((ext_vector_type(8)));
typedef float f32x4 __attribute__((ext_vector_type(4)));
typedef unsigned u32x4 __attribute__((ext_vector_type(4)));
typedef unsigned u32x2 __attribute__((ext_vector_type(2)));

constexpr size_t WS_CTL = 0;
constexpr size_t WS_MOD = 1u << 20;
constexpr size_t WS_ROPE_HD = WS_MOD + (size_t)DEPTH * 9 * MODW * 4;
constexpr size_t WS_ROPE_C = WS_ROPE_HD + (size_t)SEQ * 32 * 2 * 4;
constexpr size_t WS_ROWSS = WS_ROPE_C + (size_t)SEQ * 16 * 2 * 4;
constexpr size_t WS_Z = WS_ROWSS + (size_t)MT * 12 * 4;
constexpr size_t WS_H = WS_Z + (size_t)NCTX * D * 4;
constexpr size_t WS_RA = WS_H + (size_t)MT * D * 2;
constexpr size_t RA_BYTES = (size_t)MT * 3072 * 2;
constexpr size_t WS_P1 = WS_RA + RA_BYTES;
constexpr size_t WS_YC = WS_P1 + (size_t)MT * P1W * 2;
constexpr size_t WS_W = WS_YC + (size_t)MT * 1024 * 2;
constexpr size_t WS_SSQ = WS_W + 52000000u;
constexpr size_t WS_SS = WS_SSQ + (size_t)MT * 24 * 4;
constexpr int NBIAS = 16640, BO_F1 = 0, BO_P1 = 5632, BO_G = 7936, BO_F2 = 11008;
constexpr size_t WS_BIAS = WS_SS + (size_t)MT * 16 * 4;
constexpr size_t WS_END = WS_BIAS + (size_t)2 * 9 * NBIAS * 4;
constexpr size_t RA_QC = 0, RA_KC = (size_t)MT * 768 * 2, RA_KVR = 2 * (size_t)MT * 768 * 2;
constexpr size_t RA_VC = RA_KVR;
constexpr size_t RA_BSTR = (size_t)2304 * 6144;
static_assert(RA_BSTR * 8 == RA_BYTES, "RA slices");
constexpr size_t RAS_QC = 0, RAS_KC = (size_t)2304 * 1536, RAS_VC = (size_t)2 * 2304 * 1536;
__device__ __forceinline__ size_t ra_panel_off(int pm, int pitch_bytes) { const int b = pm < NLAT / 256 ? pm >> 3 : pm - NLAT / 256, lp = pm < NLAT / 256 ? pm & 7 : 8; return (size_t)b * RA_BSTR + (size_t)lp * 256 * pitch_bytes; }

struct Params {
    const float* in[29];
    float* out;
    unsigned char* ws;
    float invf_hd[16];
    float invf_c[8];
    int ph_lo, ph_hi;
};

__device__ __forceinline__ float bf2f(bf16_t v) { return __uint_as_float((unsigned)v << 16); }
__device__ __forceinline__ bf16_t f2bf(float f) { unsigned u = __float_as_uint(f); return (bf16_t)((u + 0x7fffu + ((u >> 16) & 1u)) >> 16); }
__device__ __forceinline__ unsigned pk2(float lo, float hi) { return (unsigned)f2bf(lo) | ((unsigned)f2bf(hi) << 16); }
__device__ __forceinline__ float sigmoidf_(float v) { return 1.0f / (1.0f + __expf(-v)); }
__device__ __forceinline__ int row_mb(int r) { return r < NLAT ? (r >> 11) : 8; }

__device__ __forceinline__ int lane_id() { int l; asm volatile("v_mbcnt_lo_u32_b32 %0, -1, 0\n\tv_mbcnt_hi_u32_b32 %0, -1, %0" : "=v"(l)); return l; }
#define PH_IDS(c) const int lane_ = lane_id(); const int tid_ = (c).wave * 64 + lane_; (void)tid_
struct Ctx {
    const Params* p;
    int wave, wg, nwg;
    int lat0, nlat, ctx0, nctx, b0, nb;
    unsigned char* ws;
    float* mod; float* rope_hd; float* rope_c; float* rowss; float* Z; bf16_t* H; bf16_t* ACT; bf16_t* QC; bf16_t* KC; bf16_t* KVR; bf16_t* VC; float* ssq; float* ss; float* bias; bf16_t* G; bf16_t* P1; bf16_t* YC;
};
__device__ __forceinline__ void ctx_init(Ctx& c, const Params* p, int wg, int nwg) {
    c.p = p; c.wave = __builtin_amdgcn_readfirstlane((int)threadIdx.x >> 6); c.wg = wg; c.nwg = nwg; c.lat0 = 0; c.nlat = NLAT / 256; c.ctx0 = NLAT / 256; c.nctx = NCTX / 256; c.b0 = 0; c.nb = NB_;
    unsigned char* ws = p->ws; c.ws = ws;
    c.mod = (float*)(ws + WS_MOD); c.rope_hd = (float*)(ws + WS_ROPE_HD); c.rope_c = (float*)(ws + WS_ROPE_C); c.rowss = (float*)(ws + WS_ROWSS);
    c.Z = (float*)(ws + WS_Z); c.H = (bf16_t*)(ws + WS_H); c.ACT = (bf16_t*)(ws + WS_RA);
    c.QC = (bf16_t*)(ws + WS_RA + RA_QC); c.KC = (bf16_t*)(ws + WS_RA + RA_KC); c.KVR = (bf16_t*)(ws + WS_RA + RA_KVR); c.VC = (bf16_t*)(ws + WS_RA + RA_VC); c.ssq = (float*)(ws + WS_SSQ); c.ss = (float*)(ws + WS_SS); c.bias = (float*)(ws + WS_BIAS); c.G = (bf16_t*)(ws + WS_RA);
    c.P1 = (bf16_t*)(ws + WS_P1); c.YC = (bf16_t*)(ws + WS_YC);
}
__device__ __forceinline__ const float* xin_row(const Ctx& c, int r, bool from_input) {
    if (from_input) return r < NLAT ? c.p->in[0] + (size_t)r * D : c.p->in[2] + (size_t)(r - NLAT) * D;
    return r < NLAT ? c.p->out + (size_t)r * D : c.Z + (size_t)(r - NLAT) * D;
}
__device__ __forceinline__ float* xout_row(const Ctx& c, int r) { return r < NLAT ? c.p->out + (size_t)r * D : c.Z + (size_t)(r - NLAT) * D; }

__device__ __forceinline__ void sincos_d(double x, float& s, float& c) {
    const double TWO_PI = 6.283185307179586476925286766559;
    const double k = rint(x * (1.0 / TWO_PI)); const double r = x - k * TWO_PI; const double r2 = r * r;
    double ts = r, ss = r, tc = 1.0, sc = 1.0;
    for (int n = 1; n <= 15; ++n) { ts *= -r2 / (double)((2 * n) * (2 * n + 1)); ss += ts; tc *= -r2 / (double)((2 * n - 1) * (2 * n)); sc += tc; }
    s = (float)ss; c = (float)sc;
}
__device__ __forceinline__ void phase_mod(Ctx& c, float* lds) {
    PH_IDS(c);
    const Params* p = c.p;
    float* cond = lds;
    float* red = lds + 9 * 1024;
    for (int i = tid_; i < 9 * 1024; i += 512) { const int mb = i >> 10, k = i & 1023; const float v = mb < 8 ? p->in[1][mb * 1024 + k] : p->in[3][k]; cond[i] = v * sigmoidf_(v); }
    __syncthreads();
    const int ksl = tid_ >> 3, c4 = (tid_ & 7) * 4;
    for (int u = c.wg; u < DEPTH * MODW / 32; u += c.nwg) {
        const int n0 = u * 32, l = n0 / MODW, nn = n0 % MODW;
        f32x4 wv[16];
        const float* w = p->in[4] + ((size_t)l * D + ksl * 16) * MODW + nn + c4;
#pragma unroll
        for (int k = 0; k < 16; ++k) wv[k] = *(const f32x4*)(w + (size_t)k * MODW);
        f32x4 acc[9];
#pragma unroll
        for (int m = 0; m < 9; ++m) acc[m] = (f32x4){0.f, 0.f, 0.f, 0.f};
#pragma unroll
        for (int k = 0; k < 16; ++k)
#pragma unroll
            for (int m = 0; m < 9; ++m) acc[m] += wv[k] * cond[m * 1024 + ksl * 16 + k];
#pragma unroll
        for (int m = 0; m < 9; ++m)
#pragma unroll
            for (int e = 0; e < 4; ++e) { float v = acc[m][e]; v += __shfl_xor(v, 8); v += __shfl_xor(v, 16); v += __shfl_xor(v, 32); acc[m][e] = v; }
        if (lane_ < 8) {
#pragma unroll
            for (int m = 0; m < 9; ++m) *(f32x4*)(red + (c.wave * 9 + m) * 32 + c4) = acc[m]; }
        __syncthreads();
        for (int o = tid_; o < 9 * 32; o += 512) { const int m = o >> 5, c2 = o & 31; float sacc = 0.f;
#pragma unroll
            for (int k2 = 0; k2 < 8; ++k2) sacc += red[(k2 * 9 + m) * 32 + c2];
            c.mod[((size_t)l * 9 + m) * MODW + nn + c2] = sacc + p->in[5][(size_t)l * MODW + nn + c2]; }
        __syncthreads();
    }
    const int gt = c.wg * 512 + tid_, ngt = c.nwg * 512;
    for (int i = gt; i < SEQ * 48; i += ngt) {
        const int s = i / 48, j = i % 48; const int row = s >> 6, col = s & 63; float sn, cs;
        if (j < 32) { const double ang = (double)(j < 16 ? row : col) * (double)p->invf_hd[j & 15]; sincos_d(ang, sn, cs); c.rope_hd[(s * 32 + j) * 2] = cs; c.rope_hd[(s * 32 + j) * 2 + 1] = sn; }
        else { const int jj = j - 32; const double ang = (double)(jj < 8 ? row : col) * (double)p->invf_c[jj & 7]; sincos_d(ang, sn, cs); c.rope_c[(s * 16 + jj) * 2] = cs; c.rope_c[(s * 16 + jj) * 2 + 1] = sn; }
    }
}

__device__ __forceinline__ float wave_sum(float v) {
#pragma unroll
    for (int o = 1; o < 64; o <<= 1) v += __shfl_xor(v, o);
    return v;
}
__device__ __forceinline__ void phase_norm(Ctx& c, int l, const float* gain, int shift_idx, int rows, bool from_input) {
    PH_IDS(c);
    const int gw = c.wg * 8 + c.wave, ngw = c.nwg * 8;
    for (int r = gw; r < rows; r += ngw) {
        const f32x4* xr = (const f32x4*)xin_row(c, r, from_input) + lane_;
        f32x4 v[4]; float s = 0.f;
#pragma unroll
        for (int j = 0; j < 4; ++j) { v[j] = xr[64 * j]; s += (v[j].x * v[j].x + v[j].y * v[j].y) + (v[j].z * v[j].z + v[j].w * v[j].w); }
        const float rstd = 1.0f / sqrtf(wave_sum(s) * (1.0f / D) + EPS);
        const float* md = c.mod + ((size_t)l * 9 + row_mb(r)) * MODW;
        unsigned long long* o8 = (unsigned long long*)(c.H + (size_t)r * D) + lane_;
#pragma unroll
        for (int j = 0; j < 4; ++j) { const int k = 4 * lane_ + 256 * j;
            const f32x4 g = *(const f32x4*)(gain + k), sh = *(const f32x4*)(md + shift_idx * D + k), sc = *(const f32x4*)(md + (shift_idx + 1) * D + k);
            const f32x4 y = v[j] * rstd * g * (sc + 1.0f) + sh;
            o8[64 * j] = (unsigned long long)pk2(y.x, y.y) | ((unsigned long long)pk2(y.z, y.w) << 32); }
    }
}

__device__ __forceinline__ void phase_xg(Ctx& c, int l, const float* gain, int shift_idx, int rows, bool from_input) {
    PH_IDS(c);
    const int gw = c.wg * 8 + c.wave, ngw = c.nwg * 8;
    const int per = (rows + ngw - 1) / ngw;
    const int r0 = gw * per, r1 = r0 + per < rows ? r0 + per : rows;
    if (r0 >= rows) return;
    f32x4 v[4], nx[4], gs[4]; int mbc = -1;
    { const f32x4* xr = (const f32x4*)xin_row(c, r0, from_input) + lane_;
#pragma unroll
      for (int j = 0; j < 4; ++j) nx[j] = xr[64 * j]; }
    for (int r = r0; r < r1; ++r) {
#pragma unroll
        for (int j = 0; j < 4; ++j) v[j] = nx[j];
        if (r + 1 < r1) { const f32x4* xr = (const f32x4*)xin_row(c, r + 1, from_input) + lane_;
#pragma unroll
            for (int j = 0; j < 4; ++j) nx[j] = xr[64 * j]; }
        const int mb = row_mb(r);
        if (mb != mbc) { mbc = mb; const float* md = c.mod + ((size_t)l * 9 + mb) * MODW + (shift_idx + 1) * D;
#pragma unroll
            for (int j = 0; j < 4; ++j) { const int k = 4 * lane_ + 256 * j; gs[j] = *(const f32x4*)(gain + k) * (*(const f32x4*)(md + k) + 1.0f); } }
        float s = 0.f;
#pragma unroll
        for (int j = 0; j < 4; ++j) s += (v[j].x * v[j].x + v[j].y * v[j].y) + (v[j].z * v[j].z + v[j].w * v[j].w);
        s = wave_sum(s);
        unsigned long long* o8 = (unsigned long long*)(c.H + (size_t)r * D) + lane_;
#pragma unroll
        for (int j = 0; j < 4; ++j) { const f32x4 y = v[j] * gs[j]; o8[64 * j] = (unsigned long long)pk2(y.x, y.y) | ((unsigned long long)pk2(y.z, y.w) << 32); }
        if (lane_ < 16) c.ss[(size_t)r * 16 + lane_] = lane_ == 0 ? s : 0.f;
    }
}

template <int NB>
__device__ __forceinline__ void naive_tile(const bf16_t* A, int lda, int K, int row0, const float* const (&wp)[NB], int ldw, const float* kscale, f32x4 (&acc)[NB], int lane) {
    const int r = lane & 15, q = lane >> 4;
    const bf16_t* ap = A + (size_t)(row0 + r) * lda + q * 8;
    for (int k0 = 0; k0 < K; k0 += 32) {
        const bf16x8 a = *(const bf16x8*)(ap + k0);
        float ks[8];
#pragma unroll
        for (int j = 0; j < 8; ++j) ks[j] = kscale ? kscale[k0 + q * 8 + j] : 1.0f;
#pragma unroll
        for (int nb = 0; nb < NB; ++nb) { bf16x8 b;
#pragma unroll
            for (int j = 0; j < 8; ++j) b[j] = (short)f2bf(wp[nb][(size_t)(k0 + q * 8 + j) * ldw + r] * ks[j]);
            acc[nb] = __builtin_amdgcn_mfma_f32_16x16x32_bf16(a, b, acc[nb], 0, 0, 0); }
    }
}
__device__ __forceinline__ float quad16_sum(float v) { v += __shfl_xor(v, 1); v += __shfl_xor(v, 2); v += __shfl_xor(v, 4); v += __shfl_xor(v, 8); return v; }

__device__ __forceinline__ void naive_ffn_up(Ctx& c, const float* w_in, int rows) {
    PH_IDS(c);
    const int gw = c.wg * 8 + c.wave, ngw = c.nwg * 8, r = lane_ & 15, q = lane_ >> 4;
    const int nu = (rows / 16) * 176;
    for (int u = gw; u < nu; u += ngw) {
        const int rt = u / 176, cg = u % 176, row0 = rt * 16, c0 = cg * 16;
        const float* wp[2] = {w_in + c0, w_in + DFF + c0};
        f32x4 acc[2] = {{0.f, 0.f, 0.f, 0.f}, {0.f, 0.f, 0.f, 0.f}};
        naive_tile<2>(c.H, D, D, row0, wp, 2 * DFF, nullptr, acc, lane_);
#pragma unroll
        for (int i = 0; i < 4; ++i) { const float g = acc[0][i], up = acc[1][i]; c.ACT[(size_t)(row0 + q * 4 + i) * DFF + c0 + r] = f2bf(g * sigmoidf_(g) * up); }
    }
}
__device__ __forceinline__ void naive_res(Ctx& c, int l, const bf16_t* A, int lda, int K, const float* W, float coef, int gi, int rows, bool from_input) {
    PH_IDS(c);
    const int gw = c.wg * 8 + c.wave, ngw = c.nwg * 8, r = lane_ & 15, q = lane_ >> 4;
    const int nu = (rows / 16) * 16;
    for (int u = gw; u < nu; u += ngw) {
        const int rt = u / 16, cg = u % 16, row0 = rt * 16, c0 = cg * 64;
        const float* wp[4] = {W + c0, W + c0 + 16, W + c0 + 32, W + c0 + 48};
        f32x4 acc[4];
#pragma unroll
        for (int nb = 0; nb < 4; ++nb) acc[nb] = (f32x4){0.f, 0.f, 0.f, 0.f};
        naive_tile<4>(A, lda, K, row0, wp, D, nullptr, acc, lane_);
#pragma unroll
        for (int i = 0; i < 4; ++i) { const int row = row0 + q * 4 + i; const float* md = c.mod + ((size_t)l * 9 + row_mb(row)) * MODW + gi * D;
            const float* bi = xin_row(c, row, from_input); float* bo = xout_row(c, row);
#pragma unroll
            for (int nb = 0; nb < 4; ++nb) { const int cc = c0 + nb * 16 + r; bo[cc] = bi[cc] + coef * md[cc] * acc[nb][i]; } }
    }
}
__device__ __forceinline__ void naive_inproj(Ctx& c, int l, int rows) {
    PH_IDS(c);
    const Params* p = c.p;
    const int gw = c.wg * 8 + c.wave, ngw = c.nwg * 8, r = lane_ & 15, q = lane_ >> 4;
    const float* W = p->in[10] + (size_t)l * D * INC;
    const int nu = (rows / 16) * 36;
    for (int u = gw; u < nu; u += ngw) {
        const int rt = u / 36, g = u % 36, row0 = rt * 16;
        if (g == 19) continue;
        int src, dst, kind;
        if (g < 2) { src = O_AK + 64 * g; dst = P_KA + 64 * g; kind = 1; }
        else if (g < 4) { src = O_AV + 64 * (g - 2); dst = P_VA + 64 * (g - 2); kind = 0; }
        else if (g < 6) { src = O_BK + 64 * (g - 4); dst = P_KB + 64 * (g - 4); kind = 2; }
        else if (g < 8) { src = O_BV + 64 * (g - 6); dst = P_VB + 64 * (g - 6); kind = 0; }
        else if (g < 12) { src = O_CKV + 64 * (g - 8); dst = P_CKV + 64 * (g - 8); kind = 0; }
        else if (g < 18) { src = O_CQ + 64 * (g - 12); dst = P_CQ + 64 * (g - 12); kind = 0; }
        else if (g == 18) { src = O_CKR; dst = P_CKR; kind = 0; }
        else if (g < 28) { src = O_AQ + 64 * (g - 20); dst = P_QA + 64 * (g - 20); kind = 3; }
        else { src = O_BQ + 64 * (g - 28); dst = P_QB + 64 * (g - 28); kind = 4; }
        const float* wp[4] = {W + src, W + src + 16, W + src + (g == 18 ? 0 : 32), W + src + (g == 18 ? 0 : 48)};
        f32x4 acc[4];
#pragma unroll
        for (int nb = 0; nb < 4; ++nb) acc[nb] = (f32x4){0.f, 0.f, 0.f, 0.f};
        naive_tile<4>(c.H, D, D, row0, wp, INC, nullptr, acc, lane_);
        const float* gn = kind == 1 ? p->in[12] + l * 64 : kind == 2 ? p->in[15] + l * 64 : kind == 3 ? p->in[11] + l * 64 : p->in[14] + l * 64;
#pragma unroll
        for (int i = 0; i < 4; ++i) {
            const int row = row0 + q * 4 + i;
            bf16_t* o = c.P1 + (size_t)row * P1W + dst;
            if (kind == 0) {
#pragma unroll
                for (int nb = 0; nb < 4; ++nb) { if (g == 18 && nb >= 2) o[nb * 16 + r] = 0; else o[nb * 16 + r] = f2bf(acc[nb][i]); }
            } else {
                float ss = 0.f;
#pragma unroll
                for (int nb = 0; nb < 4; ++nb) ss += acc[nb][i] * acc[nb][i];
                ss = quad16_sum(ss);
                const float rstd = 1.0f / sqrtf(ss * (1.0f / 64.0f) + EPS);
                const float qs = kind >= 3 ? QSC64 : 1.0f;
#pragma unroll
                for (int nb = 0; nb < 4; ++nb) { const int d = nb * 16 + r; float v = acc[nb][i] * rstd * gn[d];
                    const float pr = __shfl_xor(v, 1);
                    if (row < NLAT) { const int s = row & 2047; const float cs = c.rope_hd[(s * 32 + (d >> 1)) * 2], sn = c.rope_hd[(s * 32 + (d >> 1)) * 2 + 1];
                        v = (d & 1) ? (pr * sn + v * cs) : (v * cs - pr * sn); }
                    o[d] = f2bf(v * qs); }
            }
        }
    }
}
__device__ __forceinline__ void naive_rowss(Ctx& c, int rows) {
    PH_IDS(c);
    const int gw = c.wg * 8 + c.wave, ngw = c.nwg * 8;
    for (int r = gw; r < rows; r += ngw) {
        const bf16_t* pr = c.P1 + (size_t)r * P1W;
        float s1 = 0.f, s2 = 0.f;
        for (int k = lane_; k < 256; k += 64) { const float v = bf2f(pr[P_CKV + k]); s1 += v * v; }
        for (int k = lane_; k < 384; k += 64) { const float v = bf2f(pr[P_CQ + k]); s2 += v * v; }
        s1 = wave_sum(s1); s2 = wave_sum(s2);
        if (lane_ < 12) c.rowss[(size_t)r * 12 + lane_] = lane_ == 0 ? s1 : (lane_ == 4 ? s2 : 0.f);
    }
}
__device__ __forceinline__ float rowss_kv(const Ctx& c, int row) { const f32x4 a = *(const f32x4*)(c.rowss + (size_t)row * 12); return 1.0f / sqrtf(((a.x + a.y) + (a.z + a.w)) * (1.0f / 256.0f) + EPS); }
__device__ __forceinline__ float rowss_q(const Ctx& c, int row) { const f32x4 a = *(const f32x4*)(c.rowss + (size_t)row * 12 + 4), b = *(const f32x4*)(c.rowss + (size_t)row * 12 + 8);
    return 1.0f / sqrtf((((a.x + a.y) + (a.z + a.w)) + ((b.x + b.y) + (b.z + b.w))) * (1.0f / 384.0f) + EPS); }
__device__ __forceinline__ void naive_mla_q(Ctx& c, int l, int rows) {
    PH_IDS(c);
    const Params* p = c.p;
    const int gw = c.wg * 8 + c.wave, ngw = c.nwg * 8, r = lane_ & 15, q = lane_ >> 4;
    const float* W = p->in[17] + (size_t)l * 384 * 768; const float* gl = p->in[16] + l * 384; const float* gn = p->in[20] + l * 96;
    const int nu = (rows / 16) * 8;
    for (int u = gw; u < nu; u += ngw) {
        const int rt = u / 8, h = u % 8, row0 = rt * 16;
        const float* wp[6];
#pragma unroll
        for (int nb = 0; nb < 6; ++nb) wp[nb] = W + 96 * h + 16 * nb;
        f32x4 acc[6];
#pragma unroll
        for (int nb = 0; nb < 6; ++nb) acc[nb] = (f32x4){0.f, 0.f, 0.f, 0.f};
        naive_tile<6>(c.P1 + P_CQ, P1W, 384, row0, wp, 768, gl, acc, lane_);
#pragma unroll
        for (int i = 0; i < 4; ++i) {
            const int row = row0 + q * 4 + i; const float rq = rowss_q(c, row);
            float ss = 0.f;
#pragma unroll
            for (int nb = 0; nb < 6; ++nb) { acc[nb][i] *= rq; ss += acc[nb][i] * acc[nb][i]; }
            ss = quad16_sum(ss);
            const float rstd = 1.0f / sqrtf(ss * (1.0f / 96.0f) + EPS);
            bf16_t* o = c.QC + (size_t)row * 768 + 96 * h;
#pragma unroll
            for (int nb = 0; nb < 6; ++nb) { const int d = nb * 16 + r; float v = acc[nb][i] * rstd * gn[d];
                const float pr = __shfl_xor(v, 1);
                if (nb >= 4 && row < NLAT) { const int s = row & 2047, pi = (d - 64) >> 1; const float cs = c.rope_c[(s * 16 + pi) * 2], sn = c.rope_c[(s * 16 + pi) * 2 + 1];
                    v = (d & 1) ? (pr * sn + v * cs) : (v * cs - pr * sn); }
                o[d] = f2bf(v * QSC96); }
        }
    }
}
__device__ __forceinline__ void naive_mla_kv(Ctx& c, int l, int rows) {
    PH_IDS(c);
    const Params* p = c.p;
    const int gw = c.wg * 8 + c.wave, ngw = c.nwg * 8, r = lane_ & 15, q = lane_ >> 4;
    const float* W = p->in[19] + (size_t)l * 256 * 1024; const float* gl = p->in[18] + l * 256; const float* gn = p->in[21] + l * 96;
    const int nu = (rows / 16) * 8;
    for (int u = gw; u < nu; u += ngw) {
        const int rt = u / 8, h = u % 8, row0 = rt * 16;
        const float* wp[8];
#pragma unroll
        for (int nb = 0; nb < 8; ++nb) wp[nb] = W + 128 * h + 16 * nb;
        f32x4 acc[8];
#pragma unroll
        for (int nb = 0; nb < 8; ++nb) acc[nb] = (f32x4){0.f, 0.f, 0.f, 0.f};
        naive_tile<8>(c.P1 + P_CKV, P1W, 256, row0, wp, 1024, gl, acc, lane_);
#pragma unroll
        for (int i = 0; i < 4; ++i) {
            const int row = row0 + q * 4 + i; const float rk = rowss_kv(c, row);
            const float kr0 = bf2f(c.P1[(size_t)row * P1W + P_CKR + r]), kr1 = bf2f(c.P1[(size_t)row * P1W + P_CKR + 16 + r]);
            float ss = kr0 * kr0 + kr1 * kr1;
#pragma unroll
            for (int nb = 0; nb < 4; ++nb) { acc[nb][i] *= rk; ss += acc[nb][i] * acc[nb][i]; }
            ss = quad16_sum(ss);
            const float rstd = 1.0f / sqrtf(ss * (1.0f / 96.0f) + EPS);
            bf16_t* o = c.KC + (size_t)row * 768 + 96 * h;
#pragma unroll
            for (int nb = 0; nb < 4; ++nb) { const int d = nb * 16 + r; o[d] = f2bf(acc[nb][i] * rstd * gn[d]); }
#pragma unroll
            for (int nb = 0; nb < 2; ++nb) { const int d = 64 + nb * 16 + r; float v = (nb == 0 ? kr0 : kr1) * rstd * gn[d];
                const float pr = __shfl_xor(v, 1);
                if (row < NLAT) { const int s = row & 2047, pi = (d - 64) >> 1; const float cs = c.rope_c[(s * 16 + pi) * 2], sn = c.rope_c[(s * 16 + pi) * 2 + 1];
                    v = (d & 1) ? (pr * sn + v * cs) : (v * cs - pr * sn); }
                o[d] = f2bf(v); }
            bf16_t* ov = c.KVR + (size_t)row * 1024 + 128 * h + 64;
#pragma unroll
            for (int nb = 0; nb < 4; ++nb) ov[nb * 16 + r] = f2bf(acc[4 + nb][i] * rk);
        }
    }
}
__device__ __forceinline__ void naive_gates(Ctx& c, int l, int rows) {
    PH_IDS(c);
    const int gw = c.wg * 8 + c.wave, ngw = c.nwg * 8, r = lane_ & 15, q = lane_ >> 4;
    const float* W = c.p->in[10] + (size_t)l * D * INC + O_G;
    const int nu = (rows / 16) * 48;
    for (int u = gw; u < nu; u += ngw) {
        const int rt = u / 48, cg = u % 48, row0 = rt * 16, c0 = cg * 64;
        const float* wp[4] = {W + c0, W + c0 + 16, W + c0 + 32, W + c0 + 48};
        f32x4 acc[4];
#pragma unroll
        for (int nb = 0; nb < 4; ++nb) acc[nb] = (f32x4){0.f, 0.f, 0.f, 0.f};
        naive_tile<4>(c.H, D, D, row0, wp, INC, nullptr, acc, lane_);
#pragma unroll
        for (int i = 0; i < 4; ++i)
#pragma unroll
            for (int nb = 0; nb < 4; ++nb) c.G[(size_t)(row0 + q * 4 + i) * 3072 + c0 + nb * 16 + r] = f2bf(sigmoidf_(acc[nb][i]));
    }
}
__device__ __forceinline__ void naive_merge(Ctx& c, int l, int rows) {
    PH_IDS(c);
    const Params* p = c.p;
    const int gw = c.wg * 8 + c.wave, ngw = c.nwg * 8, r = lane_ & 15, q = lane_ >> 4;
    const int nu = (rows / 16) * 16;
    for (int u = gw; u < nu; u += ngw) {
        const int rt = u / 16, cg = u % 16, row0 = rt * 16, c0 = cg * 64;
        float tot[4][4];
#pragma unroll
        for (int nb = 0; nb < 4; ++nb)
#pragma unroll
            for (int i = 0; i < 4; ++i) tot[nb][i] = 0.f;
#pragma unroll
        for (int br = 0; br < 3; ++br) {
            const float* W = p->in[22 + br] + (size_t)l * 512 * D;
            const float* wp[4] = {W + c0, W + c0 + 16, W + c0 + 32, W + c0 + 48};
            f32x4 acc[4];
#pragma unroll
            for (int nb = 0; nb < 4; ++nb) acc[nb] = (f32x4){0.f, 0.f, 0.f, 0.f};
            const bf16_t* A = br == 0 ? c.P1 + P_QA : (br == 1 ? c.P1 + P_QB : c.YC);
            naive_tile<4>(A, br == 2 ? 512 : P1W, 512, row0, wp, D, nullptr, acc, lane_);
#pragma unroll
            for (int i = 0; i < 4; ++i)
#pragma unroll
                for (int nb = 0; nb < 4; ++nb) tot[nb][i] += bf2f(c.G[(size_t)(row0 + q * 4 + i) * 3072 + br * 1024 + c0 + nb * 16 + r]) * acc[nb][i];
        }
#pragma unroll
        for (int i = 0; i < 4; ++i)
#pragma unroll
            for (int nb = 0; nb < 4; ++nb) c.H[(size_t)(row0 + q * 4 + i) * D + c0 + nb * 16 + r] = f2bf(tot[nb][i]);
    }
}

template <int DQK>
__device__ __forceinline__ void naive_attn_keys(const bf16_t* Kb, int kpitch, const bf16_t* Vb, int vpitch, int k_lo, int k_hi, int srow, int window, const float (&qv)[DQK], float& m, float& l, float (&o)[64]) {
    for (int j = k_lo; j < k_hi; ++j) {
        const bf16_t* kr = Kb + (size_t)j * kpitch;
        float s = 0.f;
#pragma unroll
        for (int d8 = 0; d8 < DQK / 8; ++d8) { const bf16x8 kk = *(const bf16x8*)(kr + d8 * 8);
#pragma unroll
            for (int e = 0; e < 8; ++e) s += qv[d8 * 8 + e] * bf2f((bf16_t)kk[e]); }
        const bool ok = window < 0 || (j - srow <= window && srow - j <= window);
        if (ok) {
            const float mn = fmaxf(m, s); const float f = exp2f(m - mn), pp = exp2f(s - mn);
            l = l * f + pp; m = mn;
            const bf16_t* vr = Vb + (size_t)j * vpitch;
#pragma unroll
            for (int d8 = 0; d8 < 8; ++d8) { const bf16x8 vv = *(const bf16x8*)(vr + d8 * 8);
#pragma unroll
                for (int e = 0; e < 8; ++e) o[d8 * 8 + e] = o[d8 * 8 + e] * f + pp * bf2f((bf16_t)vv[e]); }
        }
    }
}
__device__ __forceinline__ void naive_attn(Ctx& c, int l, int row_lo, int row_hi) {
    PH_IDS(c);
    const Params* p = c.p;
    const int gw = c.wg * 8 + c.wave, ngw = c.nwg * 8;
    const int nrw = (row_hi - row_lo) / 64;
    for (int u = gw; u < nrw * 24; u += ngw) {
        const int br = u / (nrw * 8), rem = u % (nrw * 8), h = rem / nrw, rw = rem % nrw;
        const int row = row_lo + rw * 64 + lane_;
        const bool lat = row < NLAT; const int b = lat ? (row >> 11) : ((row - NLAT) >> 8); const int s = row & 2047;
        const int crow0 = NLAT + b * CTXL, lrow0 = b * SEQ;
        float o[64];
#pragma unroll
        for (int d = 0; d < 64; ++d) o[d] = 0.f;
        float m = -1e30f, lsum = 0.f;
        if (br == 2) {
            float qv[96];
            const bf16_t* qp = c.QC + (size_t)row * 768 + 96 * h;
#pragma unroll
            for (int d8 = 0; d8 < 12; ++d8) { const bf16x8 t = *(const bf16x8*)(qp + d8 * 8);
#pragma unroll
                for (int e = 0; e < 8; ++e) qv[d8 * 8 + e] = bf2f((bf16_t)t[e]); }
            naive_attn_keys<96>(c.KC + (size_t)crow0 * 768 + 96 * h, 768, c.KVR + (size_t)crow0 * 1024 + 128 * h + 64, 1024, 0, CTXL, 0, -1, qv, m, lsum, o);
            if (lat) naive_attn_keys<96>(c.KC + (size_t)lrow0 * 768 + 96 * h, 768, c.KVR + (size_t)lrow0 * 1024 + 128 * h + 64, 1024, 0, SEQ, 0, -1, qv, m, lsum, o);
            const float inv = 1.0f / lsum; bf16_t* op = c.YC + (size_t)row * 512 + 64 * h;
#pragma unroll
            for (int d8 = 0; d8 < 8; ++d8) { u32x4 w; w.x = pk2(o[d8 * 8] * inv, o[d8 * 8 + 1] * inv); w.y = pk2(o[d8 * 8 + 2] * inv, o[d8 * 8 + 3] * inv); w.z = pk2(o[d8 * 8 + 4] * inv, o[d8 * 8 + 5] * inv); w.w = pk2(o[d8 * 8 + 6] * inv, o[d8 * 8 + 7] * inv); *(u32x4*)(op + d8 * 8) = w; }
        } else {
            float qv[64];
            const int qoff = br == 0 ? P_QA : P_QB, koff = (br == 0 ? P_KA : P_KB) + 64 * (h >> 2), voff = (br == 0 ? P_VA : P_VB) + 64 * (h >> 2);
            bf16_t* qp = c.P1 + (size_t)row * P1W + qoff + 64 * h;
#pragma unroll
            for (int d8 = 0; d8 < 8; ++d8) { const bf16x8 t = *(const bf16x8*)(qp + d8 * 8);
#pragma unroll
                for (int e = 0; e < 8; ++e) qv[d8 * 8 + e] = bf2f((bf16_t)t[e]); }
            if (br == 0) { m = p->in[13][l * 8 + h] * LOG2E; lsum = 1.0f; }
            naive_attn_keys<64>(c.P1 + (size_t)crow0 * P1W + koff, P1W, c.P1 + (size_t)crow0 * P1W + voff, P1W, 0, CTXL, 0, -1, qv, m, lsum, o);
            if (lat) {
                if (br == 0) { const int s0 = __builtin_amdgcn_readfirstlane(s) & ~63; const int klo = s0 - 128 < 0 ? 0 : s0 - 128, khi = s0 + 63 + 128 + 1 > SEQ ? SEQ : s0 + 63 + 128 + 1;
                    naive_attn_keys<64>(c.P1 + (size_t)lrow0 * P1W + koff, P1W, c.P1 + (size_t)lrow0 * P1W + voff, P1W, klo, khi, s, 128, qv, m, lsum, o); }
                else naive_attn_keys<64>(c.P1 + (size_t)lrow0 * P1W + koff, P1W, c.P1 + (size_t)lrow0 * P1W + voff, P1W, 0, SEQ, 0, -1, qv, m, lsum, o);
            }
            const float inv = 1.0f / lsum;
#pragma unroll
            for (int d8 = 0; d8 < 8; ++d8) { u32x4 w; w.x = pk2(o[d8 * 8] * inv, o[d8 * 8 + 1] * inv); w.y = pk2(o[d8 * 8 + 2] * inv, o[d8 * 8 + 3] * inv); w.z = pk2(o[d8 * 8 + 4] * inv, o[d8 * 8 + 5] * inv); w.w = pk2(o[d8 * 8 + 6] * inv, o[d8 * 8 + 7] * inv); *(u32x4*)(qp + d8 * 8) = w; }
        }
    }
}

constexpr size_t WO_F1IN = 0;
constexpr size_t WO_F1OUT = WO_F1IN + (size_t)5632 * 1024 * 2;
constexpr size_t WO_F2IN = WO_F1OUT + (size_t)1024 * 2816 * 2;
constexpr size_t WO_F2OUT = WO_F2IN + (size_t)5632 * 1024 * 2;
constexpr size_t WO_P1 = WO_F2OUT + (size_t)1024 * 2816 * 2;
constexpr size_t WO_G = WO_P1 + (size_t)2304 * 1024 * 2;
constexpr size_t WO_UQ = WO_G + (size_t)3072 * 1024 * 2;
constexpr size_t WO_UKV = WO_UQ + (size_t)768 * 384 * 2;
constexpr size_t WO_BR = WO_UKV + (size_t)1024 * 256 * 2;
constexpr size_t WO_OUT = WO_BR + (size_t)3 * 1024 * 512 * 2;
constexpr size_t WO_END = WO_OUT + (size_t)1024 * 1024 * 2;
static_assert(WO_END <= 52000000u, "weight region");
#define LAS __attribute__((address_space(3)))
#define GAS __attribute__((address_space(1)))

__device__ __forceinline__ void conv_item(const float* W, int ldw, int K, int srccol, const float* kgain, bf16_t* WT, int dstrow0, int k0, LAS float* scr, int lane) {
    if (srccol >= 0) {
        f32x4 t[8];
#pragma unroll
        for (int i = 0; i < 8; ++i) t[i] = *(const f32x4*)(W + (size_t)(k0 + 8 * i + (lane >> 3)) * ldw + srccol + (lane & 7) * 4);
#pragma unroll
        for (int i = 0; i < 8; ++i) { const int kk = 8 * i + (lane >> 3); f32x4 v = t[i]; if (kgain) v = v * kgain[k0 + kk];
            LAS float* d = scr + kk * 33 + (lane & 7) * 4; d[0] = v[0]; d[1] = v[1]; d[2] = v[2]; d[3] = v[3]; }
    } else {
#pragma unroll 8
        for (int i = 0; i < 32; ++i) { const int kk = 2 * i + (lane >> 5); scr[kk * 33 + (lane & 31)] = 0.f; }
    }
    asm volatile("s_waitcnt lgkmcnt(0)" ::: "memory");
    const int cidx = lane & 7;
#pragma unroll
    for (int j = 0; j < 4; ++j) { const int n = (lane >> 3) + 8 * j; const LAS float* sp = scr + (8 * cidx) * 33 + n;
        u32x4 o; o.x = pk2(sp[0 * 33], sp[1 * 33]); o.y = pk2(sp[2 * 33], sp[3 * 33]); o.z = pk2(sp[4 * 33], sp[5 * 33]); o.w = pk2(sp[6 * 33], sp[7 * 33]);
        *(u32x4*)(WT + (size_t)(dstrow0 + n) * K + k0 + 8 * cidx) = o; }
    asm volatile("s_waitcnt lgkmcnt(0)" ::: "memory");
}
__device__ __forceinline__ int p1_srccol(int nb) {
    const int t = nb >> 3, p32 = nb & 7;
    const int Lh = 64 * (p32 & 3) + 32 * (p32 >> 2), Lr = 32 * p32;
    switch (t) {
    case 0: return Lh < 128 ? O_AK + Lh : O_AV + (Lh - 128);
    case 1: return Lh < 128 ? O_BK + Lh : O_BV + (Lh - 128);
    case 2: return O_CKV + Lr;
    case 3: return O_CQ + Lr;
    case 4: return Lr < 128 ? O_CQ + 256 + Lr : (Lr == 128 ? O_CKR : -1);
    case 5: case 6: return O_AQ + 256 * (t - 5) + Lh;
    default: return O_BQ + 256 * (t - 7) + Lh;
    }
}
__device__ __forceinline__ void phase_convert_bias(Ctx& c, int l, unsigned char* lds) {
    PH_IDS(c);
    const Params* p = c.p;
    LAS float* scr = (LAS float*)((LAS unsigned char*)lds + c.wave * 16384);
    LAS float* shs = scr + 64 * 33 + 16;
    unsigned char* wb = c.ws + WS_W;
    const int gw = c.wg * 8 + c.wave, ngw = c.nwg * 8;
    constexpr int NA = 2 * (176 + 176 + 72 + 96);
    constexpr int NITB[8] = {44 * 32, 44 * 32, 6 * 24, 4 * 32, 8 * 32, 8 * 32, 8 * 32, 16 * 32};
    int totalB = 0;
#pragma unroll
    for (int i = 0; i < 8; ++i) totalB += NITB[i];
    const float* modl = c.mod + (size_t)l * 9 * MODW;
    for (int it = gw; it < NA + totalB; it += ngw) {
        if (it < NA) {
            const int kh = it & 1; int r = it >> 1; int mi, nb, sidx, goff, ldw, sc; const float* W; bf16_t* WT;
            if (r < 176) { mi = 0; nb = r; } else if (r < 352) { mi = 2; nb = r - 176; } else if (r < 424) { mi = 4; nb = r - 352; } else { mi = 5; nb = r - 424; }
            if (mi == 0) { W = p->in[7] + (size_t)l * D * 2 * DFF; ldw = 2 * DFF; WT = (bf16_t*)(wb + WO_F1IN); sidx = 0; goff = BO_F1; }
            else if (mi == 2) { W = p->in[27] + (size_t)l * D * 2 * DFF; ldw = 2 * DFF; WT = (bf16_t*)(wb + WO_F2IN); sidx = 6; goff = BO_F2; }
            else if (mi == 4) { W = p->in[10] + (size_t)l * D * INC; ldw = INC; WT = (bf16_t*)(wb + WO_P1); sidx = 3; goff = BO_P1; }
            else { W = p->in[10] + (size_t)l * D * INC; ldw = INC; WT = (bf16_t*)(wb + WO_G); sidx = 3; goff = BO_G; }
            if (mi == 0 || mi == 2) { const int j = nb >> 3, w = nb & 7; sc = w < 4 ? 128 * j + 32 * w : DFF + 128 * j + 32 * (w - 4); }
            else if (mi == 4) sc = p1_srccol(nb);
            else sc = O_G + 32 * nb;
            const int n = lane_ & 31, half = lane_ >> 5;
            float acc[5] = {0.f, 0.f, 0.f, 0.f, 0.f};
            f32x4 tn[8]; float shn[9];
            auto slab_load = [&](int kb) { const int k0 = 64 * kb;
#pragma unroll
                for (int i = 0; i < 8; ++i) tn[i] = sc >= 0 ? *(const f32x4*)(W + (size_t)(k0 + 8 * i + (lane_ >> 3)) * ldw + sc + (lane_ & 7) * 4) : (f32x4){0.f, 0.f, 0.f, 0.f};
                const float* sh = modl + sidx * D + k0 + lane_;
#pragma unroll
                for (int mb = 0; mb < 9; ++mb) shn[mb] = sh[(size_t)mb * MODW]; };
            slab_load(kh * 8);
            for (int kb = kh * 8; kb < kh * 8 + 8; ++kb) {
                const int k0 = 64 * kb;
#pragma unroll
                for (int i = 0; i < 8; ++i) { LAS float* d = scr + (8 * i + (lane_ >> 3)) * 33 + (lane_ & 7) * 4; d[0] = tn[i][0]; d[1] = tn[i][1]; d[2] = tn[i][2]; d[3] = tn[i][3]; }
#pragma unroll
                for (int mb = 0; mb < 9; ++mb) shs[lane_ * 16 + (mb < 5 ? mb : mb + 3)] = shn[mb];
                shs[lane_ * 16 + 12] = 0.f;
                if (kb + 1 < kh * 8 + 8) slab_load(kb + 1);
                asm volatile("s_waitcnt lgkmcnt(0)" ::: "memory");
#pragma unroll 8
                for (int kk = 0; kk < 64; ++kk) { const float w = scr[kk * 33 + n]; const f32x4 s4 = *(const LAS f32x4*)(shs + kk * 16 + 8 * half); const float s5 = shs[kk * 16 + 8 * half + 4];
                    acc[0] += s4[0] * w; acc[1] += s4[1] * w; acc[2] += s4[2] * w; acc[3] += s4[3] * w; acc[4] += s5 * w; }
                const int cidx = lane_ & 7;
#pragma unroll
                for (int j = 0; j < 4; ++j) { const int nn = (lane_ >> 3) + 8 * j; const LAS float* sp = scr + (8 * cidx) * 33 + nn;
                    u32x4 o; o.x = pk2(sp[0 * 33], sp[1 * 33]); o.y = pk2(sp[2 * 33], sp[3 * 33]); o.z = pk2(sp[4 * 33], sp[5 * 33]); o.w = pk2(sp[6 * 33], sp[7 * 33]);
                    *(u32x4*)(WT + (size_t)(32 * nb + nn) * D + k0 + 8 * cidx) = o; }
                asm volatile("s_waitcnt lgkmcnt(0)" ::: "memory");
            }
            float* bp = c.bias + ((size_t)kh * 9 + 5 * half) * NBIAS + goff + 32 * nb + n;
#pragma unroll
            for (int j = 0; j < 5; ++j) if (half == 0 || j < 4) bp[(size_t)j * NBIAS] = acc[j];
        } else {
            int r = it - NA, mi = 0;
#pragma unroll
            for (int i = 0; i < 7; ++i) if (mi == i && r >= NITB[i]) { r -= NITB[i]; mi = i + 1; }
            const float* W; int ldw, K, nblk; bf16_t* WT; const float* kg = nullptr;
            switch (mi) {
            case 0: W = p->in[8] + (size_t)l * DFF * D; ldw = D; K = DFF; nblk = 32; WT = (bf16_t*)(wb + WO_F1OUT); break;
            case 1: W = p->in[28] + (size_t)l * DFF * D; ldw = D; K = DFF; nblk = 32; WT = (bf16_t*)(wb + WO_F2OUT); break;
            case 2: W = p->in[17] + (size_t)l * 384 * 768; ldw = 768; K = 384; nblk = 24; WT = (bf16_t*)(wb + WO_UQ); kg = p->in[16] + l * 384; break;
            case 3: W = p->in[19] + (size_t)l * 256 * 1024; ldw = 1024; K = 256; nblk = 32; WT = (bf16_t*)(wb + WO_UKV); kg = p->in[18] + l * 256; break;
            case 4: case 5: case 6: W = p->in[22 + (mi - 4)] + (size_t)l * 512 * D; ldw = D; K = 512; nblk = 32; WT = (bf16_t*)(wb + WO_BR) + (size_t)((mi - 4 + 1) % 3) * 1024 * 512; break;
            default: W = p->in[25] + (size_t)l * D * D; ldw = D; K = D; nblk = 32; WT = (bf16_t*)(wb + WO_OUT); break;
            }
            const int kb = r / nblk, nb = r % nblk;
            int sc = 32 * nb;
            if (mi == 3) { const int t = nb >> 3, p32 = nb & 7, bj = p32 >> 2, wc = p32 & 3; sc = 128 * (2 * t + (wc & 1)) + 64 * (wc >> 1) + 32 * bj; }
            conv_item(W, ldw, K, sc, kg, WT, 32 * nb, 64 * kb, scr, lane_);
        }
    }
}
__device__ __forceinline__ void phase_convert(Ctx& c, int l, unsigned char* lds) {
    PH_IDS(c);
    const Params* p = c.p;
    LAS float* scr = (LAS float*)((LAS unsigned char*)lds + c.wave * 16384);
    unsigned char* wb = c.ws + WS_W;
    const int gw = c.wg * 8 + c.wave, ngw = c.nwg * 8;
    constexpr int NIT[12] = {16 * 176, 44 * 32, 16 * 176, 44 * 32, 16 * 72, 16 * 96, 6 * 24, 4 * 32, 8 * 32, 8 * 32, 8 * 32, 16 * 32};
    int total = 0;
#pragma unroll
    for (int i = 0; i < 12; ++i) total += NIT[i];
    for (int it = gw; it < total; it += ngw) {
        int r = it, mi = 0;
#pragma unroll
        for (int i = 0; i < 11; ++i) if (mi == i && r >= NIT[i]) { r -= NIT[i]; mi = i + 1; }
        const float* W; int ldw, K, nblk; bf16_t* WT; const float* kg = nullptr;
        switch (mi) {
        case 0: W = p->in[7] + (size_t)l * D * 2 * DFF; ldw = 2 * DFF; K = D; nblk = 176; WT = (bf16_t*)(wb + WO_F1IN); break;
        case 1: W = p->in[8] + (size_t)l * DFF * D; ldw = D; K = DFF; nblk = 32; WT = (bf16_t*)(wb + WO_F1OUT); break;
        case 2: W = p->in[27] + (size_t)l * D * 2 * DFF; ldw = 2 * DFF; K = D; nblk = 176; WT = (bf16_t*)(wb + WO_F2IN); break;
        case 3: W = p->in[28] + (size_t)l * DFF * D; ldw = D; K = DFF; nblk = 32; WT = (bf16_t*)(wb + WO_F2OUT); break;
        case 4: W = p->in[10] + (size_t)l * D * INC; ldw = INC; K = D; nblk = 72; WT = (bf16_t*)(wb + WO_P1); break;
        case 5: W = p->in[10] + (size_t)l * D * INC; ldw = INC; K = D; nblk = 96; WT = (bf16_t*)(wb + WO_G); break;
        case 6: W = p->in[17] + (size_t)l * 384 * 768; ldw = 768; K = 384; nblk = 24; WT = (bf16_t*)(wb + WO_UQ); kg = p->in[16] + l * 384; break;
        case 7: W = p->in[19] + (size_t)l * 256 * 1024; ldw = 1024; K = 256; nblk = 32; WT = (bf16_t*)(wb + WO_UKV); kg = p->in[18] + l * 256; break;
        case 8: case 9: case 10: W = p->in[22 + (mi - 8)] + (size_t)l * 512 * D; ldw = D; K = 512; nblk = 32; WT = (bf16_t*)(wb + WO_BR) + (size_t)(mi - 8) * 1024 * 512; break;
        default: W = p->in[25] + (size_t)l * D * D; ldw = D; K = D; nblk = 32; WT = (bf16_t*)(wb + WO_OUT); break;
        }
        const int kb = r / nblk, nb = r % nblk;
        int sc;
        if (mi == 0 || mi == 2) { const int j = nb >> 3, w = nb & 7; sc = w < 4 ? 128 * j + 32 * w : DFF + 128 * j + 32 * (w - 4); }
        else if (mi == 4) sc = p1_srccol(nb);
        else if (mi == 5) sc = O_G + 32 * nb;
        else if (mi == 7) { const int t = nb >> 3, p32 = nb & 7, bj = p32 >> 2, wc = p32 & 3; sc = 128 * (2 * t + (wc & 1)) + 64 * (wc >> 1) + 32 * bj; }
        else sc = 32 * nb;
        conv_item(W, ldw, K, sc, kg, WT, 32 * nb, 64 * kb, scr, lane_);
    }
}

namespace pg8 {
constexpr int BM = 256, BK = 64, HALF = 128, HTB = HALF * BK * 2, STAGE_BYTES = 8 * HTB, NXCD = 8, WGM = 8;
__host__ __device__ __forceinline__ int lds_byte(int r, int c) { const int st = (r >> 4) * 2 + (c >> 5), rr = r & 15, cc = c & 31, ob = rr * 64 + cc * 2; return st * 1024 + (ob ^ (((ob >> 9) & 1) << 5)); }
__host__ __device__ __forceinline__ void stage_rc(int b, int& R, int& C) { const int st = b / 1024, sb = b % 1024, swz = sb ^ (((sb >> 9) & 1) << 5); R = (st >> 1) * 16 + swz / 64; C = (st & 1) * 32 + (swz % 64) / 2; }
__host__ __device__ __forceinline__ int perm32(int rho) { const int n = rho >> 4, i = rho & 15; return 8 * (i >> 2) + 4 * n + (i & 3); }
struct Unit { int pm, pn, z; };
struct Gemm { const bf16_t* A; const bf16_t* Bt; int M, N, K, lda; int zA = 0, zB = 0; int rap = 0; };
__device__ __forceinline__ const char* gemm_a(const Gemm& g, int z) { return (const char*)(g.A + (size_t)z * g.zA); }
__device__ __forceinline__ const char* gemm_b(const Gemm& g, int z) { return (const char*)(g.Bt + (size_t)z * g.zB); }
struct StaticOrder {
    int nM, nN, nwg, G, c, pm0, R0, G1, nlp, cx0;
    __device__ void init(int M, int N, int G_, int c_) { nM = M / BM; nN = N / BM; nwg = nM * nN; G = G_; c = c_; pm0 = 0; R0 = 1 << 20; G1 = G_; nlp = 1 << 20; cx0 = 0; }
    __device__ void init_sub(int pm0_, int npm, int N, int G_, int c_, int R0_, int G1_) { nM = npm; nN = N / BM; nwg = nM * nN; G = G_; c = c_; pm0 = pm0_; R0 = R0_; G1 = G1_; nlp = 1 << 20; cx0 = 0; }
    __device__ void init_grp(int lat0, int nlat, int ctx0, int nctx, bool all, int N, int G_, int c_) { nM = nlat + (all ? nctx : 0); nN = N / BM; nwg = nM * nN; G = G_; c = c_; pm0 = lat0; R0 = 1 << 20; G1 = G_; nlp = nlat; cx0 = ctx0; }
    __device__ bool next(int i, Unit& u) const {
        if (c < 0) return false;
        long L; if (i < R0) L = (long)i * G + c; else { if (c >= G1) return false; L = (long)R0 * G + (long)(i - R0) * G1 + c; }
        if (L >= nwg) return false;
        int wgid = (int)L; { const int q = nwg / NXCD, r = nwg % NXCD, xcd = wgid % NXCD, off = wgid / NXCD; wgid = (xcd < r ? xcd * (q + 1) : r * (q + 1) + (xcd - r) * q) + off; }
        const int nig = WGM * nN, gid = wgid / nig, fm = gid * WGM, gsz = (nM - fm) < WGM ? (nM - fm) : WGM;
        { const int j = fm + ((wgid % nig) % gsz); u.pm = j < nlp ? pm0 + j : cx0 + (j - nlp); } u.pn = (wgid % nig) / gsz; u.z = 0; return true;
    }
};
struct TripleOrder {
    StaticOrder b;
    __device__ bool next(int i, Unit& u) const { if (!b.next(i / 3, u)) return false; u.z = i % 3; return true; }
};
typedef float f32x2_t __attribute__((ext_vector_type(2))); typedef __bf16 bf16x2_t __attribute__((ext_vector_type(2)));
__device__ __forceinline__ unsigned cvt_pk_bf16(float lo, float hi) { f32x2_t v = {lo, hi}; bf16x2_t b = __builtin_convertvector(v, bf16x2_t); return __builtin_bit_cast(unsigned, b); }
__device__ __forceinline__ u32x4 pack8(const f32x4& a, const f32x4& b) { u32x4 w; w.x = cvt_pk_bf16(a[0], a[1]); w.y = cvt_pk_bf16(a[2], a[3]); w.z = cvt_pk_bf16(b[0], b[1]); w.w = cvt_pk_bf16(b[2], b[3]); return w; }
__device__ __forceinline__ float fast_sigmoid(float v) { return __builtin_amdgcn_rcpf(1.0f + __builtin_amdgcn_exp2f(-LOG2E * v)); }

typedef f32x4 Acc[2][2][4][2];
struct RowScale { const float* ss; const float* bias; };
constexpr int PRE_OFF = 131072 + 2048, PRE_TAB = 2048;
struct PreRegs { f32x4 a, b; float b0, b1; };
__device__ __forceinline__ void pre_issue(const RowScale& rs, const Unit& u, int wid, int lane, PreRegs& r) {
    const int row = u.pm * BM + wid * 32 + (lane & 31), mb = u.pm < NLAT / BM ? (u.pm >> 3) : 8;
    const float* sp = rs.ss + (size_t)row * 16 + 8 * (lane >> 5); r.a = *(const f32x4*)sp; r.b = *(const f32x4*)(sp + 4);
    const float* bp = rs.bias + (size_t)mb * NBIAS + u.pn * BM + wid * 32 + (lane & 31); r.b0 = bp[0]; r.b1 = bp[(size_t)9 * NBIAS];
}
__device__ __forceinline__ void pre_finish(const PreRegs& r, LAS float* tab, int wid, int lane) {
    float v = ((r.a.x + r.a.y) + (r.a.z + r.a.w)) + ((r.b.x + r.b.y) + (r.b.z + r.b.w)); v += __shfl_xor(v, 32);
    if (lane < 32) { tab[wid * 32 + lane] = __builtin_amdgcn_rsqf(v * (1.0f / 1024.0f) + EPS); tab[256 + wid * 32 + lane] = r.b0 + r.b1; }
}
struct Pre { float rr[2][4]; f32x4 bv[2][2]; };
__device__ __forceinline__ void pre_read(const LAS float* tab, int wr, int wc, int fr, int fq, Pre& p) {
#pragma unroll
    for (int ai = 0; ai < 2; ++ai)
#pragma unroll
        for (int m = 0; m < 4; ++m) p.rr[ai][m] = tab[ai * HALF + wr * 64 + m * 16 + fr];
#pragma unroll
    for (int bj = 0; bj < 2; ++bj)
#pragma unroll
        for (int n = 0; n < 2; ++n) p.bv[bj][n] = *(const LAS f32x4*)(tab + 256 + bj * HALF + wc * 32 + 8 * fq + 4 * n);
}
template <class E, class = void> struct epi_has_pre { static constexpr bool value = false; };
template <class E> struct epi_has_pre<E, decltype((void)E::HAS_PRE)> { static constexpr bool value = true; };

template <class Epi, class Sched, bool ALIGN_EPI>
__device__ __forceinline__ void gemm_phase(LAS unsigned char* lds, int wave, const Gemm g, const Sched& S, const Epi& E) {
    const int lane = lane_id(), wid = wave, tid = wid * 64 + lane, wr = wid >> 2, wc = wid & 3, fr = lane & 15, fq = lane >> 4;
    const int K = g.K, nt = K / BK, lda = g.lda;
    unsigned voffA[2], voffB[2];
#pragma unroll
    for (int i = 0; i < 2; ++i) { int R, C; stage_rc(tid * 16 + i * 8192, R, C); const int Rb = Epi::PERM ? ((R & ~31) + perm32(R & 31)) : R;
        voffA[i] = (unsigned)(R * lda + C) * 2u; voffB[i] = (unsigned)(Rb * K + C) * 2u; }
    const size_t kstep = (size_t)(BK * 2);
    const size_t hstepA = (size_t)HALF * lda * 2, hstepB = (size_t)HALF * K * 2;
    const size_t tstepA = 2 * hstepA, tstepB = 2 * hstepB;
    const unsigned ldsw = (unsigned)wid * 1024u;
    const int aoff = lds_byte(wr * 64 + fr, fq * 8), boff = lds_byte(wc * 32 + fr, fq * 8);
#define PG8_SA(b, h) (((b) * 2 + (h)) * HTB)
#define PG8_SB(b, h) ((4 + (b) * 2 + (h)) * HTB)
#define PG8_STAGE(bufoff, gbase, voff) do { _Pragma("unroll") for (int _i = 0; _i < 2; ++_i) \
        __builtin_amdgcn_global_load_lds((const unsigned*)((const char*)(gbase) + (voff)[_i]), (LAS unsigned*)(lds + (bufoff) + ldsw + _i * 8192), 16, 0, 0); } while (0)
#define PG8_LDA(dst, b, h) do { _Pragma("unroll") for (int m = 0; m < 4; ++m) _Pragma("unroll") for (int k = 0; k < 2; ++k) dst[m][k] = *(const LAS bf16x8*)(lds + PG8_SA(b, h) + aoff + m * 2048 + k * 1024); } while (0)
#define PG8_LDB(dst, b, h) do { _Pragma("unroll") for (int n = 0; n < 2; ++n) _Pragma("unroll") for (int k = 0; k < 2; ++k) dst[n][k] = *(const LAS bf16x8*)(lds + PG8_SB(b, h) + boff + n * 2048 + k * 1024); } while (0)
#define PG8_MMA(ai, bj, At, Bt) do { __builtin_amdgcn_s_setprio(1); _Pragma("unroll") for (int m = 0; m < 4; ++m) _Pragma("unroll") for (int n = 0; n < 2; ++n) _Pragma("unroll") for (int k = 0; k < 2; ++k) \
        acc[ai][bj][m][n] = __builtin_amdgcn_mfma_f32_16x16x32_bf16(Bt[n][k], At[m][k], acc[ai][bj][m][n], 0, 0, 0); __builtin_amdgcn_s_setprio(0); } while (0)
#define PG8_WAIT_V(n) asm volatile("s_waitcnt vmcnt(" #n ")" ::: "memory")
#define PG8_WAIT_L(n) asm volatile("s_waitcnt lgkmcnt(" #n ")" ::: "memory")
#define PG8_BAR __builtin_amdgcn_s_barrier()
#define PG8_SCHED __builtin_amdgcn_sched_barrier(0)
    Unit cur, nxt; int ui = 0;
    if (!S.next(0, cur)) return;
    Acc acc;
#pragma unroll
    for (int a = 0; a < 2; ++a)
#pragma unroll
        for (int b = 0; b < 2; ++b)
#pragma unroll
            for (int m = 0; m < 4; ++m)
#pragma unroll
                for (int n = 0; n < 2; ++n) acc[a][b][m][n] = (f32x4){0.f, 0.f, 0.f, 0.f};
    bf16x8 At[4][2], B0[2][2], B1[2][2];
    if constexpr (epi_has_pre<Epi>::value) { PreRegs r0; pre_issue(E.rs, cur, wid, lane, r0); pre_finish(r0, (LAS float*)(lds + PRE_OFF), wid, lane); }
    const char* cA = gemm_a(g, cur.z) + (g.rap ? ra_panel_off(cur.pm, g.rap) : (size_t)cur.pm * tstepA); const char* cB = gemm_b(g, cur.z) + (size_t)cur.pn * tstepB;
    PG8_STAGE(PG8_SB(0, 0), cB, voffB); PG8_STAGE(PG8_SB(0, 1), cB + hstepB, voffB); PG8_STAGE(PG8_SA(0, 0), cA, voffA); PG8_STAGE(PG8_SA(0, 1), cA + hstepA, voffA);
    if (wr == 1) PG8_BAR;
    PG8_WAIT_V(2); PG8_BAR;
    PG8_STAGE(PG8_SB(1, 0), cB + kstep, voffB); PG8_STAGE(PG8_SA(1, 0), cA + kstep, voffA); PG8_STAGE(PG8_SB(1, 1), cB + hstepB + kstep, voffB);
    PG8_WAIT_V(6); PG8_BAR;
    for (;;) {
        const bool has_next = S.next(ui + 1, nxt);
        const char* nA = has_next ? gemm_a(g, nxt.z) + (g.rap ? ra_panel_off(nxt.pm, g.rap) : (size_t)nxt.pm * tstepA) : cA; const char* nB = has_next ? gemm_b(g, nxt.z) + (size_t)nxt.pn * tstepB : cB;
#pragma unroll 1
        for (int t = 0; t < nt; t += 2) {
            const bool last = (t == nt - 2);
            const char* a1 = cA + (size_t)(t + 1) * kstep;
            const char* a2 = last ? nA : cA + (size_t)(t + 2) * kstep; const char* b2 = last ? nB : cB + (size_t)(t + 2) * kstep;
            const char* a3 = a2 + kstep; const char* b3 = b2 + kstep;
            PG8_LDB(B0, 0, 0); PG8_LDB(B1, 0, 1); PG8_SCHED; PG8_LDA(At, 0, 0); PG8_STAGE(PG8_SA(1, 1), a1 + hstepA, voffA);
            PG8_WAIT_V(8); PG8_WAIT_L(0); PG8_BAR; PG8_MMA(0, 0, At, B0); PG8_MMA(0, 1, At, B1); PG8_BAR; PG8_SCHED;
            PG8_LDA(At, 0, 1); PG8_STAGE(PG8_SB(0, 0), b2, voffB); PG8_STAGE(PG8_SB(0, 1), b2 + hstepB, voffB); PG8_STAGE(PG8_SA(0, 0), a2, voffA);
            PG8_WAIT_V(8); PG8_WAIT_L(0); PG8_BAR; PG8_MMA(1, 0, At, B0); PG8_MMA(1, 1, At, B1); PG8_BAR; PG8_SCHED;
            PG8_LDB(B0, 1, 0); PG8_LDB(B1, 1, 1); PG8_SCHED; PG8_LDA(At, 1, 0); PG8_STAGE(PG8_SA(0, 1), a2 + hstepA, voffA);
            PG8_WAIT_V(8); PG8_WAIT_L(0); PG8_BAR; PG8_MMA(0, 0, At, B0); PG8_MMA(0, 1, At, B1); PG8_BAR; PG8_SCHED;
            PG8_LDA(At, 1, 1); PG8_STAGE(PG8_SB(1, 0), b3, voffB); PG8_STAGE(PG8_SB(1, 1), b3 + hstepB, voffB); PG8_STAGE(PG8_SA(1, 0), a3, voffA);
            PG8_WAIT_V(8); PG8_WAIT_L(0); PG8_BAR; PG8_MMA(1, 0, At, B0); PG8_MMA(1, 1, At, B1); PG8_BAR; PG8_SCHED;
        }
        if constexpr (ALIGN_EPI) { if (wr == 0) PG8_BAR; }
        { int fr_ = fr, fq_ = fq; asm volatile("" : "+v"(fr_), "+v"(fq_));
          if constexpr (epi_has_pre<Epi>::value) { PreRegs rn; if (has_next) pre_issue(E.rs, nxt, wid, lane, rn);
              Pre pre; pre_read((const LAS float*)(lds + PRE_OFF + (ui & 1) * PRE_TAB), wr, wc, fr_, fq_, pre);
#if defined(FA_FAKE) && FA_FAKE == 4
              if (wid == 0 && fr_ == 0) E(acc, cur, wr, wc, fr_, fq_, pre);
#else
              E(acc, cur, wr, wc, fr_, fq_, pre);
#endif
              if (has_next) pre_finish(rn, (LAS float*)(lds + PRE_OFF + ((ui + 1) & 1) * PRE_TAB), wid, lane); }
          else E(acc, cur, wr, wc, fr_, fq_); }
        if (!has_next) break;
#pragma unroll
        for (int a = 0; a < 2; ++a)
#pragma unroll
            for (int b = 0; b < 2; ++b)
#pragma unroll
                for (int m = 0; m < 4; ++m)
#pragma unroll
                    for (int n = 0; n < 2; ++n) acc[a][b][m][n] = (f32x4){0.f, 0.f, 0.f, 0.f};
        cur = nxt; cA = nA; cB = nB; ++ui;
        if constexpr (ALIGN_EPI) { if (wr == 1) PG8_BAR; }
    }
    PG8_WAIT_V(0);
    if constexpr (!ALIGN_EPI) { if (wr == 0) PG8_BAR; }
    PG8_BAR;
#undef PG8_SA
#undef PG8_SB
#undef PG8_STAGE
#undef PG8_LDA
#undef PG8_LDB
#undef PG8_MMA
#undef PG8_WAIT_V
#undef PG8_WAIT_L
#undef PG8_BAR
#undef PG8_SCHED
}

struct EpiSwiGLU {
    static constexpr bool PERM = true;
    bf16_t* ACT;
    __device__ __forceinline__ void operator()(const Acc& acc, const Unit& u, int wr, int wc, int fr, int fq) const {
        const int row0 = u.pm * BM + wr * 64 + fr, col0 = u.pn * 128 + wc * 32 + 8 * fq;
#pragma unroll
        for (int ai = 0; ai < 2; ++ai)
#pragma unroll
            for (int m = 0; m < 4; ++m) {
                f32x4 o[2];
#pragma unroll
                for (int n = 0; n < 2; ++n) { const f32x4 gt = acc[ai][0][m][n], up = acc[ai][1][m][n];
#pragma unroll
                    for (int e = 0; e < 4; ++e) o[n][e] = gt[e] * fast_sigmoid(gt[e]) * up[e]; }
                *(u32x4*)(ACT + (size_t)(row0 + ai * HALF + m * 16) * DFF + col0) = pack8(o[0], o[1]);
            }
    }
};
struct EpiRes {
    static constexpr bool PERM = false;
    const float* base_lat; const float* base_ctx; float* out_lat; float* out_ctx; const float* modl; int gi; float coef;
    __device__ __forceinline__ void operator()(const Acc& acc, const Unit& u, int wr, int wc, int fr, int fq) const {
        const bool lat = u.pm < NLAT / BM; const int pmr = lat ? u.pm : u.pm - NLAT / BM;
        const float* bp = (lat ? base_lat : base_ctx) + (size_t)pmr * BM * D; float* op = (lat ? out_lat : out_ctx) + (size_t)pmr * BM * D;
        const float* md = modl + (size_t)(lat ? (u.pm >> 3) : 8) * MODW + gi * D;
        const int col0 = u.pn * BM + wc * 32 + 4 * fq;
        f32x4 mv[2][2];
#pragma unroll
        for (int bj = 0; bj < 2; ++bj)
#pragma unroll
            for (int n = 0; n < 2; ++n) mv[bj][n] = *(const f32x4*)(md + col0 + bj * HALF + n * 16) * coef;
#pragma unroll
        for (int ai = 0; ai < 2; ++ai)
#pragma unroll
            for (int m = 0; m < 4; ++m) { const size_t off = (size_t)(ai * HALF + wr * 64 + m * 16 + fr) * D + col0;
#pragma unroll
                for (int bj = 0; bj < 2; ++bj)
#pragma unroll
                    for (int n = 0; n < 2; ++n) { const f32x4 bs = *(const f32x4*)(bp + off + bj * HALF + n * 16); *(f32x4*)(op + off + bj * HALF + n * 16) = bs + mv[bj][n] * acc[ai][bj][m][n]; }
                if (m & 1) asm volatile("" ::: "memory"); }
    }
};
struct EpiInProj {
    static constexpr bool PERM = true;
    bf16_t* P1; float* rowss; const float* rope; const float* gqa; const float* gka; const float* gqb; const float* gkb;
    __device__ __forceinline__ void operator()(const Acc& acc, const Unit& u, int wr, int wc, int fr, int fq) const {
        const int pn = u.pn; const bool lat = u.pm < NLAT / BM;
        const int row0 = u.pm * BM + wr * 64 + fr;
        if (pn >= 2 && pn <= 4) {
            const int dstc = (pn == 2 ? P_CKV : (pn == 3 ? P_CQ : P_CQ + 256)) + wc * 32 + 8 * fq;
#pragma unroll
            for (int ai = 0; ai < 2; ++ai)
#pragma unroll
                for (int m = 0; m < 4; ++m) { const int row = row0 + ai * HALF + m * 16; float ss = 0.f;
#pragma unroll
                    for (int bj = 0; bj < 2; ++bj) { const f32x4 v0 = acc[ai][bj][m][0], v1 = acc[ai][bj][m][1];
                        *(u32x4*)(P1 + (size_t)row * P1W + dstc + bj * HALF) = pack8(v0, v1);
                        if (bj == 0 || pn != 4) ss += ((v0[0] * v0[0] + v0[1] * v0[1]) + (v0[2] * v0[2] + v0[3] * v0[3])) + ((v1[0] * v1[0] + v1[1] * v1[1]) + (v1[2] * v1[2] + v1[3] * v1[3])); }
                    ss += __shfl_xor(ss, 16); ss += __shfl_xor(ss, 32);
                    if (fq == 0) rowss[(size_t)row * 12 + (pn - 2) * 4 + wc] = ss; }
            return;
        }
        int dst; const float* gn = nullptr; float qs = 1.0f;
        if (pn == 0) { if (wc < 2) { dst = P_KA + 64 * wc; gn = gka; } else dst = P_VA + 64 * (wc - 2); }
        else if (pn == 1) { if (wc < 2) { dst = P_KB + 64 * wc; gn = gkb; } else dst = P_VB + 64 * (wc - 2); }
        else if (pn <= 6) { dst = P_QA + 64 * (4 * (pn - 5) + wc); gn = gqa; qs = QSC64; }
        else { dst = P_QB + 64 * (4 * (pn - 7) + wc); gn = gqb; qs = QSC64; }
        dst += 8 * fq;
        if (gn == nullptr) {
#pragma unroll
            for (int ai = 0; ai < 2; ++ai)
#pragma unroll
                for (int m = 0; m < 4; ++m) { const int row = row0 + ai * HALF + m * 16;
#pragma unroll
                    for (int bj = 0; bj < 2; ++bj) *(u32x4*)(P1 + (size_t)row * P1W + dst + 32 * bj) = pack8(acc[ai][bj][m][0], acc[ai][bj][m][1]); }
            return;
        }
        f32x4 gv[2][2];
#pragma unroll
        for (int bj = 0; bj < 2; ++bj)
#pragma unroll
            for (int n = 0; n < 2; ++n) gv[bj][n] = *(const f32x4*)(gn + 32 * bj + 8 * fq + 4 * n) * qs;
#pragma unroll
        for (int ai = 0; ai < 2; ++ai)
#pragma unroll
            for (int m = 0; m < 4; ++m) { const int row = row0 + ai * HALF + m * 16; float ss = 0.f;
#pragma unroll
                for (int bj = 0; bj < 2; ++bj)
#pragma unroll
                    for (int n = 0; n < 2; ++n) { const f32x4 v = acc[ai][bj][m][n]; ss += (v[0] * v[0] + v[1] * v[1]) + (v[2] * v[2] + v[3] * v[3]); }
                ss += __shfl_xor(ss, 16); ss += __shfl_xor(ss, 32);
                const float rstd = __builtin_amdgcn_rsqf(ss * (1.0f / 64.0f) + EPS);
                const float* rp = rope + (size_t)(row & 2047) * 64;
#pragma unroll
                for (int bj = 0; bj < 2; ++bj) { f32x4 o[2];
#pragma unroll
                    for (int n = 0; n < 2; ++n) { const f32x4 v = acc[ai][bj][m][n] * rstd * gv[bj][n];
                        if (lat) { const f32x4 cs = *(const f32x4*)(rp + (16 * bj + 4 * fq + 2 * n) * 2);
                            o[n][0] = v[0] * cs[0] - v[1] * cs[1]; o[n][1] = v[0] * cs[1] + v[1] * cs[0]; o[n][2] = v[2] * cs[2] - v[3] * cs[3]; o[n][3] = v[2] * cs[3] + v[3] * cs[2]; }
                        else o[n] = v; }
                    *(u32x4*)(P1 + (size_t)row * P1W + dst + 32 * bj) = pack8(o[0], o[1]); }
            }
    }
};
template <int WHICH  > struct EpiMlaUp {
    static constexpr bool PERM = true;
    bf16_t* O; const float* rowss;
    __device__ __forceinline__ void operator()(const Acc& acc, const Unit& u, int wr, int wc, int fr, int fq) const {
        constexpr int PITCH = WHICH == 0 ? 768 : 1024;
        const int row0 = u.pm * BM + wr * 64 + fr, col0 = u.pn * BM + wc * 32 + 8 * fq;
#pragma unroll
        for (int ai = 0; ai < 2; ++ai)
#pragma unroll
            for (int m = 0; m < 4; ++m) { const int row = row0 + ai * HALF + m * 16; float r;
                if (WHICH == 0) { const f32x4 a = *(const f32x4*)(rowss + (size_t)row * 12 + 4), b = *(const f32x4*)(rowss + (size_t)row * 12 + 8); r = __builtin_amdgcn_rsqf((((a.x + a.y) + (a.z + a.w)) + ((b.x + b.y) + (b.z + b.w))) * (1.0f / 384.0f) + EPS); }
                else { const f32x4 a = *(const f32x4*)(rowss + (size_t)row * 12); r = __builtin_amdgcn_rsqf(((a.x + a.y) + (a.z + a.w)) * (1.0f / 256.0f) + EPS); }
#pragma unroll
                for (int bj = 0; bj < 2; ++bj) *(u32x4*)(O + (size_t)row * PITCH + col0 + bj * HALF) = pack8(acc[ai][bj][m][0] * r, acc[ai][bj][m][1] * r);
                asm volatile("" ::: "memory"); }
    }
};
struct EpiMlaQ {
    static constexpr bool PERM = true;
    bf16_t* O; const float* rowss; float* ssq;
    __device__ __forceinline__ void operator()(const Acc& acc, const Unit& u, int wr, int wc, int fr, int fq) const {
        const int row0 = u.pm * BM + wr * 64 + fr, col0 = u.pn * BM + wc * 32 + 8 * fq;
        bf16_t* Op = (bf16_t*)((unsigned char*)O + RAS_QC + ra_panel_off(u.pm, 1536)) - (size_t)u.pm * BM * 768;
        float rr[2][4];
        { typedef float f32x2v __attribute__((ext_vector_type(2))); f32x2v t[2][4];
#pragma unroll
          for (int ai = 0; ai < 2; ++ai)
#pragma unroll
              for (int m = 0; m < 4; ++m) t[ai][m] = *(const f32x2v*)(rowss + (size_t)(row0 + ai * HALF + m * 16) * 12 + 4 + 2 * fq);
#pragma unroll
          for (int ai = 0; ai < 2; ++ai)
#pragma unroll
              for (int m = 0; m < 4; ++m) { float v = t[ai][m].x + t[ai][m].y; v += __shfl_xor(v, 16); v += __shfl_xor(v, 32); rr[ai][m] = __builtin_amdgcn_rsqf(v * (1.0f / 384.0f) + EPS); } }
#pragma unroll
        for (int ai = 0; ai < 2; ++ai)
#pragma unroll
            for (int m = 0; m < 4; ++m) { const int row = row0 + ai * HALF + m * 16;
                const float r = rr[ai][m];
#pragma unroll
                for (int bj = 0; bj < 2; ++bj) { const f32x4 v0 = acc[ai][bj][m][0] * r, v1 = acc[ai][bj][m][1] * r;
                    *(u32x4*)(Op + (size_t)row * 768 + col0 + bj * HALF) = pack8(v0, v1);
                    float ss = ((v0[0] * v0[0] + v0[1] * v0[1]) + (v0[2] * v0[2] + v0[3] * v0[3])) + ((v1[0] * v1[0] + v1[1] * v1[1]) + (v1[2] * v1[2] + v1[3] * v1[3]));
                    ss += __shfl_xor(ss, 16); ss += __shfl_xor(ss, 32);
                    if (fq == 0) ssq[(size_t)row * 24 + 8 * u.pn + 4 * bj + wc] = ss; }
                if (m & 1) asm volatile("" ::: "memory"); }
    }
};
struct EpiMlaKV {
    static constexpr bool PERM = true;
    bf16_t* KC; bf16_t* VC; const bf16_t* P1; const float* rowss; const float* gk; const float* rope;
    __device__ __forceinline__ void operator()(const Acc& acc, const Unit& u, int wr, int wc, int fr, int fq) const {
        const int row0 = u.pm * BM + wr * 64 + fr; const bool lat = u.pm < NLAT / BM;
        const int hh = 2 * u.pn + (wc & 1);
        bf16_t* KCp = (bf16_t*)((unsigned char*)KC + RAS_KC + ra_panel_off(u.pm, 1536)) - (size_t)u.pm * BM * 768;
        bf16_t* VCp = (bf16_t*)((unsigned char*)VC + RAS_VC + ra_panel_off(u.pm, 1024)) - (size_t)u.pm * BM * 512;
        float rr[2][4];
        { float t[2][4];
#pragma unroll
          for (int ai = 0; ai < 2; ++ai)
#pragma unroll
              for (int m = 0; m < 4; ++m) t[ai][m] = rowss[(size_t)(row0 + ai * HALF + m * 16) * 12 + fq];
#pragma unroll
          for (int ai = 0; ai < 2; ++ai)
#pragma unroll
              for (int m = 0; m < 4; ++m) { float v = t[ai][m]; v += __shfl_xor(v, 16); v += __shfl_xor(v, 32); rr[ai][m] = __builtin_amdgcn_rsqf(v * (1.0f / 256.0f) + EPS); } }
        if (wc >= 2) {
#pragma unroll
            for (int ai = 0; ai < 2; ++ai)
#pragma unroll
                for (int m = 0; m < 4; ++m) { const int row = row0 + ai * HALF + m * 16;
                    const float r = rr[ai][m];
#pragma unroll
                    for (int bj = 0; bj < 2; ++bj) *(u32x4*)(VCp + (size_t)row * 512 + 64 * hh + 32 * bj + 8 * fq) = pack8(acc[ai][bj][m][0] * r, acc[ai][bj][m][1] * r);
                    if (m & 1) asm volatile("" ::: "memory"); }
            return;
        }
        f32x4 gv[2][2], gr[2];
#pragma unroll
        for (int bj = 0; bj < 2; ++bj)
#pragma unroll
            for (int n = 0; n < 2; ++n) gv[bj][n] = *(const f32x4*)(gk + 32 * bj + 8 * fq + 4 * n);
        gr[0] = *(const f32x4*)(gk + 64 + 8 * fq); gr[1] = *(const f32x4*)(gk + 64 + 8 * fq + 4);
#pragma unroll
        for (int ai = 0; ai < 2; ++ai)
#pragma unroll
            for (int m = 0; m < 4; ++m) { const int row = row0 + ai * HALF + m * 16;
                const float r = rr[ai][m];
                const u32x4 kw = *(const u32x4*)(P1 + (size_t)row * P1W + P_CKR + 8 * fq);
                f32x4 k0, k1;
                k0[0] = __uint_as_float(kw.x << 16); k0[1] = __uint_as_float(kw.x & 0xffff0000u); k0[2] = __uint_as_float(kw.y << 16); k0[3] = __uint_as_float(kw.y & 0xffff0000u);
                k1[0] = __uint_as_float(kw.z << 16); k1[1] = __uint_as_float(kw.z & 0xffff0000u); k1[2] = __uint_as_float(kw.w << 16); k1[3] = __uint_as_float(kw.w & 0xffff0000u);
                float ss = ((k0[0] * k0[0] + k0[1] * k0[1]) + (k0[2] * k0[2] + k0[3] * k0[3])) + ((k1[0] * k1[0] + k1[1] * k1[1]) + (k1[2] * k1[2] + k1[3] * k1[3]));
                f32x4 v[2][2];
#pragma unroll
                for (int bj = 0; bj < 2; ++bj)
#pragma unroll
                    for (int n = 0; n < 2; ++n) { v[bj][n] = acc[ai][bj][m][n] * r; const f32x4 t = v[bj][n]; ss += (t[0] * t[0] + t[1] * t[1]) + (t[2] * t[2] + t[3] * t[3]); }
                ss += __shfl_xor(ss, 16); ss += __shfl_xor(ss, 32);
                const float rstd = __builtin_amdgcn_rsqf(ss * (1.0f / 96.0f) + EPS);
                bf16_t* o = KCp + (size_t)row * 768 + 96 * hh;
#pragma unroll
                for (int bj = 0; bj < 2; ++bj) *(u32x4*)(o + 32 * bj + 8 * fq) = pack8(v[bj][0] * rstd * gv[bj][0], v[bj][1] * rstd * gv[bj][1]);
                k0 = k0 * rstd * gr[0]; k1 = k1 * rstd * gr[1];
                if (lat) { const float* rp = rope + ((size_t)(row & 2047) * 16 + 4 * fq) * 2; const f32x4 c0 = *(const f32x4*)rp, c1 = *(const f32x4*)(rp + 4);
                    f32x4 t0, t1; t0[0] = k0[0] * c0[0] - k0[1] * c0[1]; t0[1] = k0[0] * c0[1] + k0[1] * c0[0]; t0[2] = k0[2] * c0[2] - k0[3] * c0[3]; t0[3] = k0[2] * c0[3] + k0[3] * c0[2];
                    t1[0] = k1[0] * c1[0] - k1[1] * c1[1]; t1[1] = k1[0] * c1[1] + k1[1] * c1[0]; t1[2] = k1[2] * c1[2] - k1[3] * c1[3]; t1[3] = k1[2] * c1[3] + k1[3] * c1[2]; k0 = t0; k1 = t1; }
                *(u32x4*)(o + 64 + 8 * fq) = pack8(k0, k1);
                if (m & 1) asm volatile("" ::: "memory"); }
    }
};
struct EpiSigmoid {
    static constexpr bool PERM = true;
    bf16_t* G;
    __device__ __forceinline__ void operator()(const Acc& acc, const Unit& u, int wr, int wc, int fr, int fq) const {
        const int row0 = u.pm * BM + wr * 64 + fr, col0 = u.pn * BM + wc * 32 + 8 * fq;
#pragma unroll
        for (int ai = 0; ai < 2; ++ai)
#pragma unroll
            for (int m = 0; m < 4; ++m)
#pragma unroll
                for (int bj = 0; bj < 2; ++bj) { f32x4 o[2];
#pragma unroll
                    for (int n = 0; n < 2; ++n)
#pragma unroll
                        for (int e = 0; e < 4; ++e) o[n][e] = fast_sigmoid(acc[ai][bj][m][n][e]);
                    *(u32x4*)(G + (size_t)(row0 + ai * HALF + m * 16) * 3072 + col0 + bj * HALF) = pack8(o[0], o[1]); }
    }
};
template <int Z> struct EpiMerge {
    static constexpr bool PERM = true;
    bf16_t* Mm; const bf16_t* G;
    __device__ __forceinline__ void operator()(const Acc& acc, const Unit& u, int wr, int wc, int fr, int fq) const {
        const int row0 = u.pm * BM + wr * 64 + fr, col0 = u.pn * BM + wc * 32 + 8 * fq;
#pragma unroll
        for (int ai = 0; ai < 2; ++ai)
#pragma unroll
            for (int m = 0; m < 4; ++m)
#pragma unroll
                for (int bj = 0; bj < 2; ++bj) { const size_t row = (size_t)(row0 + ai * HALF + m * 16);
                    const u32x4 gw = *(const u32x4*)(G + row * 3072 + Z * 1024 + col0 + bj * HALF);
                    u32x4 mw = (u32x4){0u, 0u, 0u, 0u}; if (Z > 0) mw = *(const u32x4*)(Mm + row * P1W + col0 + bj * HALF);
                    f32x4 o[2];
#pragma unroll
                    for (int n = 0; n < 2; ++n)
#pragma unroll
                        for (int e2 = 0; e2 < 2; ++e2) { const unsigned gg = gw[2 * n + e2], mm = mw[2 * n + e2];
                            o[n][2 * e2] = __uint_as_float(mm << 16) + __uint_as_float(gg << 16) * acc[ai][bj][m][n][2 * e2];
                            o[n][2 * e2 + 1] = __uint_as_float(mm & 0xffff0000u) + __uint_as_float(gg & 0xffff0000u) * acc[ai][bj][m][n][2 * e2 + 1]; }
                    *(u32x4*)(Mm + row * P1W + col0 + bj * HALF) = pack8(o[0], o[1]); }
    }
};
struct EpiMergeZ {
    static constexpr bool PERM = true;
    bf16_t* Mm; const bf16_t* G;
    __device__ __forceinline__ void operator()(const Acc& acc, const Unit& u, int wr, int wc, int fr, int fq) const {
        const int row0 = u.pm * BM + wr * 64 + fr, col0 = u.pn * BM + wc * 32 + 8 * fq, z = u.z, gz = z == 0 ? 2 : z - 1;
        const bf16_t* Gp = (const bf16_t*)((const unsigned char*)G + ra_panel_off(u.pm, 3072 * 2)) - (size_t)u.pm * BM * 3072;
#pragma unroll
        for (int ai = 0; ai < 2; ++ai)
#pragma unroll
            for (int m = 0; m < 4; ++m) {
#pragma unroll
                for (int bj = 0; bj < 2; ++bj) { const size_t row = (size_t)(row0 + ai * HALF + m * 16);
                    const u32x4 gw = *(const u32x4*)(Gp + row * 3072 + gz * 1024 + col0 + bj * HALF);
                    u32x4 mw = (u32x4){0u, 0u, 0u, 0u}; if (z > 0) mw = *(const u32x4*)(Mm + row * D + col0 + bj * HALF);
                    f32x4 o[2];
#pragma unroll
                    for (int n = 0; n < 2; ++n)
#pragma unroll
                        for (int e2 = 0; e2 < 2; ++e2) { const unsigned gg = gw[2 * n + e2], mm = mw[2 * n + e2];
                            o[n][2 * e2] = __uint_as_float(mm << 16) + __uint_as_float(gg << 16) * acc[ai][bj][m][n][2 * e2];
                            o[n][2 * e2 + 1] = __uint_as_float(mm & 0xffff0000u) + __uint_as_float(gg & 0xffff0000u) * acc[ai][bj][m][n][2 * e2 + 1]; }
                    *(u32x4*)(Mm + row * D + col0 + bj * HALF) = pack8(o[0], o[1]); }
                if (m & 1) asm volatile("" ::: "memory"); }
    }
};
__device__ __forceinline__ float row_r(const float* ss, int row) { const f32x4 a = *(const f32x4*)(ss + (size_t)row * 16), b = *(const f32x4*)(ss + (size_t)row * 16 + 4), c2 = *(const f32x4*)(ss + (size_t)row * 16 + 8), d = *(const f32x4*)(ss + (size_t)row * 16 + 12);
    return __builtin_amdgcn_rsqf(((((a.x + a.y) + (a.z + a.w)) + ((b.x + b.y) + (b.z + b.w))) + (((c2.x + c2.y) + (c2.z + c2.w)) + ((d.x + d.y) + (d.z + d.w)))) * (1.0f / 1024.0f) + EPS); }
__device__ __forceinline__ f32x4 bias4(const float* bias, int mb, int col) { const float* b = bias + (size_t)mb * NBIAS + col; return *(const f32x4*)b + *(const f32x4*)(b + (size_t)9 * NBIAS); }
__device__ __forceinline__ void rows_r(const float* ss, int row0, int fq, float (&rr)[2][4]) {
    f32x4 t[2][4];
#pragma unroll
    for (int ai = 0; ai < 2; ++ai)
#pragma unroll
        for (int m = 0; m < 4; ++m) t[ai][m] = *(const f32x4*)(ss + (size_t)(row0 + ai * HALF + m * 16) * 16 + 4 * fq);
#pragma unroll
    for (int ai = 0; ai < 2; ++ai)
#pragma unroll
        for (int m = 0; m < 4; ++m) { float v = (t[ai][m].x + t[ai][m].y) + (t[ai][m].z + t[ai][m].w); v += __shfl_xor(v, 16); v += __shfl_xor(v, 32); rr[ai][m] = __builtin_amdgcn_rsqf(v * (1.0f / 1024.0f) + EPS); }
}
struct EpiSwiGLU2 {
    static constexpr bool PERM = true;
    bf16_t* ACT; RowScale rs;
    static constexpr bool HAS_PRE = true;
    __device__ __forceinline__ void operator()(const Acc& acc, const Unit& u, int wr, int wc, int fr, int fq, const Pre& pre) const {
        const int row0 = wr * 64 + fr, col0 = u.pn * 128 + wc * 32 + 8 * fq;
        bf16_t* ACTp = (bf16_t*)((unsigned char*)ACT + ra_panel_off(u.pm, DFF * 2));
        const float (&rr)[2][4] = pre.rr; const f32x4 (&bv)[2][2] = pre.bv;
        const f32x4 bg[2] = {bv[0][0] * -LOG2E, bv[0][1] * -LOG2E}, bu[2] = {bv[1][0] * -LN2, bv[1][1] * -LN2};
#pragma unroll
        for (int ai = 0; ai < 2; ++ai)
#pragma unroll
            for (int m = 0; m < 4; ++m) { const int row = row0 + ai * HALF + m * 16; const float r = rr[ai][m];
                f32x4 o[2];
#pragma unroll
                for (int n = 0; n < 2; ++n) {
                    const f32x4 tg = acc[ai][0][m][n] * (r * -LOG2E) + bg[n], up = acc[ai][1][m][n] * (r * -LN2) + bu[n];
#pragma unroll
                    for (int e = 0; e < 4; ++e) o[n][e] = tg[e] * up[e] * __builtin_amdgcn_rcpf(1.0f + __builtin_amdgcn_exp2f(tg[e])); }
                *(u32x4*)(ACTp + (size_t)row * DFF + col0) = pack8(o[0], o[1]);
                if (m & 1) asm volatile("" ::: "memory"); }
    }
};
struct EpiSigmoid2 {
    static constexpr bool PERM = true;
    bf16_t* G; RowScale rs;
    static constexpr bool HAS_PRE = true;
    __device__ __forceinline__ void operator()(const Acc& acc, const Unit& u, int wr, int wc, int fr, int fq, const Pre& pre) const {
        const int row0 = wr * 64 + fr, col0 = u.pn * BM + wc * 32 + 8 * fq;
        bf16_t* Gp = (bf16_t*)((unsigned char*)G + ra_panel_off(u.pm, 3072 * 2));
        const float (&rr)[2][4] = pre.rr; const f32x4 (&bv)[2][2] = pre.bv;
#pragma unroll
        for (int ai = 0; ai < 2; ++ai)
#pragma unroll
            for (int m = 0; m < 4; ++m) { const int row = row0 + ai * HALF + m * 16; const float r = rr[ai][m];
#pragma unroll
                for (int bj = 0; bj < 2; ++bj) { f32x4 o[2];
#pragma unroll
                    for (int n = 0; n < 2; ++n) { const f32x4 t = acc[ai][bj][m][n] * r + bv[bj][n];
#pragma unroll
                        for (int e = 0; e < 4; ++e) o[n][e] = fast_sigmoid(t[e]); }
                    *(u32x4*)(Gp + (size_t)row * 3072 + col0 + bj * HALF) = pack8(o[0], o[1]); }
                if (m & 1) asm volatile("" ::: "memory"); }
    }
};
struct EpiInProj2 {
    static constexpr bool PERM = true;
    bf16_t* P1; float* rowss; const float* rope; const float* gqa; const float* gka; const float* gqb; const float* gkb; RowScale rs;
    static constexpr bool HAS_PRE = true;
    __device__ __forceinline__ void operator()(const Acc& acc, const Unit& u, int wr, int wc, int fr, int fq, const Pre& pre) const {
        const int pn = u.pn; const bool lat = u.pm < NLAT / BM; const int mb = lat ? (u.pm >> 3) : 8;
        const int row0 = u.pm * BM + wr * 64 + fr;
        const float (&rr)[2][4] = pre.rr; const f32x4 (&bv)[2][2] = pre.bv;
        if (pn >= 2 && pn <= 4) {
            const int dstc = (pn == 2 ? P_CKV : (pn == 3 ? P_CQ : P_CQ + 256)) + wc * 32 + 8 * fq;
#pragma unroll
            for (int ai = 0; ai < 2; ++ai)
#pragma unroll
                for (int m = 0; m < 4; ++m) { const int row = row0 + ai * HALF + m * 16; float ss = 0.f; const float r = rr[ai][m];
#pragma unroll
                    for (int bj = 0; bj < 2; ++bj) { const f32x4 v0 = acc[ai][bj][m][0] * r + bv[bj][0], v1 = acc[ai][bj][m][1] * r + bv[bj][1];
                        *(u32x4*)(P1 + (size_t)row * P1W + dstc + bj * HALF) = pack8(v0, v1);
                        if (bj == 0 || pn != 4) ss += ((v0[0] * v0[0] + v0[1] * v0[1]) + (v0[2] * v0[2] + v0[3] * v0[3])) + ((v1[0] * v1[0] + v1[1] * v1[1]) + (v1[2] * v1[2] + v1[3] * v1[3])); }
                    ss += __shfl_xor(ss, 16); ss += __shfl_xor(ss, 32);
                    if (fq == 0) rowss[(size_t)row * 12 + (pn - 2) * 4 + wc] = ss;
                    if (m & 1) asm volatile("" ::: "memory"); }
            return;
        }
        int dst; const float* gn = nullptr; float qs = 1.0f;
        if (pn == 0) { if (wc < 2) { dst = P_KA + 64 * wc; gn = gka; } else dst = P_VA + 64 * (wc - 2); }
        else if (pn == 1) { if (wc < 2) { dst = P_KB + 64 * wc; gn = gkb; } else dst = P_VB + 64 * (wc - 2); }
        else if (pn <= 6) { dst = P_QA + 64 * (4 * (pn - 5) + wc); gn = gqa; qs = QSC64; }
        else { dst = P_QB + 64 * (4 * (pn - 7) + wc); gn = gqb; qs = QSC64; }
        dst += 8 * fq;
        if (gn == nullptr) {
#pragma unroll
            for (int ai = 0; ai < 2; ++ai)
#pragma unroll
                for (int m = 0; m < 4; ++m) { const int row = row0 + ai * HALF + m * 16; const float r = rr[ai][m];
#pragma unroll
                    for (int bj = 0; bj < 2; ++bj) *(u32x4*)(P1 + (size_t)row * P1W + dst + 32 * bj) = pack8(acc[ai][bj][m][0] * r + bv[bj][0], acc[ai][bj][m][1] * r + bv[bj][1]);
                    if (m & 1) asm volatile("" ::: "memory"); }
            return;
        }
        f32x4 gv[2][2];
#pragma unroll
        for (int bj = 0; bj < 2; ++bj)
#pragma unroll
            for (int n = 0; n < 2; ++n) gv[bj][n] = *(const f32x4*)(gn + 32 * bj + 8 * fq + 4 * n) * qs;
#pragma unroll
        for (int ai = 0; ai < 2; ++ai)
#pragma unroll
            for (int m = 0; m < 4; ++m) { const int row = row0 + ai * HALF + m * 16; float ss = 0.f; const float r = rr[ai][m];
                f32x4 t[2][2];
#pragma unroll
                for (int bj = 0; bj < 2; ++bj)
#pragma unroll
                    for (int n = 0; n < 2; ++n) { const f32x4 v = acc[ai][bj][m][n] * r + bv[bj][n]; t[bj][n] = v; ss += (v[0] * v[0] + v[1] * v[1]) + (v[2] * v[2] + v[3] * v[3]); }
                ss += __shfl_xor(ss, 16); ss += __shfl_xor(ss, 32);
                const float rstd = __builtin_amdgcn_rsqf(ss * (1.0f / 64.0f) + EPS);
                const float* rp = rope + (size_t)(row & 2047) * 64;
#pragma unroll
                for (int bj = 0; bj < 2; ++bj) { f32x4 o[2];
#pragma unroll
                    for (int n = 0; n < 2; ++n) { const f32x4 v = t[bj][n] * rstd * gv[bj][n];
                        if (lat) { const f32x4 cs = *(const f32x4*)(rp + (16 * bj + 4 * fq + 2 * n) * 2);
                            o[n][0] = v[0] * cs[0] - v[1] * cs[1]; o[n][1] = v[0] * cs[1] + v[1] * cs[0]; o[n][2] = v[2] * cs[2] - v[3] * cs[3]; o[n][3] = v[2] * cs[3] + v[3] * cs[2]; }
                        else o[n] = v; }
                    *(u32x4*)(P1 + (size_t)row * P1W + dst + 32 * bj) = pack8(o[0], o[1]); }
                if (m & 1) asm volatile("" ::: "memory"); }
    }
};
struct EpiResN {
    static constexpr bool PERM = true;
    const Params* p; int l, gi, from_input; float coef; int gin, goff, lnext, sidx;
    __device__ __forceinline__ void operator()(const Acc& acc, const Unit& u, int wr, int wc, int fr, int fq) const {
        const bool lat = u.pm < NLAT / BM; const int pmr = lat ? u.pm : u.pm - NLAT / BM; const int mb = lat ? (u.pm >> 3) : 8;
        unsigned char* ws = p->ws;
        const float* bp = (from_input ? (lat ? p->in[0] : p->in[2]) : (lat ? (const float*)p->out : (const float*)(ws + WS_Z))) + (size_t)pmr * BM * D;
        float* op = (lat ? p->out : (float*)(ws + WS_Z)) + (size_t)pmr * BM * D;
        const float* mod = (const float*)(ws + WS_MOD);
        const float* md = mod + ((size_t)l * 9 + mb) * MODW + gi * D;
        const bool emit = gin >= 0;
        const float* gnext = emit ? p->in[gin] + goff : nullptr; const float* scn = mod + ((size_t)lnext * 9 + mb) * MODW + (sidx + 1) * D;
        bf16_t* H = (bf16_t*)(ws + WS_H); float* ss = (float*)(ws + WS_SS);
        const int col0 = u.pn * BM + wc * 32 + 8 * fq;
        f32x4 mv[2][2], gs[2][2];
#pragma unroll
        for (int bj = 0; bj < 2; ++bj)
#pragma unroll
            for (int n = 0; n < 2; ++n) { const int cc = col0 + bj * HALF + 4 * n; mv[bj][n] = *(const f32x4*)(md + cc) * coef;
                gs[bj][n] = emit ? *(const f32x4*)(gnext + cc) * (*(const f32x4*)(scn + cc) + 1.0f) : (f32x4){0.f, 0.f, 0.f, 0.f}; }
#pragma unroll
        for (int ai = 0; ai < 2; ++ai)
#pragma unroll
            for (int m = 0; m < 4; ++m) { const int rl = ai * HALF + wr * 64 + m * 16 + fr; const size_t off = (size_t)rl * D + col0; float ssum = 0.f;
#pragma unroll
                for (int bj = 0; bj < 2; ++bj) { f32x4 x[2];
#pragma unroll
                    for (int n = 0; n < 2; ++n) { x[n] = *(const f32x4*)(bp + off + bj * HALF + 4 * n) + mv[bj][n] * acc[ai][bj][m][n]; *(f32x4*)(op + off + bj * HALF + 4 * n) = x[n];
                        ssum += (x[n][0] * x[n][0] + x[n][1] * x[n][1]) + (x[n][2] * x[n][2] + x[n][3] * x[n][3]); }
                    if (emit) *(u32x4*)(H + (size_t)(u.pm * BM + rl) * D + col0 + bj * HALF) = pack8(x[0] * gs[bj][0], x[1] * gs[bj][1]); }
                if (emit) { ssum += __shfl_xor(ssum, 16); ssum += __shfl_xor(ssum, 32); if (fq == 0) ss[(size_t)(u.pm * BM + rl) * 16 + u.pn * 4 + wc] = ssum; }
                if (m & 1) asm volatile("" ::: "memory"); }
    }
};
}

__device__ __forceinline__ void phase_mla_norm(Ctx& c, int l, int rows_q, int rows_k) {
    PH_IDS(c);
    const Params* p = c.p;
    const int gw = c.wg * 8 + c.wave, ngw = c.nwg * 8, h = lane_ >> 3, j = lane_ & 7;
    const float* gq = p->in[20] + l * 96 + 12 * j; const float* gk = p->in[21] + l * 96 + 12 * j;
    float gqv[12], gkv[12];
#pragma unroll
    for (int i = 0; i < 12; ++i) { gqv[i] = gq[i] * QSC96; gkv[i] = gk[i]; }
    for (int r = gw; r < rows_k; r += ngw) {
        const bool lat = r < NLAT; const int s = r & 2047;
#pragma unroll
        for (int which = 0; which < 2; ++which) {
            if (which == 0 && r >= rows_q) continue;
            float v[12];
            if (which == 0) { const u32x2* qp = (const u32x2*)(c.QC + (size_t)r * 768 + 96 * h + 12 * j);
#pragma unroll
                for (int i = 0; i < 3; ++i) { const u32x2 w = qp[i]; v[4 * i] = __uint_as_float(w.x << 16); v[4 * i + 1] = __uint_as_float(w.x & 0xffff0000u); v[4 * i + 2] = __uint_as_float(w.y << 16); v[4 * i + 3] = __uint_as_float(w.y & 0xffff0000u); } }
            else {
#pragma unroll
                for (int i = 0; i < 3; ++i) { const int d = 12 * j + 4 * i;
                    const bf16_t* src = d < 64 ? c.KVR + (size_t)r * 1024 + 128 * h + d : c.P1 + (size_t)r * P1W + P_CKR + (d - 64);
                    const u32x2 w = *(const u32x2*)src; v[4 * i] = __uint_as_float(w.x << 16); v[4 * i + 1] = __uint_as_float(w.x & 0xffff0000u); v[4 * i + 2] = __uint_as_float(w.y << 16); v[4 * i + 3] = __uint_as_float(w.y & 0xffff0000u); } }
            float ss = 0.f;
#pragma unroll
            for (int i = 0; i < 12; ++i) ss += v[i] * v[i];
            ss += __shfl_xor(ss, 1); ss += __shfl_xor(ss, 2); ss += __shfl_xor(ss, 4);
            const float rstd = 1.0f / sqrtf(ss * (1.0f / 96.0f) + EPS);
#pragma unroll
            for (int i = 0; i < 12; ++i) v[i] *= rstd * (which == 0 ? gqv[i] : gkv[i]);
            if (lat) {
#pragma unroll
                for (int i = 0; i < 6; ++i) { const int d = 12 * j + 2 * i;
                    if (d >= 64) { const float cs = c.rope_c[(s * 16 + ((d - 64) >> 1)) * 2], sn = c.rope_c[(s * 16 + ((d - 64) >> 1)) * 2 + 1];
                        const float x0 = v[2 * i], x1 = v[2 * i + 1]; v[2 * i] = x0 * cs - x1 * sn; v[2 * i + 1] = x0 * sn + x1 * cs; } }
            }
            u32x2* op = (u32x2*)((which == 0 ? c.QC : c.KC) + (size_t)r * 768 + 96 * h + 12 * j);
#pragma unroll
            for (int i = 0; i < 3; ++i) { u32x2 w; w.x = pk2(v[4 * i], v[4 * i + 1]); w.y = pk2(v[4 * i + 2], v[4 * i + 3]); op[i] = w; }
        }
    }
}

__device__ __forceinline__ void fast_ffn_up(Ctx& c, unsigned char* lds, size_t wo, int rows) {
    pg8::Gemm g{c.H, (const bf16_t*)(c.ws + WS_W + wo), rows, 2 * DFF, D, D}; pg8::StaticOrder S; S.init(rows, 2 * DFF, c.nwg, c.wg);
    pg8::EpiSwiGLU E{c.ACT};
    pg8::gemm_phase<pg8::EpiSwiGLU, pg8::StaticOrder, true>((LAS unsigned char*)lds, c.wave, g, S, E);
}
__device__ __forceinline__ void fast_res(Ctx& c, unsigned char* lds, int l, const bf16_t* A, int K, size_t wo, float coef, int gi, int rows, bool from_input) {
    pg8::Gemm g{A, (const bf16_t*)(c.ws + WS_W + wo), rows, D, K, K}; pg8::StaticOrder S; S.init(rows, D, c.nwg, c.wg);
    pg8::EpiRes E{from_input ? c.p->in[0] : c.p->out, from_input ? c.p->in[2] : c.Z, c.p->out, c.Z, c.mod + (size_t)l * 9 * MODW, gi, coef};
    pg8::gemm_phase<pg8::EpiRes, pg8::StaticOrder, true>((LAS unsigned char*)lds, c.wave, g, S, E);
}
__device__ __forceinline__ void fast_inproj(Ctx& c, unsigned char* lds, int l, int rows) {
    const Params* p = c.p;
    pg8::Gemm g{c.H, (const bf16_t*)(c.ws + WS_W + WO_P1), rows, P1W, D, D}; pg8::StaticOrder S; S.init(rows, P1W, c.nwg, c.wg);
    pg8::EpiInProj E{c.P1, c.rowss, c.rope_hd, p->in[11] + l * 64, p->in[12] + l * 64, p->in[14] + l * 64, p->in[15] + l * 64};
    pg8::gemm_phase<pg8::EpiInProj, pg8::StaticOrder, true>((LAS unsigned char*)lds, c.wave, g, S, E);
}
__device__ __forceinline__ void fast_mla_up(Ctx& c, unsigned char* lds, int l, int rows_q, int rows_k) {
    { pg8::Gemm g{c.P1 + P_CQ, (const bf16_t*)(c.ws + WS_W + WO_UQ), rows_q, 768, 384, P1W}; pg8::StaticOrder S; S.init_grp(c.lat0, c.nlat, c.ctx0, c.nctx, rows_q == MT, 768, c.nwg, c.wg);
      pg8::EpiMlaQ E{(bf16_t*)(c.ws + WS_RA), c.rowss, c.ssq};     pg8::gemm_phase<pg8::EpiMlaQ, pg8::StaticOrder, true>((LAS unsigned char*)lds, c.wave, g, S, E); }
    { pg8::Gemm g{c.P1 + P_CKV, (const bf16_t*)(c.ws + WS_W + WO_UKV), rows_k, 1024, 256, P1W}; pg8::StaticOrder S; S.init_grp(c.lat0, c.nlat, c.ctx0, c.nctx, rows_k == MT, 1024, c.nwg, c.wg);
      pg8::EpiMlaKV E{(bf16_t*)(c.ws + WS_RA), (bf16_t*)(c.ws + WS_RA), c.P1, c.rowss, c.p->in[21] + l * 96, c.rope_c};     pg8::gemm_phase<pg8::EpiMlaKV, pg8::StaticOrder, true>((LAS unsigned char*)lds, c.wave, g, S, E); }
}
__device__ __forceinline__ void fast_gates(Ctx& c, unsigned char* lds, int rows) {
    pg8::Gemm g{c.H, (const bf16_t*)(c.ws + WS_W + WO_G), rows, 3072, D, D}; pg8::StaticOrder S; S.init(rows, 3072, c.nwg, c.wg);
    pg8::EpiSigmoid E{c.G};
    pg8::gemm_phase<pg8::EpiSigmoid, pg8::StaticOrder, true>((LAS unsigned char*)lds, c.wave, g, S, E);
}
__device__ __forceinline__ void fast_merge(Ctx& c, unsigned char* lds, int rows) {
    pg8::StaticOrder S; S.init(rows, D, c.nwg, c.wg);
    { pg8::Gemm g{c.P1 + P_QA, (const bf16_t*)(c.ws + WS_W + WO_BR), rows, D, 512, P1W}; pg8::EpiMerge<0> E{c.P1, c.G}; pg8::gemm_phase<pg8::EpiMerge<0>, pg8::StaticOrder, true>((LAS unsigned char*)lds, c.wave, g, S, E); }
    { pg8::Gemm g{c.P1 + P_QB, (const bf16_t*)(c.ws + WS_W + WO_BR) + (size_t)1024 * 512, rows, D, 512, P1W}; pg8::EpiMerge<1> E{c.P1, c.G}; pg8::gemm_phase<pg8::EpiMerge<1>, pg8::StaticOrder, true>((LAS unsigned char*)lds, c.wave, g, S, E); }
    { pg8::Gemm g{c.YC, (const bf16_t*)(c.ws + WS_W + WO_BR) + (size_t)2 * 1024 * 512, rows, D, 512, 512}; pg8::EpiMerge<2> E{c.P1, c.G}; pg8::gemm_phase<pg8::EpiMerge<2>, pg8::StaticOrder, true>((LAS unsigned char*)lds, c.wave, g, S, E); }
}

__device__ __forceinline__ void fz_ffn_up(Ctx& c, unsigned char* lds, size_t wo, int boff, int rows) {
    pg8::Gemm g{c.H, (const bf16_t*)(c.ws + WS_W + wo), rows, 2 * DFF, D, D}; pg8::StaticOrder S; S.init_grp(c.lat0, c.nlat, c.ctx0, c.nctx, rows == MT, 2 * DFF, c.nwg, c.wg);
    pg8::EpiSwiGLU2 E{c.ACT, {c.ss, c.bias + boff}};
    pg8::gemm_phase<pg8::EpiSwiGLU2, pg8::StaticOrder, true>((LAS unsigned char*)lds, c.wave, g, S, E);
}
__device__ __forceinline__ void fz_res(Ctx& c, unsigned char* lds, int l, const bf16_t* A, int lda, int K, size_t wo, float coef, int gi, int rows, bool from_input, int gin, int goff, int lnext, int sidx) {
    pg8::Gemm g{A, (const bf16_t*)(c.ws + WS_W + wo), rows, D, K, lda}; g.rap = (A == c.ACT) ? DFF * 2 : 0; pg8::StaticOrder S; S.init_grp(c.lat0, c.nlat, c.ctx0, c.nctx, rows == MT, D, c.nwg, c.wg);
    pg8::EpiResN E{c.p, l, gi, from_input ? 1 : 0, coef, gin, goff, lnext, sidx};
    pg8::gemm_phase<pg8::EpiResN, pg8::StaticOrder, true>((LAS unsigned char*)lds, c.wave, g, S, E);
}
__device__ __forceinline__ void fz_inproj(Ctx& c, unsigned char* lds, int l, int rows) {
    const Params* p = c.p;
    pg8::Gemm g{c.H, (const bf16_t*)(c.ws + WS_W + WO_P1), rows, P1W, D, D}; pg8::StaticOrder S; S.init_grp(c.lat0, c.nlat, c.ctx0, c.nctx, rows == MT, P1W, c.nwg, c.wg);
    pg8::EpiInProj2 E{c.P1, c.rowss, c.rope_hd, p->in[11] + l * 64, p->in[12] + l * 64, p->in[14] + l * 64, p->in[15] + l * 64, {c.ss, c.bias + BO_P1}};
    pg8::gemm_phase<pg8::EpiInProj2, pg8::StaticOrder, true>((LAS unsigned char*)lds, c.wave, g, S, E);
}
__device__ __forceinline__ void fz_gates(Ctx& c, unsigned char* lds, int rows) {
    pg8::Gemm g{c.H, (const bf16_t*)(c.ws + WS_W + WO_G), rows, 3072, D, D}; pg8::StaticOrder S; S.init_grp(c.lat0, c.nlat, c.ctx0, c.nctx, rows == MT, 3072, c.nwg, c.wg);
    pg8::EpiSigmoid2 E{c.G, {c.ss, c.bias + BO_G}};
    pg8::gemm_phase<pg8::EpiSigmoid2, pg8::StaticOrder, true>((LAS unsigned char*)lds, c.wave, g, S, E);
}
__device__ __forceinline__ void fz_merge(Ctx& c, unsigned char* lds, int rows) {
    bf16_t* Mb = (bf16_t*)(c.ws + WS_YC); const bf16_t* W = (const bf16_t*)(c.ws + WS_W + WO_BR);
    static_assert(P_QA == P_YC + 512 && P_QB == P_YC + 1024, "branch outputs 512 columns apart: z = 0 C, 1 A, 2 B");
    pg8::Gemm g{c.P1 + P_YC, W, rows, D, 512, P1W, 512, 1024 * 512};
    pg8::TripleOrder S; S.b.init_grp(c.lat0, c.nlat, c.ctx0, c.nctx, rows == MT, D, c.nwg, c.wg);
    pg8::EpiMergeZ E{Mb, c.G};
    pg8::gemm_phase<pg8::EpiMergeZ, pg8::TripleOrder, true>((LAS unsigned char*)lds, c.wave, g, S, E);
}

__device__ __forceinline__ void fz_ffn_up_sub(Ctx& c, unsigned char* lds, size_t wo, int boff, int pm0, int npm, int G, int cc, int R0, int G1) {
    pg8::Gemm g{c.H, (const bf16_t*)(c.ws + WS_W + wo), MT, 2 * DFF, D, D}; pg8::StaticOrder S; S.init_sub(pm0, npm, 2 * DFF, G, cc, R0, G1);
    pg8::EpiSwiGLU2 E{c.ACT, {c.ss, c.bias + boff}};
    pg8::gemm_phase<pg8::EpiSwiGLU2, pg8::StaticOrder, true>((LAS unsigned char*)lds, c.wave, g, S, E);
}
__device__ __forceinline__ void fz_res_sub(Ctx& c, unsigned char* lds, int l, size_t wo, int gi, bool from_input, int gin, int goff, int lnext, int sidx, int pm0, int npm, int G, int cc) {
    pg8::Gemm g{c.ACT, (const bf16_t*)(c.ws + WS_W + wo), MT, D, DFF, DFF}; g.rap = DFF * 2; pg8::StaticOrder S; S.init_sub(pm0, npm, D, G, cc, 1 << 20, G);
    pg8::EpiResN E{c.p, l, gi, from_input ? 1 : 0, 0.5f, gin, goff, lnext, sidx};
    pg8::gemm_phase<pg8::EpiResN, pg8::StaticOrder, true>((LAS unsigned char*)lds, c.wave, g, S, E);
}

namespace fa {
#ifndef FA_FORCE_RESC
#define FA_FORCE_RESC 0
#endif
#if defined(FA_FAKE) && FA_FAKE == 1
#define FA_EXP(x) (__builtin_fabsf(x) * 0.01f + 0.01f)
#else
#define FA_EXP(x) __builtin_amdgcn_exp2f(x)
#endif
typedef float f32x16 __attribute__((ext_vector_type(16)));
typedef short s16x4 __attribute__((ext_vector_type(4)));
typedef short v4i16_t __attribute__((ext_vector_type(4)));
constexpr int KBUF = 12288, VBUF = 8192, SLOT = KBUF + VBUF, NSLOT = 4;
constexpr int OFF_WS = NSLOT * SLOT, OFF_OST = OFF_WS + 2048, LDS_TOTAL = OFF_OST + 8 * 4096;
static_assert(LDS_TOTAL <= 131072, "attention LDS");
constexpr float THR = 8.0f;
__device__ __forceinline__ int crow(int r, int hi) { return (r & 3) + 8 * (r >> 2) + 4 * hi; }
__device__ __forceinline__ s16x4 vtr(const LAS unsigned char* p) { return __builtin_bit_cast(s16x4, __builtin_amdgcn_ds_read_tr16_b64_v4i16((LAS v4i16_t*)p)); }
__device__ __forceinline__ unsigned cvtpk(float lo, float hi) { return pg8::cvt_pk_bf16(lo, hi); }
__device__ __forceinline__ float mx3(float a, float b, float c) { float d; asm("v_max3_f32 %0, %1, %2, %3" : "=v"(d) : "v"(a), "v"(b), "v"(c)); return d; }
__device__ __forceinline__ float mx2(float a, float b) { float d; asm("v_max_f32 %0, %1, %2" : "=v"(d) : "v"(a), "v"(b)); return d; }
__device__ __forceinline__ void glds16(const void* gsrc, unsigned lds_dst) { unsigned keep;
    asm volatile("s_mov_b32 %0, m0\n\ts_mov_b32 m0, %2\n\ts_nop 0\n\tglobal_load_lds_dwordx4 %1, off\n\ts_mov_b32 m0, %0" : "=&s"(keep) : "v"(gsrc), "s"(lds_dst) : "memory"); }
struct UnitDesc {
    const bf16_t* Q; bf16_t* O;
    const bf16_t* Kc; const bf16_t* Vc;
    const bf16_t* Kl; const bf16_t* Vl;
    int qpitch, opitch, kpitch, vpitch, nt_ctx, nt_lat;
    int qoff;
    float sinkl;
    const float* qss; const float* qgain; const float* qrope;
};
template <int DQK, bool WIN, bool SINK>
__device__ __forceinline__ void attn_unit(const UnitDesc& u, LAS unsigned char* lds, int wid) {
    const int lane = lane_id(), r32 = lane & 31, hi = lane >> 5;
    constexpr int ND = DQK / 16, NCH = DQK / 8;
    constexpr int LPT = NCH > 8 ? 3 : 2;
    const int NT = u.nt_ctx + u.nt_lat;
    LAS float* wsf = (LAS float*)(lds + OFF_WS) + wid * 64;
    const unsigned lds0 = (unsigned)(uintptr_t)lds;
    auto issue = [&](int t, int s) {
#if defined(FA_FAKE) && FA_FAKE == 5
        if (t > 2) return;
#endif
        const bool ctx = t < u.nt_ctx; const int tt = ctx ? t : t - u.nt_ctx;
        const bf16_t* Kt = (ctx ? u.Kc : u.Kl) + (size_t)tt * 64 * u.kpitch; const bf16_t* Vt = (ctx ? u.Vc : u.Vl) + (size_t)tt * 64 * u.vpitch;
        const unsigned sb = lds0 + (unsigned)(s * SLOT);
        glds16(Kt + (size_t)lane * u.kpitch + wid * 8, (unsigned)__builtin_amdgcn_readfirstlane(sb + wid * 1024));
        if (NCH > 8) { const int cc = 8 + (wid & 3);
            glds16(Kt + (size_t)lane * u.kpitch + cc * 8, (unsigned)__builtin_amdgcn_readfirstlane(sb + cc * 1024)); }
        glds16(Vt + (size_t)(16 * (wid & 3) + (lane >> 2)) * u.vpitch + (wid >> 2) * 32 + (lane & 3) * 8, (unsigned)__builtin_amdgcn_readfirstlane(sb + KBUF + wid * 1024));
    };
#if defined(FA_FAKE) && FA_FAKE == 3
#define FA_WAIT_BAR(n) asm volatile("s_waitcnt vmcnt(" #n ") lgkmcnt(0)" ::: "memory")
#else
#define FA_WAIT_BAR(n) asm volatile("s_waitcnt vmcnt(" #n ") lgkmcnt(0)\n\ts_barrier" ::: "memory")
#endif
#define FA_WAIT1() do { if (LPT == 3) FA_WAIT_BAR(3); else FA_WAIT_BAR(2); } while (0)
    issue(0, 0); issue(1, 1); issue(2, 2);
    bf16x8 qr[ND];
    { const bf16_t* qp = u.Q + (size_t)(wid * 32 + r32) * u.qpitch + hi * 8;
#pragma unroll
      for (int d0 = 0; d0 < ND; ++d0) qr[d0] = *(const bf16x8*)(qp + d0 * 16);
      if (DQK == 96) {
          const float* sq = u.qss + (size_t)(wid * 32 + r32) * 24; const float rstd = __builtin_amdgcn_rsqf((sq[0] + sq[1] + sq[2]) * (1.0f / 96.0f) + EPS);
#pragma unroll
          for (int d0 = 0; d0 < ND; ++d0) { const f32x4 g0 = *(const f32x4*)(u.qgain + d0 * 16 + hi * 8), g1 = *(const f32x4*)(u.qgain + d0 * 16 + hi * 8 + 4);
              float v[8];
#pragma unroll
              for (int j = 0; j < 8; ++j) v[j] = bf2f((bf16_t)qr[d0][j]) * rstd * (j < 4 ? g0[j] : g1[j - 4]) * QSC96;
              if (d0 >= 4 && u.qrope != nullptr) { const float* rp = u.qrope + ((size_t)((wid * 32 + r32) & 2047) * 16 + (d0 - 4) * 8 + hi * 4) * 2; const f32x4 c0 = *(const f32x4*)rp, c1 = *(const f32x4*)(rp + 4);
                  float t[8]; t[0] = v[0] * c0[0] - v[1] * c0[1]; t[1] = v[0] * c0[1] + v[1] * c0[0]; t[2] = v[2] * c0[2] - v[3] * c0[3]; t[3] = v[2] * c0[3] + v[3] * c0[2];
                  t[4] = v[4] * c1[0] - v[5] * c1[1]; t[5] = v[4] * c1[1] + v[5] * c1[0]; t[6] = v[6] * c1[2] - v[7] * c1[3]; t[7] = v[6] * c1[3] + v[7] * c1[2];
#pragma unroll
                  for (int j = 0; j < 8; ++j) v[j] = t[j]; }
              u32x4 w; w.x = cvtpk(v[0], v[1]); w.y = cvtpk(v[2], v[3]); w.z = cvtpk(v[4], v[5]); w.w = cvtpk(v[6], v[7]); qr[d0] = __builtin_bit_cast(bf16x8, w); } } }
    f32x16 o[2]; o[0] = f32x16{}; o[1] = f32x16{};
    f32x4 o2 = (f32x4){0.f, 0.f, 0.f, 0.f};
    bf16x8 ones; { const unsigned sel = (((lane & 15) < 8) == (((lane >> 4) & 1) == 0)) ? 0x3F803F80u : 0u; u32x4 w; w.x = sel; w.y = sel; w.z = sel; w.w = sel; ones = __builtin_bit_cast(bf16x8, w); }
    const int q2 = 4 * (lane >> 4) + ((lane & 8) ? 16 : 0);
    f32x16 negm = f32x16{};
    float m = 0.f;
    const int qi = u.qoff + wid * 32;
    const int koff = hi * 1024 + r32 * 16;
    const int voff = KBUF + ((lane >> 4) & 1) * 32 + (lane & 3) * 8 + (4 * hi + ((lane & 15) >> 2)) * 64;
    asm volatile("" :: "v"(qr[0]) : "memory");
    if (LPT == 3) FA_WAIT_BAR(6); else FA_WAIT_BAR(4);
    auto qk = [&](int t, f32x16& c0, f32x16& c1) {
        const LAS unsigned char* kb = lds + (t & (NSLOT - 1)) * SLOT + koff;
        bf16x8 kf[2 * ND];
#pragma unroll
        for (int d0 = 0; d0 < ND; ++d0) { kf[2 * d0] = *(const LAS bf16x8*)(kb + d0 * 2048); kf[2 * d0 + 1] = *(const LAS bf16x8*)(kb + d0 * 2048 + 512); }
        c0 = __builtin_amdgcn_mfma_f32_32x32x16_bf16(kf[0], qr[0], negm, 0, 0, 0); c1 = __builtin_amdgcn_mfma_f32_32x32x16_bf16(kf[1], qr[0], negm, 0, 0, 0);
#pragma unroll
#if defined(FA_FAKE) && FA_FAKE == 2
        for (int d0 = 1; d0 < 1; ++d0)
#else
        for (int d0 = 1; d0 < ND; ++d0)
#endif
        { c0 = __builtin_amdgcn_mfma_f32_32x32x16_bf16(kf[2 * d0], qr[d0], c0, 0, 0, 0); c1 = __builtin_amdgcn_mfma_f32_32x32x16_bf16(kf[2 * d0 + 1], qr[d0], c1, 0, 0, 0); }
    };
    auto mask = [&](int t, f32x16& c0, f32x16& c1) {
        if (WIN && t >= u.nt_ctx) { const int jb = (t - u.nt_ctx) * 64;
            if (!((jb + 63 - qi <= 128) && (qi + 31 - jb <= 128))) { const int q = qi + r32;
#pragma unroll
                for (int r = 0; r < 16; ++r) { const int d0_ = jb + crow(r, hi) - q, d1_ = d0_ + 32;
                    if (d0_ > 128 || d0_ < -128) c0[r] = -INFINITY; if (d1_ > 128 || d1_ < -128) c1[r] = -INFINITY; } } }
    };
    auto rowmax = [&](f32x16& c0, f32x16& c1) {
        asm volatile("s_nop 15" : "+v"(c0), "+v"(c1));
        float a0 = mx3(c0[0], c1[0], c0[4]), a1 = mx3(c0[1], c1[1], c0[5]), a2 = mx3(c0[2], c1[2], c0[6]), a3 = mx3(c0[3], c1[3], c0[7]);
        a0 = mx3(a0, c1[4], c0[8]); a1 = mx3(a1, c1[5], c0[9]); a2 = mx3(a2, c1[6], c0[10]); a3 = mx3(a3, c1[7], c0[11]);
        a0 = mx3(a0, c1[8], c0[12]); a1 = mx3(a1, c1[9], c0[13]); a2 = mx3(a2, c1[10], c0[14]); a3 = mx3(a3, c1[11], c0[15]);
        a0 = mx3(a0, c1[12], c1[13]); a1 = mx3(a1, c1[14], c1[15]);
        float rm = mx2(mx3(a0, a1, a2), a3);
        { const auto rr = __builtin_amdgcn_permlane32_swap(__float_as_uint(rm), __float_as_uint(rm), false, false); rm = mx2(__uint_as_float(rr[0]), __uint_as_float(rr[1])); }
        return rm;
    };
    auto rowmax_i = [&](const f32x16& c0, const f32x16& c1) {
        auto I = [](float x) { return __builtin_bit_cast(int, x); };
        auto mx = [](int a, int b, int c) { const int ab = a > b ? a : b; return ab > c ? ab : c; };
        int a0 = mx(I(c0[0]), I(c1[0]), I(c0[4])), a1 = mx(I(c0[1]), I(c1[1]), I(c0[5])), a2 = mx(I(c0[2]), I(c1[2]), I(c0[6])), a3 = mx(I(c0[3]), I(c1[3]), I(c0[7]));
        a0 = mx(a0, I(c1[4]), I(c0[8])); a1 = mx(a1, I(c1[5]), I(c0[9])); a2 = mx(a2, I(c1[6]), I(c0[10])); a3 = mx(a3, I(c1[7]), I(c0[11]));
        a0 = mx(a0, I(c1[8]), I(c0[12])); a1 = mx(a1, I(c1[9]), I(c0[13])); a2 = mx(a2, I(c1[10]), I(c0[14])); a3 = mx(a3, I(c1[11]), I(c0[15]));
        a0 = mx(a0, I(c1[12]), I(c1[13])); a1 = mx(a1, I(c1[14]), I(c1[15]));
        int rmi = mx(a0, a1, a2); rmi = rmi > a3 ? rmi : a3;
        { const auto rr = __builtin_amdgcn_permlane32_swap((unsigned)rmi, (unsigned)rmi, false, false); const int x = (int)rr[0], y = (int)rr[1]; rmi = x > y ? x : y; }
        return rmi;
    };
    auto pv = [&](int t, const u32x4 (&pw)[4]) {
        const LAS unsigned char* vp = lds + (t & (NSLOT - 1)) * SLOT + voff;
#pragma unroll
        for (int d0 = 0; d0 < 2; ++d0)
#pragma unroll
            for (int ks = 0; ks < 4; ++ks) { const s16x4 lo = vtr(vp + d0 * 4096 + ks * 1024), h2 = vtr(vp + d0 * 4096 + ks * 1024 + 512);
                const bf16x8 vf = (bf16x8){lo[0], lo[1], lo[2], lo[3], h2[0], h2[1], h2[2], h2[3]};
                o[d0] = __builtin_amdgcn_mfma_f32_32x32x16_bf16(__builtin_bit_cast(bf16x8, pw[ks]), vf, o[d0], 0, 0, 0); }
#pragma unroll
        for (int ks = 0; ks < 4; ++ks) o2 = __builtin_amdgcn_mfma_f32_16x16x32_bf16(__builtin_bit_cast(bf16x8, pw[ks]), ones, o2, 0, 0, 0);
    };
    auto sum_pack = [&](const f32x16& p0, const f32x16& p1, u32x4 (&pw)[4]) {
#pragma unroll
        for (int k = 0; k < 4; ++k) { pw[0][k] = cvtpk(p0[2 * k], p0[2 * k + 1]); pw[1][k] = cvtpk(p0[8 + 2 * k], p0[9 + 2 * k]); pw[2][k] = cvtpk(p1[2 * k], p1[2 * k + 1]); pw[3][k] = cvtpk(p1[8 + 2 * k], p1[9 + 2 * k]); }
    };
    f32x16 pa, pb, cp;
    qk(0, pa, pb); mask(0, pa, pb);
    { const float rm = rowmax(pa, pb); m = rm;
#pragma unroll
      for (int r = 0; r < 16; ++r) { pa[r] = FA_EXP(pa[r] - rm); cp[r] = pb[r] - rm; negm[r] = -rm; } }
    FA_WAIT1();
#pragma unroll 1
    for (int t = 1; t < NT; ++t) {
        if (t + 2 < NT) issue(t + 2, (t + 2) & (NSLOT - 1));
#define FA_SB __builtin_amdgcn_sched_barrier(0)
        f32x16 c0, c1; u32x4 pw[4]; bf16x8 vf[2][4];
        const LAS unsigned char* vpp = lds + ((t - 1) & (NSLOT - 1)) * SLOT + voff;
        { const LAS unsigned char* kb = lds + (t & (NSLOT - 1)) * SLOT + koff;
          bf16x8 kf[2 * ND];
#pragma unroll
          for (int d0 = 0; d0 < ND; ++d0) { kf[2 * d0] = *(const LAS bf16x8*)(kb + d0 * 2048); kf[2 * d0 + 1] = *(const LAS bf16x8*)(kb + d0 * 2048 + 512); if (d0 == 0) FA_SB; }
          FA_SB;
#pragma unroll
          for (int d0 = 0; d0 < ND; ++d0) {
              if (d0 == 0) { c0 = __builtin_amdgcn_mfma_f32_32x32x16_bf16(kf[0], qr[0], negm, 0, 0, 0);
                  asm("v_mfma_f32_32x32x16_bf16 %0, %1, %2, %3" : "=&v"(c1) : "v"(kf[1]), "v"(qr[0]), "v"(negm)); }
              else { c0 = __builtin_amdgcn_mfma_f32_32x32x16_bf16(kf[2 * d0], qr[d0], c0, 0, 0, 0); c1 = __builtin_amdgcn_mfma_f32_32x32x16_bf16(kf[2 * d0 + 1], qr[d0], c1, 0, 0, 0); }
              if (d0 < 4) {
#pragma unroll
                  for (int r = 4 * d0; r < 4 * d0 + 4; ++r) pb[r] = FA_EXP(cp[r]);
                  if (d0 < 3) {
#pragma unroll
                      for (int k = 0; k < 4; ++k) pw[d0][k] = d0 < 2 ? cvtpk(pa[8 * d0 + 2 * k], pa[8 * d0 + 2 * k + 1]) : cvtpk(pb[2 * k], pb[2 * k + 1]); } }
              if (d0 == ND - 1) {
#pragma unroll
                  for (int k = 0; k < 4; ++k) pw[3][k] = cvtpk(pb[8 + 2 * k], pb[9 + 2 * k]); }
              if (d0 < 4) {
#pragma unroll
                  for (int dd = 0; dd < 2; ++dd) { const s16x4 lo = vtr(vpp + dd * 4096 + d0 * 1024), h2 = vtr(vpp + dd * 4096 + d0 * 1024 + 512); vf[dd][d0] = (bf16x8){lo[0], lo[1], lo[2], lo[3], h2[0], h2[1], h2[2], h2[3]}; } }
              FA_SB; } }
        mask(t, c0, c1);
        int rmi;
        {
          auto I = [](float x) { return __builtin_bit_cast(int, x); };
          auto mx = [](int a, int b, int c) { const int ab = a > b ? a : b; return ab > c ? ab : c; };
          int am[4];
#pragma unroll
          for (int ks = 0; ks < 4; ++ks) {
              const bf16x8 pf = __builtin_bit_cast(bf16x8, pw[ks]);
              o[0] = __builtin_amdgcn_mfma_f32_32x32x16_bf16(pf, vf[0][ks], o[0], 0, 0, 0); o[1] = __builtin_amdgcn_mfma_f32_32x32x16_bf16(pf, vf[1][ks], o[1], 0, 0, 0);
              o2 = __builtin_amdgcn_mfma_f32_16x16x32_bf16(pf, ones, o2, 0, 0, 0);
              const int r0 = 4 * ks;
#pragma unroll
              for (int r = r0; r < r0 + 4; ++r) pa[r] = FA_EXP(c0[r]);
              int a = mx(I(c0[r0]), I(c1[r0]), I(c0[r0 + 1])); a = mx(a, I(c1[r0 + 1]), I(c0[r0 + 2])); a = mx(a, I(c1[r0 + 2]), I(c0[r0 + 3])); am[ks] = a > I(c1[r0 + 3]) ? a : I(c1[r0 + 3]);
              FA_SB; }
          rmi = mx(am[0], am[1], am[2]); rmi = rmi > am[3] ? rmi : am[3];
          { const auto rr = __builtin_amdgcn_permlane32_swap((unsigned)rmi, (unsigned)rmi, false, false); const int x = (int)rr[0], y = (int)rr[1]; rmi = x > y ? x : y; } }
        asm volatile("" : "+v"(pa));
        cp = c1;
#undef FA_SB
        if (FA_FORCE_RESC || __any(rmi > 0x41000000)) {
            const float rm = __builtin_bit_cast(float, rmi);
            const float dl = fmaxf(rm, 0.f); m += dl;
            const float al = __builtin_amdgcn_exp2f(-dl);
            if (hi == 0) wsf[r32] = al;
#pragma unroll
            for (int r = 0; r < 16; ++r) { pa[r] = FA_EXP(c0[r] - dl); cp[r] -= dl; negm[r] = -m; }
#pragma unroll
            for (int r = 0; r < 16; ++r) { const float a = wsf[crow(r, hi)]; o[0][r] *= a; o[1][r] *= a; }
#pragma unroll
            for (int j = 0; j < 4; ++j) o2[j] *= wsf[q2 + j];
        }
        if (t + 2 < NT) FA_WAIT1(); else FA_WAIT_BAR(0);
    }
    { u32x4 pw[4];
#pragma unroll
      for (int r = 0; r < 16; ++r) pb[r] = FA_EXP(cp[r]);
      sum_pack(pa, pb, pw); pv(NT - 1, pw); }
    asm volatile("s_waitcnt lgkmcnt(0)\n\ts_barrier" ::: "memory");
#undef FA_WAIT1
#undef FA_WAIT_BAR
    if (SINK && hi == 0) wsf[r32] = __builtin_amdgcn_exp2f(u.sinkl - m);
    if ((lane & 7) == 0) {
#pragma unroll
        for (int j = 0; j < 4; ++j) wsf[32 + q2 + j] = o2[j]; }
    LAS bf16_t* stg = (LAS bf16_t*)(lds + OFF_OST + wid * 4096);
#pragma unroll
    for (int r = 0; r < 16; ++r) { const int orow = crow(r, hi); float lr = wsf[32 + orow]; if (SINK) lr += wsf[orow]; const float rl = 1.0f / lr;
        stg[orow * 64 + r32] = f2bf(o[0][r] * rl); stg[orow * 64 + 32 + r32] = f2bf(o[1][r] * rl); }
    bf16_t* Ow = u.O + (size_t)(wid * 32) * u.opitch;
#pragma unroll
    for (int i = 0; i < 4; ++i) { const int row = i * 8 + (lane >> 3), ch = lane & 7; const u32x4 v = *(const LAS u32x4*)(stg + row * 64 + ch * 8); *(u32x4*)(Ow + (size_t)row * u.opitch + ch * 8) = v; }
}
}
__device__ __forceinline__ void phase_attn(Ctx& c, int l, unsigned char* lds_, bool ctx_out) {
    LAS unsigned char* lds = (LAS unsigned char*)lds_;
    const int nl = c.nb * 64, total = 3 * nl + (ctx_out ? 3 * c.nb * 8 : 0);
    for (int ui = c.wg; ui < total; ui += c.nwg) {
        int br, b, h, qb; bool cq;
        if (ui < 3 * nl) { br = 2 - ui / nl; const int i = ui % nl; b = c.b0 + (i >> 6); h = (i >> 3) & 7; qb = i & 7; cq = false; }
        else { const int j = ui - 3 * nl, nc = c.nb * 8; br = 2 - j / nc; const int i = j % nc; b = c.b0 + (i >> 3); h = i & 7; qb = 0; cq = true; }
        const int qrow = cq ? NLAT + b * CTXL : b * SEQ + qb * 256, crow0 = NLAT + b * CTXL, lrow0 = b * SEQ;
        fa::UnitDesc u; u.nt_ctx = 4; u.qoff = 0; u.sinkl = 0.f; u.qss = nullptr; u.qgain = nullptr; u.qrope = nullptr;
        if (br == 2) {
            const unsigned char* sl = c.ws + WS_RA + (size_t)b * RA_BSTR; const int lq = cq ? 2048 : qb * 256;
            u.Q = (const bf16_t*)(sl + RAS_QC) + (size_t)lq * 768 + 96 * h; u.qpitch = 768; u.O = c.P1 + (size_t)qrow * P1W + P_YC + 64 * h; u.opitch = P1W;
            u.Kc = (const bf16_t*)(sl + RAS_KC) + (size_t)2048 * 768 + 96 * h; u.Kl = (const bf16_t*)(sl + RAS_KC) + 96 * h; u.kpitch = 768;
            u.Vc = (const bf16_t*)(sl + RAS_VC) + (size_t)2048 * 512 + 64 * h; u.Vl = (const bf16_t*)(sl + RAS_VC) + 64 * h; u.vpitch = 512;
            u.qss = c.ssq + (size_t)qrow * 24 + 3 * h; u.qgain = c.p->in[20] + l * 96; u.qrope = cq ? nullptr : c.rope_c + (size_t)(qb * 256) * 32;
            u.nt_lat = cq ? 0 : 32;
            fa::attn_unit<96, false, false>(u, lds, c.wave);
        } else {
            const int qo = br == 0 ? P_QA : P_QB, ko = (br == 0 ? P_KA : P_KB) + 64 * (h >> 2), vo = (br == 0 ? P_VA : P_VB) + 64 * (h >> 2);
            bf16_t* qp = c.P1 + (size_t)qrow * P1W + qo + 64 * h;
            u.Q = qp; u.O = qp; u.qpitch = P1W; u.opitch = P1W; u.kpitch = P1W; u.vpitch = P1W;
            u.Kc = c.P1 + (size_t)crow0 * P1W + ko; u.Vc = c.P1 + (size_t)crow0 * P1W + vo;
            if (br == 1) { u.Kl = c.P1 + (size_t)lrow0 * P1W + ko; u.Vl = c.P1 + (size_t)lrow0 * P1W + vo; u.nt_lat = cq ? 0 : 32;
                fa::attn_unit<64, false, false>(u, lds, c.wave); }
            else {
                u.sinkl = c.p->in[13][l * 8 + h] * LOG2E;
                if (cq) { u.Kl = u.Kc; u.Vl = u.Vc; u.nt_lat = 0; fa::attn_unit<64, false, true>(u, lds, c.wave); }
                else { const int lt0 = 4 * qb - 2 < 0 ? 0 : 4 * qb - 2, lt1 = 4 * qb + 5 > 31 ? 31 : 4 * qb + 5;
                    u.Kl = c.P1 + (size_t)(lrow0 + 64 * lt0) * P1W + ko; u.Vl = c.P1 + (size_t)(lrow0 + 64 * lt0) * P1W + vo; u.nt_lat = lt1 - lt0 + 1; u.qoff = 256 * qb - 64 * lt0;
                    fa::attn_unit<64, true, true>(u, lds, c.wave); }
            }
        }
    }
}

constexpr int CW_BAR = 4096;
constexpr int MISC_OFF = 131072 + 320;
#define XB_TMO      128
#define XB_XCNT(j)  (256  + 64 * (j))
#define XB_XSUB(j)  (1280 + 64 * (j))
#define XB_XGEN(j)  (2304 + 64 * (j))
#define XB_TOP      3328
#define XB_TOPGEN   3392
#define XCD_BAR_WORDS 3456
#define XB_SPIN_CAP (1u << 18)
__device__ __forceinline__ unsigned xb_ld(unsigned* p)              { return __hip_atomic_load(p, __ATOMIC_RELAXED, __HIP_MEMORY_SCOPE_AGENT); }
__device__ __forceinline__ unsigned xb_add(unsigned* p, unsigned v) { return __hip_atomic_fetch_add(p, v, __ATOMIC_RELAXED, __HIP_MEMORY_SCOPE_AGENT); }
__device__ __forceinline__ unsigned xb_xcc_id() { return (unsigned)__builtin_amdgcn_s_getreg((3 << 11) | 20) & 0xFu; }
#define XB_SPIN(cond, bar) do { unsigned _sp = 0; while (cond) { __builtin_amdgcn_s_sleep(1); \
    if ((++_sp & 255u) == 0u) { if (xb_ld(&(bar)[XB_TMO])) break; if (_sp > XB_SPIN_CAP) { atomicAdd(&(bar)[XB_TMO], 1u); break; } } } } while (0)
struct XcdBarrier { unsigned* bar; unsigned x; volatile LAS unsigned* st; };
__device__ __forceinline__ void xcd_barrier_complete(unsigned* bar, unsigned x, unsigned& nloc, unsigned& nx) {
    const unsigned G = gridDim.x * gridDim.y * gridDim.z;
    unsigned sum, cnt, mine, sp = 0u;
    for (;;) {
        sum = 0u; cnt = 0u; mine = 0u;
#pragma unroll
        for (unsigned j = 0; j < 16; ++j) { const unsigned cc = xb_ld(&bar[XB_XCNT(j)]); sum += cc; cnt += (cc > 0u) ? 1u : 0u; mine = (j == x) ? cc : mine; }
        if (sum == G) break;
        __builtin_amdgcn_s_sleep(1);
        if ((++sp & 255u) == 0u) { if (xb_ld(&bar[XB_TMO])) break; if (sp > XB_SPIN_CAP) { atomicAdd(&bar[XB_TMO], 1u); break; } }
    }
    nloc = mine > 0u ? mine : 1u; nx = cnt > 0u ? cnt : 1u;
}
__device__ __forceinline__ void xcd_barrier(const XcdBarrier& b, int wave, bool local = false) {
    asm volatile("s_waitcnt vmcnt(0)" ::: "memory");
    __syncthreads();
    if (wave == 0 && lane_id() == 0) {
        unsigned* bar = b.bar;
        __builtin_amdgcn_s_waitcnt(0);
        unsigned nloc = b.st[0], nx = b.st[1];
        if (nloc == 0u) { xcd_barrier_complete(bar, b.x, nloc, nx); b.st[0] = nloc; b.st[1] = nx; }
        const unsigned old = xb_add(&bar[XB_XSUB(b.x)], 1u);
        const unsigned gen = old / nloc;
        if (old + 1u == (gen + 1u) * nloc && local) {
            xb_add(&bar[XB_XGEN(b.x)], 1u);
            __builtin_amdgcn_fence(__ATOMIC_ACQUIRE, "agent");
            asm volatile("s_waitcnt vmcnt(0)" ::: "memory");
        } else if (old + 1u == (gen + 1u) * nloc) {
            __builtin_amdgcn_fence(__ATOMIC_RELEASE, "agent");
            asm volatile("s_waitcnt vmcnt(0)" ::: "memory");
            const unsigned og = xb_add(&bar[XB_TOP], 1u);
            const unsigned tg = og / nx;
            if (og + 1u == (tg + 1u) * nx) xb_add(&bar[XB_TOPGEN], 1u);
            else XB_SPIN(xb_ld(&bar[XB_TOPGEN]) == tg, bar);
            __builtin_amdgcn_fence(__ATOMIC_ACQUIRE, "agent");
            xb_add(&bar[XB_XGEN(b.x)], 1u);
            asm volatile("s_waitcnt vmcnt(0)" ::: "memory");
        } else {
            XB_SPIN(xb_ld(&bar[XB_XGEN(b.x)]) == gen, bar);
            __builtin_amdgcn_fence(__ATOMIC_ACQUIRE, "agent");
            asm volatile("s_waitcnt vmcnt(0)" ::: "memory");
        }
    }
    __syncthreads();
}

template <int S> __device__ __forceinline__ void run_stage(Ctx& c, int l, unsigned char* lds) {
    const Params* p = c.p;
    const bool last = l == DEPTH - 1;
    const int rows_all = MT, rows_mix = last ? NLAT : MT;
    if constexpr (S == -1) phase_mod(c, (float*)lds);
    if constexpr (S == 0) phase_norm(c, l, p->in[6] + l * D, 0, rows_all, l == 0);
    if constexpr (S == 1) naive_ffn_up(c, p->in[7] + (size_t)l * D * 2 * DFF, rows_all);
    if constexpr (S == 2) naive_res(c, l, c.ACT, DFF, DFF, p->in[8] + (size_t)l * DFF * D, 0.5f, 2, rows_all, l == 0);
    if constexpr (S == 3) phase_norm(c, l, p->in[9] + l * D, 3, rows_all, false);
    if constexpr (S == 4) naive_inproj(c, l, rows_all);
    if constexpr (S == 5) naive_rowss(c, rows_all);
    if constexpr (S == 6) { naive_mla_q(c, l, rows_mix); naive_mla_kv(c, l, rows_all); }
    if constexpr (S == 7) naive_attn(c, l, 0, rows_mix);
    if constexpr (S == 8) naive_gates(c, l, rows_mix);
    if constexpr (S == 9) naive_merge(c, l, rows_mix);
    if constexpr (S == 10) naive_res(c, l, c.H, D, D, p->in[25] + (size_t)l * D * D, 1.0f, 5, rows_mix, false);
    if constexpr (S == 11) phase_norm(c, l, p->in[26] + l * D, 6, rows_mix, false);
    if constexpr (S == 12) naive_ffn_up(c, p->in[27] + (size_t)l * D * 2 * DFF, rows_mix);
    if constexpr (S == 13) naive_res(c, l, c.ACT, DFF, DFF, p->in[28] + (size_t)l * DFF * D, 0.5f, 8, rows_mix, false);
    if constexpr (S == 20) phase_convert(c, l, lds);
    if constexpr (S == 21) fast_ffn_up(c, lds, WO_F1IN, rows_all);
    if constexpr (S == 22) fast_res(c, lds, l, c.ACT, DFF, WO_F1OUT, 0.5f, 2, rows_all, l == 0);
    if constexpr (S == 24) fast_inproj(c, lds, l, rows_all);
    if constexpr (S == 26) fast_mla_up(c, lds, l, rows_mix, rows_all);
    if constexpr (S == 27) phase_mla_norm(c, l, rows_mix, rows_all);
    if constexpr (S == 28) fast_gates(c, lds, rows_mix);
    if constexpr (S == 29) fast_merge(c, lds, rows_mix);
    if constexpr (S == 30) fast_res(c, lds, l, c.H, D, WO_OUT, 1.0f, 5, rows_mix, false);
    if constexpr (S == 32) fast_ffn_up(c, lds, WO_F2IN, rows_mix);
    if constexpr (S == 33) fast_res(c, lds, l, c.ACT, DFF, WO_F2OUT, 0.5f, 8, rows_mix, false);
    if constexpr (S == 40) phase_attn(c, l, lds, !last);
    if constexpr (S == 50) phase_convert_bias(c, l, lds);
    if constexpr (S == 51) phase_xg(c, 0, p->in[6], 0, MT, true);
    if constexpr (S == 52) fz_ffn_up(c, lds, WO_F1IN, BO_F1, rows_all);
    if constexpr (S == 53) fz_res(c, lds, l, c.ACT, DFF, DFF, WO_F1OUT, 0.5f, 2, rows_all, l == 0, 9, l * D, l, 3);
    if constexpr (S == 54) fz_inproj(c, lds, l, rows_all);
    if constexpr (S == 55) fz_gates(c, lds, rows_mix);
    if constexpr (S == 56) fz_merge(c, lds, rows_mix);
    if constexpr (S == 57) fz_res(c, lds, l, (const bf16_t*)(c.ws + WS_YC), D, D, WO_OUT, 1.0f, 5, rows_mix, false, 26, l * D, l, 6);
    if constexpr (S == 58) fz_ffn_up(c, lds, WO_F2IN, BO_F2, rows_mix);
    { const int nz = 4 * c.nctx, g1 = c.nwg - nz, cz = c.wg >= g1 ? c.wg - g1 : -1;
    if constexpr (S == 60) fz_ffn_up_sub(c, lds, WO_F1IN, BO_F1, c.ctx0, c.nctx, c.nwg, c.wg, 1 << 20, c.nwg);
    if constexpr (S == 61) { fz_res_sub(c, lds, l, WO_F1OUT, 2, l == 0, 9, l * D, l, 3, c.ctx0, c.nctx, nz, cz);
                             fz_ffn_up_sub(c, lds, WO_F1IN, BO_F1, c.lat0, c.nlat, c.nwg, c.wg, 3, g1); }
    if constexpr (S == 62) fz_res_sub(c, lds, l, WO_F1OUT, 2, l == 0, 9, l * D, l, 3, c.lat0, c.nlat, c.nwg, c.wg);
    if constexpr (S == 63) fz_ffn_up_sub(c, lds, WO_F2IN, BO_F2, c.ctx0, c.nctx, c.nwg, c.wg, 1 << 20, c.nwg);
    if constexpr (S == 64) { fz_res_sub(c, lds, l, WO_F2OUT, 8, false, 6, (l + 1) * D, l + 1, 0, c.ctx0, c.nctx, nz, cz);
                             fz_ffn_up_sub(c, lds, WO_F2IN, BO_F2, c.lat0, c.nlat, c.nwg, c.wg, 3, g1); }
    if constexpr (S == 65) fz_res_sub(c, lds, l, WO_F2OUT, 8, false, 6, (l + 1) * D, l + 1, 0, c.lat0, c.nlat, c.nwg, c.wg); }
    if constexpr (S == 59) fz_res(c, lds, l, c.ACT, DFF, DFF, WO_F2OUT, 0.5f, 8, rows_mix, false, last ? -1 : 6, (l + 1) * D, last ? l : l + 1, 0);
}
template <int S> __global__ void __launch_bounds__(512, 2) k_stage(Params prm, int l) {
    extern __shared__ __attribute__((aligned(16))) unsigned char lds[];
    Ctx c; ctx_init(c, &prm, blockIdx.x, gridDim.x);
    run_stage<S>(c, l, lds);
}
constexpr int LDS_NAIVE = 65536, LDS_FAST = 147456;
#ifndef MULTI
#define MULTI 0
#endif
#ifndef PROBE_K
#define PROBE_K -1
#endif
#ifndef PROBE_WG
#define PROBE_WG 0
#endif
#ifndef PROBE_SCALE
#define PROBE_SCALE 10000.0f
#endif
__global__ void __launch_bounds__(512, 2) mega_kernel(Params prm) {
    extern __shared__ __attribute__((aligned(16))) unsigned char lds[];
    Ctx c; ctx_init(c, &prm, blockIdx.x, gridDim.x);
    volatile LAS unsigned* MISC = (volatile LAS unsigned*)((LAS unsigned char*)lds + MISC_OFF);
    { const int ln = lane_id(); if (c.wave == 0 && ln < 32) MISC[ln] = 0u; }
    __syncthreads();
    XcdBarrier bar; bar.bar = (unsigned*)(prm.ws + WS_CTL) + CW_BAR; bar.x = xb_xcc_id(); bar.st = MISC + 8;
    if (c.wave == 0 && lane_id() == 0) MISC[10] = xb_add(&bar.bar[XB_XCNT(bar.x)], 1u);
    __syncthreads();
#if PROBE_K >= 0
    unsigned long long tacc = 0, t0 = __builtin_amdgcn_s_memrealtime(), t1; int lastk = -1;
#ifndef PROBE_INCL_BAR
#define PROBE_INCL_BAR 0
#endif
#if PROBE_K >= 10
#define PH(k, body) do { t0 = __builtin_amdgcn_s_memtime(); body; t1 = __builtin_amdgcn_s_memtime(); lastk = (k); if (PROBE_K - 10 == (k)) tacc += t1 - t0; } while (0)
#else
#define PH(k, body) do { t0 = __builtin_amdgcn_s_memrealtime(); body; t1 = __builtin_amdgcn_s_memrealtime(); lastk = (k); if (PROBE_K == (k) || PROBE_K == 7) tacc += t1 - t0; } while (0)
#endif
#define GRID_BAR() do { t0 = __builtin_amdgcn_s_memrealtime(); xcd_barrier(bar, c.wave); t1 = __builtin_amdgcn_s_memrealtime(); if (PROBE_K == 1 || PROBE_K == 7 || (PROBE_INCL_BAR && PROBE_K == lastk)) tacc += t1 - t0; } while (0)
#define LBAR() do { t0 = __builtin_amdgcn_s_memrealtime(); xcd_barrier(bar, c.wave, local); t1 = __builtin_amdgcn_s_memrealtime(); if (PROBE_K == 1 || PROBE_K == 7 || (PROBE_INCL_BAR && PROBE_K == lastk)) tacc += t1 - t0; } while (0)
#else
#define PH(k, body) do { body; } while (0)
#define GRID_BAR() xcd_barrier(bar, c.wave)
#define LBAR() xcd_barrier(bar, c.wave, local)
#endif
    PH(6, run_stage<-1>(c, 0, lds)); GRID_BAR();
    bool local = false; int gb = 0;
    { int npop = 0, below = 0; bool uni = true;
#pragma unroll
      for (unsigned j = 0; j < 16; ++j) { const unsigned cj = (unsigned)__builtin_amdgcn_readfirstlane((int)xb_ld(&bar.bar[XB_XCNT(j)])); if (cj) { ++npop; uni = uni && cj == 32u; below += (j < bar.x) ? 1 : 0; } }
      local = gridDim.x == 256 && npop == 8 && uni; gb = below; }
    const int gwg = c.wg, gnwg = c.nwg;
    const int lrank = __builtin_amdgcn_readfirstlane((int)MISC[10]);
#define SET_LOCAL() do { if (local) { c.wg = lrank; c.nwg = 32; c.lat0 = 8 * gb; c.nlat = 8; c.ctx0 = NLAT / 256 + gb; c.nctx = 1; c.b0 = gb; c.nb = 1; } } while (0)
#define SET_GLOBAL() do { c.wg = gwg; c.nwg = gnwg; c.lat0 = 0; c.nlat = NLAT / 256; c.ctx0 = NLAT / 256; c.nctx = NCTX / 256; c.b0 = 0; c.nb = NB_; } while (0)
#pragma unroll 1
    for (int l = 0; l < DEPTH; ++l) {
        SET_GLOBAL();
        PH(6, run_stage<50>(c, l, lds); if (l == 0) run_stage<51>(c, l, lds)); GRID_BAR();
        SET_LOCAL();
        const bool split = c.nctx > 0 && (c.nwg - 4 * c.nctx) * 2 >= c.nwg && c.nlat * 22 >= 3 * c.nwg;
        if (split) { PH(2, run_stage<60>(c, l, lds)); LBAR(); PH(2, run_stage<61>(c, l, lds)); LBAR(); PH(3, run_stage<62>(c, l, lds)); LBAR(); }
        else { PH(2, run_stage<52>(c, l, lds)); LBAR(); PH(3, run_stage<53>(c, l, lds)); LBAR(); }
        PH(4, run_stage<54>(c, l, lds)); LBAR();
        PH(5, run_stage<26>(c, l, lds)); LBAR();
        PH(0, run_stage<40>(c, l, lds)); LBAR();
        PH(4, run_stage<55>(c, l, lds)); LBAR();
        PH(5, run_stage<56>(c, l, lds)); LBAR();
        PH(5, run_stage<57>(c, l, lds)); LBAR();
        if (l + 1 < DEPTH) {
            if (split) { PH(2, run_stage<63>(c, l, lds)); LBAR(); PH(2, run_stage<64>(c, l, lds)); LBAR(); PH(3, run_stage<65>(c, l, lds)); }
            else { PH(2, run_stage<58>(c, l, lds)); LBAR(); PH(3, run_stage<59>(c, l, lds)); }
            GRID_BAR();
        } else { PH(2, run_stage<58>(c, l, lds)); LBAR(); PH(3, run_stage<59>(c, l, lds)); }
    }
#undef SET_LOCAL
#undef SET_GLOBAL
#undef LBAR
#if PROBE_K >= 0
    xcd_barrier(bar, c.wave);
    if (blockIdx.x == PROBE_WG && c.wave == 0 && lane_id() == 0) prm.out[0] +=
#ifdef FA_FAKE
        (float)((tacc / 1600ull) * 16ull) / PROBE_SCALE;
#else
        (float)tacc * 0.01f / PROBE_SCALE;
#endif
    (void)0;
#endif
#undef GRID_BAR
#undef PH
}
#ifndef PROBE_WG
#define PROBE_WG 0
#endif
static int g_cus = 0;
template <int S> static void launch_stage(const Params& p, int l, hipStream_t stream) {
    constexpr bool fast = S >= 20;
    static int inited = 0;
    if (!inited) { (void)hipFuncSetAttribute((const void*)k_stage<S>, hipFuncAttributeMaxDynamicSharedMemorySize, fast ? LDS_FAST : LDS_NAIVE); inited = 1; }
    hipLaunchKernelGGL(k_stage<S>, dim3(fast ? g_cus : 1024), dim3(512), fast ? LDS_FAST : LDS_NAIVE, stream, p, l);
}
#ifndef FASTMASK
#define FASTMASK 0xffff
#endif
template <int BIT, int SF, int SN> static void launch_sel(const Params& p, int l, hipStream_t stream) { if constexpr ((FASTMASK >> BIT) & 1) launch_stage<SF>(p, l, stream); else launch_stage<SN>(p, l, stream); }

extern "C" void kernel_launch(void* const* d_in, const int* in_sizes, int n_in, void* d_out, int out_size, void* d_ws, size_t ws_size, hipStream_t stream) {
    if (n_in != 29 || out_size != NLAT * D || ws_size < WS_END) { fprintf(stderr, "kernel_launch: unexpected shapes (n_in %d out %d ws %zu need %zu)\n", n_in, out_size, ws_size, (size_t)WS_END); return; }
    if (!g_cus) { int dev = 0; (void)hipGetDevice(&dev); (void)hipDeviceGetAttribute(&g_cus, hipDeviceAttributeMultiprocessorCount, dev); if (g_cus <= 0) g_cus = 256;
        (void)hipFuncSetAttribute((const void*)mega_kernel, hipFuncAttributeMaxDynamicSharedMemorySize, LDS_FAST); }
    Params p{};
    for (int i = 0; i < 29; ++i) p.in[i] = (const float*)d_in[i];
    p.out = (float*)d_out; p.ws = (unsigned char*)d_ws;
    for (int f = 0; f < 16; ++f) p.invf_hd[f] = (float)pow(10000.0, -(double)f / 16.0);
    for (int f = 0; f < 8; ++f) p.invf_c[f] = (float)pow(10000.0, -(double)f / 8.0);
    (void)hipMemsetAsync((char*)d_ws + WS_CTL, 0, 64u << 10, stream);
#if !MULTI
    hipLaunchKernelGGL(mega_kernel, dim3(g_cus), dim3(512), LDS_FAST, stream, p);
#else
    launch_stage<-1>(p, 0, stream);
    for (int l = 0; l < DEPTH; ++l) {
        launch_stage<20>(p, l, stream);
        launch_stage<0>(p, l, stream);
        launch_sel<0, 21, 1>(p, l, stream);
        launch_sel<1, 22, 2>(p, l, stream);
        launch_stage<3>(p, l, stream);
        launch_sel<2, 24, 4>(p, l, stream);
        if constexpr (!((FASTMASK >> 2) & 1)) launch_stage<5>(p, l, stream);
        if constexpr ((FASTMASK >> 3) & 1) { launch_stage<26>(p, l, stream); } else launch_stage<6>(p, l, stream);
        launch_sel<9, 40, 7>(p, l, stream);
        launch_sel<4, 28, 8>(p, l, stream);
        launch_sel<5, 29, 9>(p, l, stream);
        launch_sel<6, 30, 10>(p, l, stream);
        launch_stage<11>(p, l, stream);
        launch_sel<7, 32, 12>(p, l, stream);
        launch_sel<8, 33, 13>(p, l, stream);
    }
#endif
}
```

```cpp
#include <hip/hip_runtime.h>
#include <cstdio>
#include <cstdint>
#include <cmath>

constexpr int D = 1024, NB_ = 8, SEQ = 2048, CTXL = 256, DFF = 2816, DEPTH = 2;
constexpr int NLAT = NB_ * SEQ;
constexpr int NCTX = NB_ * CTXL;
constexpr int MT = NLAT + NCTX;
constexpr int NMOD = 9, MODW = NMOD * D;
constexpr int INC = 5280;
constexpr int O_AK = 0, O_AV = 128, O_BK = 256, O_BV = 384, O_CKV = 512, O_CKR = 768, O_AQ = 800, O_BQ = 1312, O_CQ = 1824, O_G = 2208;
constexpr int P1W = 2304;
constexpr int P_KA = 0, P_VA = 128, P_KB = 256, P_VB = 384, P_CKV = 512, P_CQ = 768, P_CKR = 1152, P_QA = 1280, P_QB = 1792;
constexpr int P_YC = 768;
constexpr float EPS = 1e-6f;
constexpr float LOG2E = 1.4426950408889634f;
constexpr float QSC64 = 0.125f * LOG2E;
constexpr float QSC96 = 0.10206207261596575f * LOG2E;

typedef unsigned short bf16_t;
typedef short bf16x8 __attribute__((ext_vector_type(8)));
typedef float f32x4 __attribute__((ext_vector_type(4)));
typedef unsigned u32x4 __attribute__((ext_vector_type(4)));
typedef unsigned u32x2 __attribute__((ext_vector_type(2)));

constexpr size_t WS_CTL = 0;
constexpr size_t WS_MOD = 1u << 20;
constexpr size_t WS_ROPE_HD = WS_MOD + (size_t)DEPTH * 9 * MODW * 4;
constexpr size_t WS_ROPE_C = WS_ROPE_HD + (size_t)SEQ * 32 * 2 * 4;
constexpr size_t WS_ROWSS = WS_ROPE_C + (size_t)SEQ * 16 * 2 * 4;
constexpr size_t WS_Z = WS_ROWSS + (size_t)MT * 12 * 4;
constexpr size_t WS_H = WS_Z + (size_t)NCTX * D * 4;
constexpr size_t WS_RA = WS_H + (size_t)MT * D * 2;
constexpr size_t RA_BYTES = (size_t)MT * 3072 * 2;
constexpr size_t WS_P1 = WS_RA + RA_BYTES;
constexpr size_t WS_YC = WS_P1 + (size_t)MT * P1W * 2;
constexpr size_t WS_W = WS_YC + (size_t)MT * 1024 * 2;
constexpr size_t WS_SSQ = WS_W + 52000000u;
constexpr size_t WS_SS = WS_SSQ + (size_t)MT * 24 * 4;
constexpr int NBIAS = 16640, BO_F1 = 0, BO_P1 = 5632, BO_G = 7936, BO_F2 = 11008;
constexpr size_t WS_BIAS = WS_SS + (size_t)MT * 16 * 4;
constexpr size_t WS_END = WS_BIAS + (size_t)2 * 9 * NBIAS * 4;
constexpr size_t RA_QC = 0, RA_KC = (size_t)MT * 768 * 2, RA_KVR = 2 * (size_t)MT * 768 * 2;
constexpr size_t RA_VC = RA_KVR;
constexpr size_t RA_BSTR = (size_t)2304 * 6144;
static_assert(RA_BSTR * 8 == RA_BYTES, "RA slices");
constexpr size_t RAS_QC = 0, RAS_KC = (size_t)2304 * 1536, RAS_VC = (size_t)2 * 2304 * 1536;
__device__ __forceinline__ size_t ra_panel_off(int pm, int pitch_bytes) { const int b = pm < NLAT / 256 ? pm >> 3 : pm - NLAT / 256, lp = pm < NLAT / 256 ? pm & 7 : 8; return (size_t)b * RA_BSTR + (size_t)lp * 256 * pitch_bytes; }

struct Params {
    const float* in[29];
    float* out;
    unsigned char* ws;
    float invf_hd[16];
    float invf_c[8];
    int ph_lo, ph_hi;
};

__device__ __forceinline__ float bf2f(bf16_t v) { return __uint_as_float((unsigned)v << 16); }
__device__ __forceinline__ bf16_t f2bf(float f) { unsigned u = __float_as_uint(f); return (bf16_t)((u + 0x7fffu + ((u >> 16) & 1u)) >> 16); }
__device__ __forceinline__ unsigned pk2(float lo, float hi) { return (unsigned)f2bf(lo) | ((unsigned)f2bf(hi) << 16); }
__device__ __forceinline__ float sigmoidf_(float v) { return 1.0f / (1.0f + __expf(-v)); }
__device__ __forceinline__ int row_mb(int r) { return r < NLAT ? (r >> 11) : 8; }

__device__ __forceinline__ int lane_id() { int l; asm volatile("v_mbcnt_lo_u32_b32 %0, -1, 0\n\tv_mbcnt_hi_u32_b32 %0, -1, %0" : "=v"(l)); return l; }
#define PH_IDS(c) const int lane_ = lane_id(); const int tid_ = (c).wave * 64 + lane_; (void)tid_
struct Ctx {
    const Params* p;
    int wave, wg, nwg;
    int lat0, nlat, ctx0, nctx, b0, nb;
    unsigned char* ws;
    float* mod; float* rope_hd; float* rope_c; float* rowss; float* Z; bf16_t* H; bf16_t* ACT; bf16_t* QC; bf16_t* KC; bf16_t* KVR; bf16_t* VC; float* ssq; float* ss; float* bias; bf16_t* G; bf16_t* P1; bf16_t* YC;
};
__device__ __forceinline__ void ctx_init(Ctx& c, const Params* p, int wg, int nwg) {
    c.p = p; c.wave = __builtin_amdgcn_readfirstlane((int)threadIdx.x >> 6); c.wg = wg; c.nwg = nwg; c.lat0 = 0; c.nlat = NLAT / 256; c.ctx0 = NLAT / 256; c.nctx = NCTX / 256; c.b0 = 0; c.nb = NB_;
    unsigned char* ws = p->ws; c.ws = ws;
    c.mod = (float*)(ws + WS_MOD); c.rope_hd = (float*)(ws + WS_ROPE_HD); c.rope_c = (float*)(ws + WS_ROPE_C); c.rowss = (float*)(ws + WS_ROWSS);
    c.Z = (float*)(ws + WS_Z); c.H = (bf16_t*)(ws + WS_H); c.ACT = (bf16_t*)(ws + WS_RA);
    c.QC = (bf16_t*)(ws + WS_RA + RA_QC); c.KC = (bf16_t*)(ws + WS_RA + RA_KC); c.KVR = (bf16_t*)(ws + WS_RA + RA_KVR); c.VC = (bf16_t*)(ws + WS_RA + RA_VC); c.ssq = (float*)(ws + WS_SSQ); c.ss = (float*)(ws + WS_SS); c.bias = (float*)(ws + WS_BIAS); c.G = (bf16_t*)(ws + WS_RA);
    c.P1 = (bf16_t*)(ws + WS_P1); c.YC = (bf16_t*)(ws + WS_YC);
}
__device__ __forceinline__ const float* xin_row(const Ctx& c, int r, bool from_input) {
    if (from_input) return r < NLAT ? c.p->in[0] + (size_t)r * D : c.p->in[2] + (size_t)(r - NLAT) * D;
    return r < NLAT ? c.p->out + (size_t)r * D : c.Z + (size_t)(r - NLAT) * D;
}
__device__ __forceinline__ float* xout_row(const Ctx& c, int r) { return r < NLAT ? c.p->out + (size_t)r * D : c.Z + (size_t)(r - NLAT) * D; }

__device__ __forceinline__ void sincos_d(double x, float& s, float& c) {
    const double TWO_PI = 6.283185307179586476925286766559;
    const double k = rint(x * (1.0 / TWO_PI)); const double r = x - k * TWO_PI; const double r2 = r * r;
    double ts = r, ss = r, tc = 1.0, sc = 1.0;
    for (int n = 1; n <= 15; ++n) { ts *= -r2 / (double)((2 * n) * (2 * n + 1)); ss += ts; tc *= -r2 / (double)((2 * n - 1) * (2 * n)); sc += tc; }
    s = (float)ss; c = (float)sc;
}
__device__ __forceinline__ void phase_mod(Ctx& c, float* lds) {
    PH_IDS(c);
    const Params* p = c.p;
    float* cond = lds;
    float* red = lds + 9 * 1024;
    for (int i = tid_; i < 9 * 1024; i += 512) { const int mb = i >> 10, k = i & 1023; const float v = mb < 8 ? p->in[1][mb * 1024 + k] : p->in[3][k]; cond[i] = v * sigmoidf_(v); }
    __syncthreads();
    const int ksl = tid_ >> 3, c4 = (tid_ & 7) * 4;
    for (int u = c.wg; u < DEPTH * MODW / 32; u += c.nwg) {
        const int n0 = u * 32, l = n0 / MODW, nn = n0 % MODW;
        f32x4 wv[16];
        const float* w = p->in[4] + ((size_t)l * D + ksl * 16) * MODW + nn + c4;
#pragma unroll
        for (int k = 0; k < 16; ++k) wv[k] = *(const f32x4*)(w + (size_t)k * MODW);
        f32x4 acc[9];
#pragma unroll
        for (int m = 0; m < 9; ++m) acc[m] = (f32x4){0.f, 0.f, 0.f, 0.f};
#pragma unroll
        for (int k = 0; k < 16; ++k)
#pragma unroll
            for (int m = 0; m < 9; ++m) acc[m] += wv[k] * cond[m * 1024 + ksl * 16 + k];
#pragma unroll
        for (int m = 0; m < 9; ++m)
#pragma unroll
            for (int e = 0; e < 4; ++e) { float v = acc[m][e]; v += __shfl_xor(v, 8); v += __shfl_xor(v, 16); v += __shfl_xor(v, 32); acc[m][e] = v; }
        if (lane_ < 8) {
#pragma unroll
            for (int m = 0; m < 9; ++m) *(f32x4*)(red + (c.wave * 9 + m) * 32 + c4) = acc[m]; }
        __syncthreads();
        for (int o = tid_; o < 9 * 32; o += 512) { const int m = o >> 5, c2 = o & 31; float sacc = 0.f;
#pragma unroll
            for (int k2 = 0; k2 < 8; ++k2) sacc += red[(k2 * 9 + m) * 32 + c2];
            c.mod[((size_t)l * 9 + m) * MODW + nn + c2] = sacc + p->in[5][(size_t)l * MODW + nn + c2]; }
        __syncthreads();
    }
    const int gt = c.wg * 512 + tid_, ngt = c.nwg * 512;
    for (int i = gt; i < SEQ * 48; i += ngt) {
        const int s = i / 48, j = i % 48; const int row = s >> 6, col = s & 63; float sn, cs;
        if (j < 32) { const double ang = (double)(j < 16 ? row : col) * (double)p->invf_hd[j & 15]; sincos_d(ang, sn, cs); c.rope_hd[(s * 32 + j) * 2] = cs; c.rope_hd[(s * 32 + j) * 2 + 1] = sn; }
        else { const int jj = j - 32; const double ang = (double)(jj < 8 ? row : col) * (double)p->invf_c[jj & 7]; sincos_d(ang, sn, cs); c.rope_c[(s * 16 + jj) * 2] = cs; c.rope_c[(s * 16 + jj) * 2 + 1] = sn; }
    }
}

__device__ __forceinline__ float wave_sum(float v) {
#pragma unroll
    for (int o = 1; o < 64; o <<= 1) v += __shfl_xor(v, o);
    return v;
}
__device__ __forceinline__ void phase_norm(Ctx& c, int l, const float* gain, int shift_idx, int rows, bool from_input) {
    PH_IDS(c);
    const int gw = c.wg * 8 + c.wave, ngw = c.nwg * 8;
    for (int r = gw; r < rows; r += ngw) {
        const f32x4* xr = (const f32x4*)xin_row(c, r, from_input) + lane_;
        f32x4 v[4]; float s = 0.f;
#pragma unroll
        for (int j = 0; j < 4; ++j) { v[j] = xr[64 * j]; s += (v[j].x * v[j].x + v[j].y * v[j].y) + (v[j].z * v[j].z + v[j].w * v[j].w); }
        const float rstd = 1.0f / sqrtf(wave_sum(s) * (1.0f / D) + EPS);
        const float* md = c.mod + ((size_t)l * 9 + row_mb(r)) * MODW;
        unsigned long long* o8 = (unsigned long long*)(c.H + (size_t)r * D) + lane_;
#pragma unroll
        for (int j = 0; j < 4; ++j) { const int k = 4 * lane_ + 256 * j;
            const f32x4 g = *(const f32x4*)(gain + k), sh = *(const f32x4*)(md + shift_idx * D + k), sc = *(const f32x4*)(md + (shift_idx + 1) * D + k);
            const f32x4 y = v[j] * rstd * g * (sc + 1.0f) + sh;
            o8[64 * j] = (unsigned long long)pk2(y.x, y.y) | ((unsigned long long)pk2(y.z, y.w) << 32); }
    }
}

__device__ __forceinline__ void phase_xg(Ctx& c, int l, const float* gain, int shift_idx, int rows, bool from_input) {
    PH_IDS(c);
    const int gw = c.wg * 8 + c.wave, ngw = c.nwg * 8;
    const int per = (rows + ngw - 1) / ngw;
    const int r0 = gw * per, r1 = r0 + per < rows ? r0 + per : rows;
    if (r0 >= rows) return;
    f32x4 v[4], nx[4], gs[4]; int mbc = -1;
    { const f32x4* xr = (const f32x4*)xin_row(c, r0, from_input) + lane_;
#pragma unroll
      for (int j = 0; j < 4; ++j) nx[j] = xr[64 * j]; }
    for (int r = r0; r < r1; ++r) {
#pragma unroll
        for (int j = 0; j < 4; ++j) v[j] = nx[j];
        if (r + 1 < r1) { const f32x4* xr = (const f32x4*)xin_row(c, r + 1, from_input) + lane_;
#pragma unroll
            for (int j = 0; j < 4; ++j) nx[j] = xr[64 * j]; }
        const int mb = row_mb(r);
        if (mb != mbc) { mbc = mb; const float* md = c.mod + ((size_t)l * 9 + mb) * MODW + (shift_idx + 1) * D;
#pragma unroll
            for (int j = 0; j < 4; ++j) { const int k = 4 * lane_ + 256 * j; gs[j] = *(const f32x4*)(gain + k) * (*(const f32x4*)(md + k) + 1.0f); } }
        float s = 0.f;
#pragma unroll
        for (int j = 0; j < 4; ++j) s += (v[j].x * v[j].x + v[j].y * v[j].y) + (v[j].z * v[j].z + v[j].w * v[j].w);
        s = wave_sum(s);
        unsigned long long* o8 = (unsigned long long*)(c.H + (size_t)r * D) + lane_;
#pragma unroll
        for (int j = 0; j < 4; ++j) { const f32x4 y = v[j] * gs[j]; o8[64 * j] = (unsigned long long)pk2(y.x, y.y) | ((unsigned long long)pk2(y.z, y.w) << 32); }
        if (lane_ < 16) c.ss[(size_t)r * 16 + lane_] = lane_ == 0 ? s : 0.f;
    }
}

template <int NB>
__device__ __forceinline__ void naive_tile(const bf16_t* A, int lda, int K, int row0, const float* const (&wp)[NB], int ldw, const float* kscale, f32x4 (&acc)[NB], int lane) {
    const int r = lane & 15, q = lane >> 4;
    const bf16_t* ap = A + (size_t)(row0 + r) * lda + q * 8;
    for (int k0 = 0; k0 < K; k0 += 32) {
        const bf16x8 a = *(const bf16x8*)(ap + k0);
        float ks[8];
#pragma unroll
        for (int j = 0; j < 8; ++j) ks[j] = kscale ? kscale[k0 + q * 8 + j] : 1.0f;
#pragma unroll
        for (int nb = 0; nb < NB; ++nb) { bf16x8 b;
#pragma unroll
            for (int j = 0; j < 8; ++j) b[j] = (short)f2bf(wp[nb][(size_t)(k0 + q * 8 + j) * ldw + r] * ks[j]);
            acc[nb] = __builtin_amdgcn_mfma_f32_16x16x32_bf16(a, b, acc[nb], 0, 0, 0); }
    }
}
__device__ __forceinline__ float quad16_sum(float v) { v += __shfl_xor(v, 1); v += __shfl_xor(v, 2); v += __shfl_xor(v, 4); v += __shfl_xor(v, 8); return v; }

__device__ __forceinline__ void naive_ffn_up(Ctx& c, const float* w_in, int rows) {
    PH_IDS(c);
    const int gw = c.wg * 8 + c.wave, ngw = c.nwg * 8, r = lane_ & 15, q = lane_ >> 4;
    const int nu = (rows / 16) * 176;
    for (int u = gw; u < nu; u += ngw) {
        const int rt = u / 176, cg = u % 176, row0 = rt * 16, c0 = cg * 16;
        const float* wp[2] = {w_in + c0, w_in + DFF + c0};
        f32x4 acc[2] = {{0.f, 0.f, 0.f, 0.f}, {0.f, 0.f, 0.f, 0.f}};
        naive_tile<2>(c.H, D, D, row0, wp, 2 * DFF, nullptr, acc, lane_);
#pragma unroll
        for (int i = 0; i < 4; ++i) { const float g = acc[0][i], up = acc[1][i]; c.ACT[(size_t)(row0 + q * 4 + i) * DFF + c0 + r] = f2bf(g * sigmoidf_(g) * up); }
    }
}
__device__ __forceinline__ void naive_res(Ctx& c, int l, const bf16_t* A, int lda, int K, const float* W, float coef, int gi, int rows, bool from_input) {
    PH_IDS(c);
    const int gw = c.wg * 8 + c.wave, ngw = c.nwg * 8, r = lane_ & 15, q = lane_ >> 4;
    const int nu = (rows / 16) * 16;
    for (int u = gw; u < nu; u += ngw) {
        const int rt = u / 16, cg = u % 16, row0 = rt * 16, c0 = cg * 64;
        const float* wp[4] = {W + c0, W + c0 + 16, W + c0 + 32, W + c0 + 48};
        f32x4 acc[4];
#pragma unroll
        for (int nb = 0; nb < 4; ++nb) acc[nb] = (f32x4){0.f, 0.f, 0.f, 0.f};
        naive_tile<4>(A, lda, K, row0, wp, D, nullptr, acc, lane_);
#pragma unroll
        for (int i = 0; i < 4; ++i) { const int row = row0 + q * 4 + i; const float* md = c.mod + ((size_t)l * 9 + row_mb(row)) * MODW + gi * D;
            const float* bi = xin_row(c, row, from_input); float* bo = xout_row(c, row);
#pragma unroll
            for (int nb = 0; nb < 4; ++nb) { const int cc = c0 + nb * 16 + r; bo[cc] = bi[cc] + coef * md[cc] * acc[nb][i]; } }
    }
}
__device__ __forceinline__ void naive_inproj(Ctx& c, int l, int rows) {
    PH_IDS(c);
    const Params* p = c.p;
    const int gw = c.wg * 8 + c.wave, ngw = c.nwg * 8, r = lane_ & 15, q = lane_ >> 4;
    const float* W = p->in[10] + (size_t)l * D * INC;
    const int nu = (rows / 16) * 36;
    for (int u = gw; u < nu; u += ngw) {
        const int rt = u / 36, g = u % 36, row0 = rt * 16;
        if (g == 19) continue;
        int src, dst, kind;
        if (g < 2) { src = O_AK + 64 * g; dst = P_KA + 64 * g; kind = 1; }
        else if (g < 4) { src = O_AV + 64 * (g - 2); dst = P_VA + 64 * (g - 2); kind = 0; }
        else if (g < 6) { src = O_BK + 64 * (g - 4); dst = P_KB + 64 * (g - 4); kind = 2; }
        else if (g < 8) { src = O_BV + 64 * (g - 6); dst = P_VB + 64 * (g - 6); kind = 0; }
        else if (g < 12) { src = O_CKV + 64 * (g - 8); dst = P_CKV + 64 * (g - 8); kind = 0; }
        else if (g < 18) { src = O_CQ + 64 * (g - 12); dst = P_CQ + 64 * (g - 12); kind = 0; }
        else if (g == 18) { src = O_CKR; dst = P_CKR; kind = 0; }
        else if (g < 28) { src = O_AQ + 64 * (g - 20); dst = P_QA + 64 * (g - 20); kind = 3; }
        else { src = O_BQ + 64 * (g - 28); dst = P_QB + 64 * (g - 28); kind = 4; }
        const float* wp[4] = {W + src, W + src + 16, W + src + (g == 18 ? 0 : 32), W + src + (g == 18 ? 0 : 48)};
        f32x4 acc[4];
#pragma unroll
        for (int nb = 0; nb < 4; ++nb) acc[nb] = (f32x4){0.f, 0.f, 0.f, 0.f};
        naive_tile<4>(c.H, D, D, row0, wp, INC, nullptr, acc, lane_);
        const float* gn = kind == 1 ? p->in[12] + l * 64 : kind == 2 ? p->in[15] + l * 64 : kind == 3 ? p->in[11] + l * 64 : p->in[14] + l * 64;
#pragma unroll
        for (int i = 0; i < 4; ++i) {
            const int row = row0 + q * 4 + i;
            bf16_t* o = c.P1 + (size_t)row * P1W + dst;
            if (kind == 0) {
#pragma unroll
                for (int nb = 0; nb < 4; ++nb) { if (g == 18 && nb >= 2) o[nb * 16 + r] = 0; else o[nb * 16 + r] = f2bf(acc[nb][i]); }
            } else {
                float ss = 0.f;
#pragma unroll
                for (int nb = 0; nb < 4; ++nb) ss += acc[nb][i] * acc[nb][i];
                ss = quad16_sum(ss);
                const float rstd = 1.0f / sqrtf(ss * (1.0f / 64.0f) + EPS);
                const float qs = kind >= 3 ? QSC64 : 1.0f;
#pragma unroll
                for (int nb = 0; nb < 4; ++nb) { const int d = nb * 16 + r; float v = acc[nb][i] * rstd * gn[d];
                    const float pr = __shfl_xor(v, 1);
                    if (row < NLAT) { const int s = row & 2047; const float cs = c.rope_hd[(s * 32 + (d >> 1)) * 2], sn = c.rope_hd[(s * 32 + (d >> 1)) * 2 + 1];
                        v = (d & 1) ? (pr * sn + v * cs) : (v * cs - pr * sn); }
                    o[d] = f2bf(v * qs); }
            }
        }
    }
}
__device__ __forceinline__ void naive_rowss(Ctx& c, int rows) {
    PH_IDS(c);
    const int gw = c.wg * 8 + c.wave, ngw = c.nwg * 8;
    for (int r = gw; r < rows; r += ngw) {
        const bf16_t* pr = c.P1 + (size_t)r * P1W;
        float s1 = 0.f, s2 = 0.f;
        for (int k = lane_; k < 256; k += 64) { const float v = bf2f(pr[P_CKV + k]); s1 += v * v; }
        for (int k = lane_; k < 384; k += 64) { const float v = bf2f(pr[P_CQ + k]); s2 += v * v; }
        s1 = wave_sum(s1); s2 = wave_sum(s2);
        if (lane_ < 12) c.rowss[(size_t)r * 12 + lane_] = lane_ == 0 ? s1 : (lane_ == 4 ? s2 : 0.f);
    }
}
__device__ __forceinline__ float rowss_kv(const Ctx& c, int row) { const f32x4 a = *(const f32x4*)(c.rowss + (size_t)row * 12); return 1.0f / sqrtf(((a.x + a.y) + (a.z + a.w)) * (1.0f / 256.0f) + EPS); }
__device__ __forceinline__ float rowss_q(const Ctx& c, int row) { const f32x4 a = *(const f32x4*)(c.rowss + (size_t)row * 12 + 4), b = *(const f32x4*)(c.rowss + (size_t)row * 12 + 8);
    return 1.0f / sqrtf((((a.x + a.y) + (a.z + a.w)) + ((b.x + b.y) + (b.z + b.w))) * (1.0f / 384.0f) + EPS); }
__device__ __forceinline__ void naive_mla_q(Ctx& c, int l, int rows) {
    PH_IDS(c);
    const Params* p = c.p;
    const int gw = c.wg * 8 + c.wave, ngw = c.nwg * 8, r = lane_ & 15, q = lane_ >> 4;
    const float* W = p->in[17] + (size_t)l * 384 * 768; const float* gl = p->in[16] + l * 384; const float* gn = p->in[20] + l * 96;
    const int nu = (rows / 16) * 8;
    for (int u = gw; u < nu; u += ngw) {
        const int rt = u / 8, h = u % 8, row0 = rt * 16;
        const float* wp[6];
#pragma unroll
        for (int nb = 0; nb < 6; ++nb) wp[nb] = W + 96 * h + 16 * nb;
        f32x4 acc[6];
#pragma unroll
        for (int nb = 0; nb < 6; ++nb) acc[nb] = (f32x4){0.f, 0.f, 0.f, 0.f};
        naive_tile<6>(c.P1 + P_CQ, P1W, 384, row0, wp, 768, gl, acc, lane_);
#pragma unroll
        for (int i = 0; i < 4; ++i) {
            const int row = row0 + q * 4 + i; const float rq = rowss_q(c, row);
            float ss = 0.f;
#pragma unroll
            for (int nb = 0; nb < 6; ++nb) { acc[nb][i] *= rq; ss += acc[nb][i] * acc[nb][i]; }
            ss = quad16_sum(ss);
            const float rstd = 1.0f / sqrtf(ss * (1.0f / 96.0f) + EPS);
            bf16_t* o = c.QC + (size_t)row * 768 + 96 * h;
#pragma unroll
            for (int nb = 0; nb < 6; ++nb) { const int d = nb * 16 + r; float v = acc[nb][i] * rstd * gn[d];
                const float pr = __shfl_xor(v, 1);
                if (nb >= 4 && row < NLAT) { const int s = row & 2047, pi = (d - 64) >> 1; const float cs = c.rope_c[(s * 16 + pi) * 2], sn = c.rope_c[(s * 16 + pi) * 2 + 1];
                    v = (d & 1) ? (pr * sn + v * cs) : (v * cs - pr * sn); }
                o[d] = f2bf(v * QSC96); }
        }
    }
}
__device__ __forceinline__ void naive_mla_kv(Ctx& c, int l, int rows) {
    PH_IDS(c);
    const Params* p = c.p;
    const int gw = c.wg * 8 + c.wave, ngw = c.nwg * 8, r = lane_ & 15, q = lane_ >> 4;
    const float* W = p->in[19] + (size_t)l * 256 * 1024; const float* gl = p->in[18] + l * 256; const float* gn = p->in[21] + l * 96;
    const int nu = (rows / 16) * 8;
    for (int u = gw; u < nu; u += ngw) {
        const int rt = u / 8, h = u % 8, row0 = rt * 16;
        const float* wp[8];
#pragma unroll
        for (int nb = 0; nb < 8; ++nb) wp[nb] = W + 128 * h + 16 * nb;
        f32x4 acc[8];
#pragma unroll
        for (int nb = 0; nb < 8; ++nb) acc[nb] = (f32x4){0.f, 0.f, 0.f, 0.f};
        naive_tile<8>(c.P1 + P_CKV, P1W, 256, row0, wp, 1024, gl, acc, lane_);
#pragma unroll
        for (int i = 0; i < 4; ++i) {
            const int row = row0 + q * 4 + i; const float rk = rowss_kv(c, row);
            const float kr0 = bf2f(c.P1[(size_t)row * P1W + P_CKR + r]), kr1 = bf2f(c.P1[(size_t)row * P1W + P_CKR + 16 + r]);
            float ss = kr0 * kr0 + kr1 * kr1;
#pragma unroll
            for (int nb = 0; nb < 4; ++nb) { acc[nb][i] *= rk; ss += acc[nb][i] * acc[nb][i]; }
            ss = quad16_sum(ss);
            const float rstd = 1.0f / sqrtf(ss * (1.0f / 96.0f) + EPS);
            bf16_t* o = c.KC + (size_t)row * 768 + 96 * h;
#pragma unroll
            for (int nb = 0; nb < 4; ++nb) { const int d = nb * 16 + r; o[d] = f2bf(acc[nb][i] * rstd * gn[d]); }
#pragma unroll
            for (int nb = 0; nb < 2; ++nb) { const int d = 64 + nb * 16 + r; float v = (nb == 0 ? kr0 : kr1) * rstd * gn[d];
                const float pr = __shfl_xor(v, 1);
                if (row < NLAT) { const int s = row & 2047, pi = (d - 64) >> 1; const float cs = c.rope_c[(s * 16 + pi) * 2], sn = c.rope_c[(s * 16 + pi) * 2 + 1];
                    v = (d & 1) ? (pr * sn + v * cs) : (v * cs - pr * sn); }
                o[d] = f2bf(v); }
            bf16_t* ov = c.KVR + (size_t)row * 1024 + 128 * h + 64;
#pragma unroll
            for (int nb = 0; nb < 4; ++nb) ov[nb * 16 + r] = f2bf(acc[4 + nb][i] * rk);
        }
    }
}
__device__ __forceinline__ void naive_gates(Ctx& c, int l, int rows) {
    PH_IDS(c);
    const int gw = c.wg * 8 + c.wave, ngw = c.nwg * 8, r = lane_ & 15, q = lane_ >> 4;
    const float* W = c.p->in[10] + (size_t)l * D * INC + O_G;
    const int nu = (rows / 16) * 48;
    for (int u = gw; u < nu; u += ngw) {
        const int rt = u / 48, cg = u % 48, row0 = rt * 16, c0 = cg * 64;
        const float* wp[4] = {W + c0, W + c0 + 16, W + c0 + 32, W + c0 + 48};
        f32x4 acc[4];
#pragma unroll
        for (int nb = 0; nb < 4; ++nb) acc[nb] = (f32x4){0.f, 0.f, 0.f, 0.f};
        naive_tile<4>(c.H, D, D, row0, wp, INC, nullptr, acc, lane_);
#pragma unroll
        for (int i = 0; i < 4; ++i)
#pragma unroll
            for (int nb = 0; nb < 4; ++nb) c.G[(size_t)(row0 + q * 4 + i) * 3072 + c0 + nb * 16 + r] = f2bf(sigmoidf_(acc[nb][i]));
    }
}
__device__ __forceinline__ void naive_merge(Ctx& c, int l, int rows) {
    PH_IDS(c);
    const Params* p = c.p;
    const int gw = c.wg * 8 + c.wave, ngw = c.nwg * 8, r = lane_ & 15, q = lane_ >> 4;
    const int nu = (rows / 16) * 16;
    for (int u = gw; u < nu; u += ngw) {
        const int rt = u / 16, cg = u % 16, row0 = rt * 16, c0 = cg * 64;
        float tot[4][4];
#pragma unroll
        for (int nb = 0; nb < 4; ++nb)
#pragma unroll
            for (int i = 0; i < 4; ++i) tot[nb][i] = 0.f;
#pragma unroll
        for (int br = 0; br < 3; ++br) {
            const float* W = p->in[22 + br] + (size_t)l * 512 * D;
            const float* wp[4] = {W + c0, W + c0 + 16, W + c0 + 32, W + c0 + 48};
            f32x4 acc[4];
#pragma unroll
            for (int nb = 0; nb < 4; ++nb) acc[nb] = (f32x4){0.f, 0.f, 0.f, 0.f};
            const bf16_t* A = br == 0 ? c.P1 + P_QA : (br == 1 ? c.P1 + P_QB : c.YC);
            naive_tile<4>(A, br == 2 ? 512 : P1W, 512, row0, wp, D, nullptr, acc, lane_);
#pragma unroll
            for (int i = 0; i < 4; ++i)
#pragma unroll
                for (int nb = 0; nb < 4; ++nb) tot[nb][i] += bf2f(c.G[(size_t)(row0 + q * 4 + i) * 3072 + br * 1024 + c0 + nb * 16 + r]) * acc[nb][i];
        }
#pragma unroll
        for (int i = 0; i < 4; ++i)
#pragma unroll
            for (int nb = 0; nb < 4; ++nb) c.H[(size_t)(row0 + q * 4 + i) * D + c0 + nb * 16 + r] = f2bf(tot[nb][i]);
    }
}

template <int DQK>
__device__ __forceinline__ void naive_attn_keys(const bf16_t* Kb, int kpitch, const bf16_t* Vb, int vpitch, int k_lo, int k_hi, int srow, int window, const float (&qv)[DQK], float& m, float& l, float (&o)[64]) {
    for (int j = k_lo; j < k_hi; ++j) {
        const bf16_t* kr = Kb + (size_t)j * kpitch;
        float s = 0.f;
#pragma unroll
        for (int d8 = 0; d8 < DQK / 8; ++d8) { const bf16x8 kk = *(const bf16x8*)(kr + d8 * 8);
#pragma unroll
            for (int e = 0; e < 8; ++e) s += qv[d8 * 8 + e] * bf2f((bf16_t)kk[e]); }
        const bool ok = window < 0 || (j - srow <= window && srow - j <= window);
        if (ok) {
            const float mn = fmaxf(m, s); const float f = exp2f(m - mn), pp = exp2f(s - mn);
            l = l * f + pp; m = mn;
            const bf16_t* vr = Vb + (size_t)j * vpitch;
#pragma unroll
            for (int d8 = 0; d8 < 8; ++d8) { const bf16x8 vv = *(const bf16x8*)(vr + d8 * 8);
#pragma unroll
                for (int e = 0; e < 8; ++e) o[d8 * 8 + e] = o[d8 * 8 + e] * f + pp * bf2f((bf16_t)vv[e]); }
        }
    }
}
__device__ __forceinline__ void naive_attn(Ctx& c, int l, int row_lo, int row_hi) {
    PH_IDS(c);
    const Params* p = c.p;
    const int gw = c.wg * 8 + c.wave, ngw = c.nwg * 8;
    const int nrw = (row_hi - row_lo) / 64;
    for (int u = gw; u < nrw * 24; u += ngw) {
        const int br = u / (nrw * 8), rem = u % (nrw * 8), h = rem / nrw, rw = rem % nrw;
        const int row = row_lo + rw * 64 + lane_;
        const bool lat = row < NLAT; const int b = lat ? (row >> 11) : ((row - NLAT) >> 8); const int s = row & 2047;
        const int crow0 = NLAT + b * CTXL, lrow0 = b * SEQ;
        float o[64];
#pragma unroll
        for (int d = 0; d < 64; ++d) o[d] = 0.f;
        float m = -1e30f, lsum = 0.f;
        if (br == 2) {
            float qv[96];
            const bf16_t* qp = c.QC + (size_t)row * 768 + 96 * h;
#pragma unroll
            for (int d8 = 0; d8 < 12; ++d8) { const bf16x8 t = *(const bf16x8*)(qp + d8 * 8);
#pragma unroll
                for (int e = 0; e < 8; ++e) qv[d8 * 8 + e] = bf2f((bf16_t)t[e]); }
            naive_attn_keys<96>(c.KC + (size_t)crow0 * 768 + 96 * h, 768, c.KVR + (size_t)crow0 * 1024 + 128 * h + 64, 1024, 0, CTXL, 0, -1, qv, m, lsum, o);
            if (lat) naive_attn_keys<96>(c.KC + (size_t)lrow0 * 768 + 96 * h, 768, c.KVR + (size_t)lrow0 * 1024 + 128 * h + 64, 1024, 0, SEQ, 0, -1, qv, m, lsum, o);
            const float inv = 1.0f / lsum; bf16_t* op = c.YC + (size_t)row * 512 + 64 * h;
#pragma unroll
            for (int d8 = 0; d8 < 8; ++d8) { u32x4 w; w.x = pk2(o[d8 * 8] * inv, o[d8 * 8 + 1] * inv); w.y = pk2(o[d8 * 8 + 2] * inv, o[d8 * 8 + 3] * inv); w.z = pk2(o[d8 * 8 + 4] * inv, o[d8 * 8 + 5] * inv); w.w = pk2(o[d8 * 8 + 6] * inv, o[d8 * 8 + 7] * inv); *(u32x4*)(op + d8 * 8) = w; }
        } else {
            float qv[64];
            const int qoff = br == 0 ? P_QA : P_QB, koff = (br == 0 ? P_KA : P_KB) + 64 * (h >> 2), voff = (br == 0 ? P_VA : P_VB) + 64 * (h >> 2);
            bf16_t* qp = c.P1 + (size_t)row * P1W + qoff + 64 * h;
#pragma unroll
            for (int d8 = 0; d8 < 8; ++d8) { const bf16x8 t = *(const bf16x8*)(qp + d8 * 8);
#pragma unroll
                for (int e = 0; e < 8; ++e) qv[d8 * 8 + e] = bf2f((bf16_t)t[e]); }
            if (br == 0) { m = p->in[13][l * 8 + h] * LOG2E; lsum = 1.0f; }
            naive_attn_keys<64>(c.P1 + (size_t)crow0 * P1W + koff, P1W, c.P1 + (size_t)crow0 * P1W + voff, P1W, 0, CTXL, 0, -1, qv, m, lsum, o);
            if (lat) {
                if (br == 0) { const int s0 = __builtin_amdgcn_readfirstlane(s) & ~63; const int klo = s0 - 128 < 0 ? 0 : s0 - 128, khi = s0 + 63 + 128 + 1 > SEQ ? SEQ : s0 + 63 + 128 + 1;
                    naive_attn_keys<64>(c.P1 + (size_t)lrow0 * P1W + koff, P1W, c.P1 + (size_t)lrow0 * P1W + voff, P1W, klo, khi, s, 128, qv, m, lsum, o); }
                else naive_attn_keys<64>(c.P1 + (size_t)lrow0 * P1W + koff, P1W, c.P1 + (size_t)lrow0 * P1W + voff, P1W, 0, SEQ, 0, -1, qv, m, lsum, o);
            }
            const float inv = 1.0f / lsum;
#pragma unroll
            for (int d8 = 0; d8 < 8; ++d8) { u32x4 w; w.x = pk2(o[d8 * 8] * inv, o[d8 * 8 + 1] * inv); w.y = pk2(o[d8 * 8 + 2] * inv, o[d8 * 8 + 3] * inv); w.z = pk2(o[d8 * 8 + 4] * inv, o[d8 * 8 + 5] * inv); w.w = pk2(o[d8 * 8 + 6] * inv, o[d8 * 8 + 7] * inv); *(u32x4*)(qp + d8 * 8) = w; }
        }
    }
}

constexpr size_t WO_F1IN = 0;
constexpr size_t WO_F1OUT = WO_F1IN + (size_t)5632 * 1024 * 2;
constexpr size_t WO_F2IN = WO_F1OUT + (size_t)1024 * 2816 * 2;
constexpr size_t WO_F2OUT = WO_F2IN + (size_t)5632 * 1024 * 2;
constexpr size_t WO_P1 = WO_F2OUT + (size_t)1024 * 2816 * 2;
constexpr size_t WO_G = WO_P1 + (size_t)2304 * 1024 * 2;
constexpr size_t WO_UQ = WO_G + (size_t)3072 * 1024 * 2;
constexpr size_t WO_UKV = WO_UQ + (size_t)768 * 384 * 2;
constexpr size_t WO_BR = WO_UKV + (size_t)1024 * 256 * 2;
constexpr size_t WO_OUT = WO_BR + (size_t)3 * 1024 * 512 * 2;
constexpr size_t WO_END = WO_OUT + (size_t)1024 * 1024 * 2;
static_assert(WO_END <= 52000000u, "weight region");
#define LAS __attribute__((address_space(3)))
#define GAS __attribute__((address_space(1)))

__device__ __forceinline__ void conv_item(const float* W, int ldw, int K, int srccol, const float* kgain, bf16_t* WT, int dstrow0, int k0, LAS float* scr, int lane) {
    if (srccol >= 0) {
        f32x4 t[8];
#pragma unroll
        for (int i = 0; i < 8; ++i) t[i] = *(const f32x4*)(W + (size_t)(k0 + 8 * i + (lane >> 3)) * ldw + srccol + (lane & 7) * 4);
#pragma unroll
        for (int i = 0; i < 8; ++i) { const int kk = 8 * i + (lane >> 3); f32x4 v = t[i]; if (kgain) v = v * kgain[k0 + kk];
            LAS float* d = scr + kk * 33 + (lane & 7) * 4; d[0] = v[0]; d[1] = v[1]; d[2] = v[2]; d[3] = v[3]; }
    } else {
#pragma unroll 8
        for (int i = 0; i < 32; ++i) { const int kk = 2 * i + (lane >> 5); scr[kk * 33 + (lane & 31)] = 0.f; }
    }
    asm volatile("s_waitcnt lgkmcnt(0)" ::: "memory");
    const int cidx = lane & 7;
#pragma unroll
    for (int j = 0; j < 4; ++j) { const int n = (lane >> 3) + 8 * j; const LAS float* sp = scr + (8 * cidx) * 33 + n;
        u32x4 o; o.x = pk2(sp[0 * 33], sp[1 * 33]); o.y = pk2(sp[2 * 33], sp[3 * 33]); o.z = pk2(sp[4 * 33], sp[5 * 33]); o.w = pk2(sp[6 * 33], sp[7 * 33]);
        *(u32x4*)(WT + (size_t)(dstrow0 + n) * K + k0 + 8 * cidx) = o; }
    asm volatile("s_waitcnt lgkmcnt(0)" ::: "memory");
}
__device__ __forceinline__ int p1_srccol(int nb) {
    const int t = nb >> 3, p32 = nb & 7;
    const int Lh = 64 * (p32 & 3) + 32 * (p32 >> 2), Lr = 32 * p32;
    switch (t) {
    case 0: return Lh < 128 ? O_AK + Lh : O_AV + (Lh - 128);
    case 1: return Lh < 128 ? O_BK + Lh : O_BV + (Lh - 128);
    case 2: return O_CKV + Lr;
    case 3: return O_CQ + Lr;
    case 4: return Lr < 128 ? O_CQ + 256 + Lr : (Lr == 128 ? O_CKR : -1);
    case 5: case 6: return O_AQ + 256 * (t - 5) + Lh;
    default: return O_BQ + 256 * (t - 7) + Lh;
    }
}
__device__ __forceinline__ void phase_convert_bias(Ctx& c, int l, unsigned char* lds) {
    PH_IDS(c);
    const Params* p = c.p;
    LAS float* scr = (LAS float*)((LAS unsigned char*)lds + c.wave * 16384);
    LAS float* shs = scr + 64 * 33 + 16;
    unsigned char* wb = c.ws + WS_W;
    const int gw = c.wg * 8 + c.wave, ngw = c.nwg * 8;
    constexpr int NA = 2 * (176 + 176 + 72 + 96);
    constexpr int NITB[8] = {44 * 32, 44 * 32, 6 * 24, 4 * 32, 8 * 32, 8 * 32, 8 * 32, 16 * 32};
    int totalB = 0;
#pragma unroll
    for (int i = 0; i < 8; ++i) totalB += NITB[i];
    const float* modl = c.mod + (size_t)l * 9 * MODW;
    for (int it = gw; it < NA + totalB; it += ngw) {
        if (it < NA) {
            const int kh = it & 1; int r = it >> 1; int mi, nb, sidx, goff, ldw, sc; const float* W; bf16_t* WT;
            if (r < 176) { mi = 0; nb = r; } else if (r < 352) { mi = 2; nb = r - 176; } else if (r < 424) { mi = 4; nb = r - 352; } else { mi = 5; nb = r - 424; }
            if (mi == 0) { W = p->in[7] + (size_t)l * D * 2 * DFF; ldw = 2 * DFF; WT = (bf16_t*)(wb + WO_F1IN); sidx = 0; goff = BO_F1; }
            else if (mi == 2) { W = p->in[27] + (size_t)l * D * 2 * DFF; ldw = 2 * DFF; WT = (bf16_t*)(wb + WO_F2IN); sidx = 6; goff = BO_F2; }
            else if (mi == 4) { W = p->in[10] + (size_t)l * D * INC; ldw = INC; WT = (bf16_t*)(wb + WO_P1); sidx = 3; goff = BO_P1; }
            else { W = p->in[10] + (size_t)l * D * INC; ldw = INC; WT = (bf16_t*)(wb + WO_G); sidx = 3; goff = BO_G; }
            if (mi == 0 || mi == 2) { const int j = nb >> 3, w = nb & 7; sc = w < 4 ? 128 * j + 32 * w : DFF + 128 * j + 32 * (w - 4); }
            else if (mi == 4) sc = p1_srccol(nb);
            else sc = O_G + 32 * nb;
            const int n = lane_ & 31, half = lane_ >> 5;
            float acc[5] = {0.f, 0.f, 0.f, 0.f, 0.f};
            f32x4 tn[8]; float shn[9];
            auto slab_load = [&](int kb) { const int k0 = 64 * kb;
#pragma unroll
                for (int i = 0; i < 8; ++i) tn[i] = sc >= 0 ? *(const f32x4*)(W + (size_t)(k0 + 8 * i + (lane_ >> 3)) * ldw + sc + (lane_ & 7) * 4) : (f32x4){0.f, 0.f, 0.f, 0.f};
                const float* sh = modl + sidx * D + k0 + lane_;
#pragma unroll
                for (int mb = 0; mb < 9; ++mb) shn[mb] = sh[(size_t)mb * MODW]; };
            slab_load(kh * 8);
            for (int kb = kh * 8; kb < kh * 8 + 8; ++kb) {
                const int k0 = 64 * kb;
#pragma unroll
                for (int i = 0; i < 8; ++i) { LAS float* d = scr + (8 * i + (lane_ >> 3)) * 33 + (lane_ & 7) * 4; d[0] = tn[i][0]; d[1] = tn[i][1]; d[2] = tn[i][2]; d[3] = tn[i][3]; }
#pragma unroll
                for (int mb = 0; mb < 9; ++mb) shs[lane_ * 16 + (mb < 5 ? mb : mb + 3)] = shn[mb];
                shs[lane_ * 16 + 12] = 0.f;
                if (kb + 1 < kh * 8 + 8) slab_load(kb + 1);
                asm volatile("s_waitcnt lgkmcnt(0)" ::: "memory");
#pragma unroll 8
                for (int kk = 0; kk < 64; ++kk) { const float w = scr[kk * 33 + n]; const f32x4 s4 = *(const LAS f32x4*)(shs + kk * 16 + 8 * half); const float s5 = shs[kk * 16 + 8 * half + 4];
                    acc[0] += s4[0] * w; acc[1] += s4[1] * w; acc[2] += s4[2] * w; acc[3] += s4[3] * w; acc[4] += s5 * w; }
                const int cidx = lane_ & 7;
#pragma unroll
                for (int j = 0; j < 4; ++j) { const int nn = (lane_ >> 3) + 8 * j; const LAS float* sp = scr + (8 * cidx) * 33 + nn;
                    u32x4 o; o.x = pk2(sp[0 * 33], sp[1 * 33]); o.y = pk2(sp[2 * 33], sp[3 * 33]); o.z = pk2(sp[4 * 33], sp[5 * 33]); o.w = pk2(sp[6 * 33], sp[7 * 33]);
                    *(u32x4*)(WT + (size_t)(32 * nb + nn) * D + k0 + 8 * cidx) = o; }
                asm volatile("s_waitcnt lgkmcnt(0)" ::: "memory");
            }
            float* bp = c.bias + ((size_t)kh * 9 + 5 * half) * NBIAS + goff + 32 * nb + n;
#pragma unroll
            for (int j = 0; j < 5; ++j) if (half == 0 || j < 4) bp[(size_t)j * NBIAS] = acc[j];
        } else {
            int r = it - NA, mi = 0;
#pragma unroll
            for (int i = 0; i < 7; ++i) if (mi == i && r >= NITB[i]) { r -= NITB[i]; mi = i + 1; }
            const float* W; int ldw, K, nblk; bf16_t* WT; const float* kg = nullptr;
            switch (mi) {
            case 0: W = p->in[8] + (size_t)l * DFF * D; ldw = D; K = DFF; nblk = 32; WT = (bf16_t*)(wb + WO_F1OUT); break;
            case 1: W = p->in[28] + (size_t)l * DFF * D; ldw = D; K = DFF; nblk = 32; WT = (bf16_t*)(wb + WO_F2OUT); break;
            case 2: W = p->in[17] + (size_t)l * 384 * 768; ldw = 768; K = 384; nblk = 24; WT = (bf16_t*)(wb + WO_UQ); kg = p->in[16] + l * 384; break;
            case 3: W = p->in[19] + (size_t)l * 256 * 1024; ldw = 1024; K = 256; nblk = 32; WT = (bf16_t*)(wb + WO_UKV); kg = p->in[18] + l * 256; break;
            case 4: case 5: case 6: W = p->in[22 + (mi - 4)] + (size_t)l * 512 * D; ldw = D; K = 512; nblk = 32; WT = (bf16_t*)(wb + WO_BR) + (size_t)((mi - 4 + 1) % 3) * 1024 * 512; break;
            default: W = p->in[25] + (size_t)l * D * D; ldw = D; K = D; nblk = 32; WT = (bf16_t*)(wb + WO_OUT); break;
            }
            const int kb = r / nblk, nb = r % nblk;
            int sc = 32 * nb;
            if (mi == 3) { const int t = nb >> 3, p32 = nb & 7, bj = p32 >> 2, wc = p32 & 3; sc = 128 * (2 * t + (wc & 1)) + 64 * (wc >> 1) + 32 * bj; }
            conv_item(W, ldw, K, sc, kg, WT, 32 * nb, 64 * kb, scr, lane_);
        }
    }
}
__device__ __forceinline__ void phase_convert(Ctx& c, int l, unsigned char* lds) {
    PH_IDS(c);
    const Params* p = c.p;
    LAS float* scr = (LAS float*)((LAS unsigned char*)lds + c.wave * 16384);
    unsigned char* wb = c.ws + WS_W;
    const int gw = c.wg * 8 + c.wave, ngw = c.nwg * 8;
    constexpr int NIT[12] = {16 * 176, 44 * 32, 16 * 176, 44 * 32, 16 * 72, 16 * 96, 6 * 24, 4 * 32, 8 * 32, 8 * 32, 8 * 32, 16 * 32};
    int total = 0;
#pragma unroll
    for (int i = 0; i < 12; ++i) total += NIT[i];
    for (int it = gw; it < total; it += ngw) {
        int r = it, mi = 0;
#pragma unroll
        for (int i = 0; i < 11; ++i) if (mi == i && r >= NIT[i]) { r -= NIT[i]; mi = i + 1; }
        const float* W; int ldw, K, nblk; bf16_t* WT; const float* kg = nullptr;
        switch (mi) {
        case 0: W = p->in[7] + (size_t)l * D * 2 * DFF; ldw = 2 * DFF; K = D; nblk = 176; WT = (bf16_t*)(wb + WO_F1IN); break;
        case 1: W = p->in[8] + (size_t)l * DFF * D; ldw = D; K = DFF; nblk = 32; WT = (bf16_t*)(wb + WO_F1OUT); break;
        case 2: W = p->in[27] + (size_t)l * D * 2 * DFF; ldw = 2 * DFF; K = D; nblk = 176; WT = (bf16_t*)(wb + WO_F2IN); break;
        case 3: W = p->in[28] + (size_t)l * DFF * D; ldw = D; K = DFF; nblk = 32; WT = (bf16_t*)(wb + WO_F2OUT); break;
        case 4: W = p->in[10] + (size_t)l * D * INC; ldw = INC; K = D; nblk = 72; WT = (bf16_t*)(wb + WO_P1); break;
        case 5: W = p->in[10] + (size_t)l * D * INC; ldw = INC; K = D; nblk = 96; WT = (bf16_t*)(wb + WO_G); break;
        case 6: W = p->in[17] + (size_t)l * 384 * 768; ldw = 768; K = 384; nblk = 24; WT = (bf16_t*)(wb + WO_UQ); kg = p->in[16] + l * 384; break;
        case 7: W = p->in[19] + (size_t)l * 256 * 1024; ldw = 1024; K = 256; nblk = 32; WT = (bf16_t*)(wb + WO_UKV); kg = p->in[18] + l * 256; break;
        case 8: case 9: case 10: W = p->in[22 + (mi - 8)] + (size_t)l * 512 * D; ldw = D; K = 512; nblk = 32; WT = (bf16_t*)(wb + WO_BR) + (size_t)(mi - 8) * 1024 * 512; break;
        default: W = p->in[25] + (size_t)l * D * D; ldw = D; K = D; nblk = 32; WT = (bf16_t*)(wb + WO_OUT); break;
        }
        const int kb = r / nblk, nb = r % nblk;
        int sc;
        if (mi == 0 || mi == 2) { const int j = nb >> 3, w = nb & 7; sc = w < 4 ? 128 * j + 32 * w : DFF + 128 * j + 32 * (w - 4); }
        else if (mi == 4) sc = p1_srccol(nb);
        else if (mi == 5) sc = O_G + 32 * nb;
        else if (mi == 7) { const int t = nb >> 3, p32 = nb & 7, bj = p32 >> 2, wc = p32 & 3; sc = 128 * (2 * t + (wc & 1)) + 64 * (wc >> 1) + 32 * bj; }
        else sc = 32 * nb;
        conv_item(W, ldw, K, sc, kg, WT, 32 * nb, 64 * kb, scr, lane_);
    }
}

namespace pg8 {
constexpr int BM = 256, BK = 64, HALF = 128, HTB = HALF * BK * 2, STAGE_BYTES = 8 * HTB, NXCD = 8, WGM = 8;
__host__ __device__ __forceinline__ int lds_byte(int r, int c) { const int st = (r >> 4) * 2 + (c >> 5), rr = r & 15, cc = c & 31, ob = rr * 64 + cc * 2; return st * 1024 + (ob ^ (((ob >> 9) & 1) << 5)); }
__host__ __device__ __forceinline__ void stage_rc(int b, int& R, int& C) { const int st = b / 1024, sb = b % 1024, swz = sb ^ (((sb >> 9) & 1) << 5); R = (st >> 1) * 16 + swz / 64; C = (st & 1) * 32 + (swz % 64) / 2; }
__host__ __device__ __forceinline__ int perm32(int rho) { const int n = rho >> 4, i = rho & 15; return 8 * (i >> 2) + 4 * n + (i & 3); }
struct Unit { int pm, pn, z; };
struct Gemm { const bf16_t* A; const bf16_t* Bt; int M, N, K, lda; int zA = 0, zB = 0; int rap = 0; };
__device__ __forceinline__ const char* gemm_a(const Gemm& g, int z) { return (const char*)(g.A + (size_t)z * g.zA); }
__device__ __forceinline__ const char* gemm_b(const Gemm& g, int z) { return (const char*)(g.Bt + (size_t)z * g.zB); }
struct StaticOrder {
    int nM, nN, nwg, G, c, pm0, R0, G1, nlp, cx0;
    __device__ void init(int M, int N, int G_, int c_) { nM = M / BM; nN = N / BM; nwg = nM * nN; G = G_; c = c_; pm0 = 0; R0 = 1 << 20; G1 = G_; nlp = 1 << 20; cx0 = 0; }
    __device__ void init_sub(int pm0_, int npm, int N, int G_, int c_, int R0_, int G1_) { nM = npm; nN = N / BM; nwg = nM * nN; G = G_; c = c_; pm0 = pm0_; R0 = R0_; G1 = G1_; nlp = 1 << 20; cx0 = 0; }
    __device__ void init_grp(int lat0, int nlat, int ctx0, int nctx, bool all, int N, int G_, int c_) { nM = nlat + (all ? nctx : 0); nN = N / BM; nwg = nM * nN; G = G_; c = c_; pm0 = lat0; R0 = 1 << 20; G1 = G_; nlp = nlat; cx0 = ctx0; }
    __device__ bool next(int i, Unit& u) const {
        if (c < 0) return false;
        long L; if (i < R0) L = (long)i * G + c; else { if (c >= G1) return false; L = (long)R0 * G + (long)(i - R0) * G1 + c; }
        if (L >= nwg) return false;
        int wgid = (int)L; { const int q = nwg / NXCD, r = nwg % NXCD, xcd = wgid % NXCD, off = wgid / NXCD; wgid = (xcd < r ? xcd * (q + 1) : r * (q + 1) + (xcd - r) * q) + off; }
        const int nig = WGM * nN, gid = wgid / nig, fm = gid * WGM, gsz = (nM - fm) < WGM ? (nM - fm) : WGM;
        { const int j = fm + ((wgid % nig) % gsz); u.pm = j < nlp ? pm0 + j : cx0 + (j - nlp); } u.pn = (wgid % nig) / gsz; u.z = 0; return true;
    }
};
struct TripleOrder {
    StaticOrder b;
    __device__ bool next(int i, Unit& u) const { if (!b.next(i / 3, u)) return false; u.z = i % 3; return true; }
};
typedef float f32x2_t __attribute__((ext_vector_type(2))); typedef __bf16 bf16x2_t __attribute__((ext_vector_type(2)));
__device__ __forceinline__ unsigned cvt_pk_bf16(float lo, float hi) { f32x2_t v = {lo, hi}; bf16x2_t b = __builtin_convertvector(v, bf16x2_t); return __builtin_bit_cast(unsigned, b); }
__device__ __forceinline__ u32x4 pack8(const f32x4& a, const f32x4& b) { u32x4 w; w.x = cvt_pk_bf16(a[0], a[1]); w.y = cvt_pk_bf16(a[2], a[3]); w.z = cvt_pk_bf16(b[0], b[1]); w.w = cvt_pk_bf16(b[2], b[3]); return w; }
__device__ __forceinline__ float fast_sigmoid(float v) { return __builtin_amdgcn_rcpf(1.0f + __builtin_amdgcn_exp2f(-LOG2E * v)); }

typedef f32x4 Acc[2][2][4][2];
struct RowScale { const float* ss; const float* bias; };
constexpr int PRE_OFF = 131072 + 2048, PRE_TAB = 2048;
struct PreRegs { f32x4 a, b; float b0, b1; };
__device__ __forceinline__ void pre_issue(const RowScale& rs, const Unit& u, int wid, int lane, PreRegs& r) {
    const int row = u.pm * BM + wid * 32 + (lane & 31), mb = u.pm < NLAT / BM ? (u.pm >> 3) : 8;
    const float* sp = rs.ss + (size_t)row * 16 + 8 * (lane >> 5); r.a = *(const f32x4*)sp; r.b = *(const f32x4*)(sp + 4);
    const float* bp = rs.bias + (size_t)mb * NBIAS + u.pn * BM + wid * 32 + (lane & 31); r.b0 = bp[0]; r.b1 = bp[(size_t)9 * NBIAS];
}
__device__ __forceinline__ void pre_finish(const PreRegs& r, LAS float* tab, int wid, int lane) {
    float v = ((r.a.x + r.a.y) + (r.a.z + r.a.w)) + ((r.b.x + r.b.y) + (r.b.z + r.b.w)); v += __shfl_xor(v, 32);
    if (lane < 32) { tab[wid * 32 + lane] = __builtin_amdgcn_rsqf(v * (1.0f / 1024.0f) + EPS); tab[256 + wid * 32 + lane] = r.b0 + r.b1; }
}
struct Pre { float rr[2][4]; f32x4 bv[2][2]; };
__device__ __forceinline__ void pre_read(const LAS float* tab, int wr, int wc, int fr, int fq, Pre& p) {
#pragma unroll
    for (int ai = 0; ai < 2; ++ai)
#pragma unroll
        for (int m = 0; m < 4; ++m) p.rr[ai][m] = tab[ai * HALF + wr * 64 + m * 16 + fr];
#pragma unroll
    for (int bj = 0; bj < 2; ++bj)
#pragma unroll
        for (int n = 0; n < 2; ++n) p.bv[bj][n] = *(const LAS f32x4*)(tab + 256 + bj * HALF + wc * 32 + 8 * fq + 4 * n);
}
template <class E, class = void> struct epi_has_pre { static constexpr bool value = false; };
template <class E> struct epi_has_pre<E, decltype((void)E::HAS_PRE)> { static constexpr bool value = true; };

template <class Epi, class Sched, bool ALIGN_EPI>
__device__ __forceinline__ void gemm_phase(LAS unsigned char* lds, int wave, const Gemm g, const Sched& S, const Epi& E) {
    const int lane = lane_id(), wid = wave, tid = wid * 64 + lane, wr = wid >> 2, wc = wid & 3, fr = lane & 15, fq = lane >> 4;
    const int K = g.K, nt = K / BK, lda = g.lda;
    unsigned voffA[2], voffB[2];
#pragma unroll
    for (int i = 0; i < 2; ++i) { int R, C; stage_rc(tid * 16 + i * 8192, R, C); const int Rb = Epi::PERM ? ((R & ~31) + perm32(R & 31)) : R;
        voffA[i] = (unsigned)(R * lda + C) * 2u; voffB[i] = (unsigned)(Rb * K + C) * 2u; }
    const size_t kstep = (size_t)(BK * 2);
    const size_t hstepA = (size_t)HALF * lda * 2, hstepB = (size_t)HALF * K * 2;
    const size_t tstepA = 2 * hstepA, tstepB = 2 * hstepB;
    const unsigned ldsw = (unsigned)wid * 1024u;
    const int aoff = lds_byte(wr * 64 + fr, fq * 8), boff = lds_byte(wc * 32 + fr, fq * 8);
#define PG8_SA(b, h) (((b) * 2 + (h)) * HTB)
#define PG8_SB(b, h) ((4 + (b) * 2 + (h)) * HTB)
#define PG8_STAGE(bufoff, gbase, voff) do { _Pragma("unroll") for (int _i = 0; _i < 2; ++_i) \
        __builtin_amdgcn_global_load_lds((const unsigned*)((const char*)(gbase) + (voff)[_i]), (LAS unsigned*)(lds + (bufoff) + ldsw + _i * 8192), 16, 0, 0); } while (0)
#define PG8_LDA(dst, b, h) do { _Pragma("unroll") for (int m = 0; m < 4; ++m) _Pragma("unroll") for (int k = 0; k < 2; ++k) dst[m][k] = *(const LAS bf16x8*)(lds + PG8_SA(b, h) + aoff + m * 2048 + k * 1024); } while (0)
#define PG8_LDB(dst, b, h) do { _Pragma("unroll") for (int n = 0; n < 2; ++n) _Pragma("unroll") for (int k = 0; k < 2; ++k) dst[n][k] = *(const LAS bf16x8*)(lds + PG8_SB(b, h) + boff + n * 2048 + k * 1024); } while (0)
#define PG8_MMA(ai, bj, At, Bt) do { __builtin_amdgcn_s_setprio(1); _Pragma("unroll") for (int m = 0; m < 4; ++m) _Pragma("unroll") for (int n = 0; n < 2; ++n) _Pragma("unroll") for (int k = 0; k < 2; ++k) \
        acc[ai][bj][m][n] = __builtin_amdgcn_mfma_f32_16x16x32_bf16(Bt[n][k], At[m][k], acc[ai][bj][m][n], 0, 0, 0); __builtin_amdgcn_s_setprio(0); } while (0)
#define PG8_WAIT_V(n) asm volatile("s_waitcnt vmcnt(" #n ")" ::: "memory")
#define PG8_WAIT_L(n) asm volatile("s_waitcnt lgkmcnt(" #n ")" ::: "memory")
#define PG8_BAR __builtin_amdgcn_s_barrier()
#define PG8_SCHED __builtin_amdgcn_sched_barrier(0)
    Unit cur, nxt; int ui = 0;
    if (!S.next(0, cur)) return;
    Acc acc;
#pragma unroll
    for (int a = 0; a < 2; ++a)
#pragma unroll
        for (int b = 0; b < 2; ++b)
#pragma unroll
            for (int m = 0; m < 4; ++m)
#pragma unroll
                for (int n = 0; n < 2; ++n) acc[a][b][m][n] = (f32x4){0.f, 0.f, 0.f, 0.f};
    bf16x8 At[4][2], B0[2][2], B1[2][2];
    if constexpr (epi_has_pre<Epi>::value) { PreRegs r0; pre_issue(E.rs, cur, wid, lane, r0); pre_finish(r0, (LAS float*)(lds + PRE_OFF), wid, lane); }
    const char* cA = gemm_a(g, cur.z) + (g.rap ? ra_panel_off(cur.pm, g.rap) : (size_t)cur.pm * tstepA); const char* cB = gemm_b(g, cur.z) + (size_t)cur.pn * tstepB;
    PG8_STAGE(PG8_SB(0, 0), cB, voffB); PG8_STAGE(PG8_SB(0, 1), cB + hstepB, voffB); PG8_STAGE(PG8_SA(0, 0), cA, voffA); PG8_STAGE(PG8_SA(0, 1), cA + hstepA, voffA);
    if (wr == 1) PG8_BAR;
    PG8_WAIT_V(2); PG8_BAR;
    PG8_STAGE(PG8_SB(1, 0), cB + kstep, voffB); PG8_STAGE(PG8_SA(1, 0), cA + kstep, voffA); PG8_STAGE(PG8_SB(1, 1), cB + hstepB + kstep, voffB);
    PG8_WAIT_V(6); PG8_BAR;
    for (;;) {
        const bool has_next = S.next(ui + 1, nxt);
        const char* nA = has_next ? gemm_a(g, nxt.z) + (g.rap ? ra_panel_off(nxt.pm, g.rap) : (size_t)nxt.pm * tstepA) : cA; const char* nB = has_next ? gemm_b(g, nxt.z) + (size_t)nxt.pn * tstepB : cB;
#pragma unroll 1
        for (int t = 0; t < nt; t += 2) {
            const bool last = (t == nt - 2);
            const char* a1 = cA + (size_t)(t + 1) * kstep;
            const char* a2 = last ? nA : cA + (size_t)(t + 2) * kstep; const char* b2 = last ? nB : cB + (size_t)(t + 2) * kstep;
            const char* a3 = a2 + kstep; const char* b3 = b2 + kstep;
            PG8_LDB(B0, 0, 0); PG8_LDB(B1, 0, 1); PG8_SCHED; PG8_LDA(At, 0, 0); PG8_STAGE(PG8_SA(1, 1), a1 + hstepA, voffA);
            PG8_WAIT_V(8); PG8_WAIT_L(0); PG8_BAR; PG8_MMA(0, 0, At, B0); PG8_MMA(0, 1, At, B1); PG8_BAR; PG8_SCHED;
            PG8_LDA(At, 0, 1); PG8_STAGE(PG8_SB(0, 0), b2, voffB); PG8_STAGE(PG8_SB(0, 1), b2 + hstepB, voffB); PG8_STAGE(PG8_SA(0, 0), a2, voffA);
            PG8_WAIT_V(8); PG8_WAIT_L(0); PG8_BAR; PG8_MMA(1, 0, At, B0); PG8_MMA(1, 1, At, B1); PG8_BAR; PG8_SCHED;
            PG8_LDB(B0, 1, 0); PG8_LDB(B1, 1, 1); PG8_SCHED; PG8_LDA(At, 1, 0); PG8_STAGE(PG8_SA(0, 1), a2 + hstepA, voffA);
            PG8_WAIT_V(8); PG8_WAIT_L(0); PG8_BAR; PG8_MMA(0, 0, At, B0); PG8_MMA(0, 1, At, B1); PG8_BAR; PG8_SCHED;
            PG8_LDA(At, 1, 1); PG8_STAGE(PG8_SB(1, 0), b3, voffB); PG8_STAGE(PG8_SB(1, 1), b3 + hstepB, voffB); PG8_STAGE(PG8_SA(1, 0), a3, voffA);
            PG8_WAIT_V(8); PG8_WAIT_L(0); PG8_BAR; PG8_MMA(1, 0, At, B0); PG8_MMA(1, 1, At, B1); PG8_BAR; PG8_SCHED;
        }
        if constexpr (ALIGN_EPI) { if (wr == 0) PG8_BAR; }
        { int fr_ = fr, fq_ = fq; asm volatile("" : "+v"(fr_), "+v"(fq_));
          if constexpr (epi_has_pre<Epi>::value) { PreRegs rn; if (has_next) pre_issue(E.rs, nxt, wid, lane, rn);
              Pre pre; pre_read((const LAS float*)(lds + PRE_OFF + (ui & 1) * PRE_TAB), wr, wc, fr_, fq_, pre);
#if defined(FA_FAKE) && FA_FAKE == 4
              if (wid == 0 && fr_ == 0) E(acc, cur, wr, wc, fr_, fq_, pre);
#else
              E(acc, cur, wr, wc, fr_, fq_, pre);
#endif
              if (has_next) pre_finish(rn, (LAS float*)(lds + PRE_OFF + ((ui + 1) & 1) * PRE_TAB), wid, lane); }
          else E(acc, cur, wr, wc, fr_, fq_); }
        if (!has_next) break;
#pragma unroll
        for (int a = 0; a < 2; ++a)
#pragma unroll
            for (int b = 0; b < 2; ++b)
#pragma unroll
                for (int m = 0; m < 4; ++m)
#pragma unroll
                    for (int n = 0; n < 2; ++n) acc[a][b][m][n] = (f32x4){0.f, 0.f, 0.f, 0.f};
        cur = nxt; cA = nA; cB = nB; ++ui;
        if constexpr (ALIGN_EPI) { if (wr == 1) PG8_BAR; }
    }
    PG8_WAIT_V(0);
    if constexpr (!ALIGN_EPI) { if (wr == 0) PG8_BAR; }
    PG8_BAR;
#undef PG8_SA
#undef PG8_SB
#undef PG8_STAGE
#undef PG8_LDA
#undef PG8_LDB
#undef PG8_MMA
#undef PG8_WAIT_V
#undef PG8_WAIT_L
#undef PG8_BAR
#undef PG8_SCHED
}

struct EpiSwiGLU {
    static constexpr bool PERM = true;
    bf16_t* ACT;
    __device__ __forceinline__ void operator()(const Acc& acc, const Unit& u, int wr, int wc, int fr, int fq) const {
        const int row0 = u.pm * BM + wr * 64 + fr, col0 = u.pn * 128 + wc * 32 + 8 * fq;
#pragma unroll
        for (int ai = 0; ai < 2; ++ai)
#pragma unroll
            for (int m = 0; m < 4; ++m) {
                f32x4 o[2];
#pragma unroll
                for (int n = 0; n < 2; ++n) { const f32x4 gt = acc[ai][0][m][n], up = acc[ai][1][m][n];
#pragma unroll
                    for (int e = 0; e < 4; ++e) o[n][e] = gt[e] * fast_sigmoid(gt[e]) * up[e]; }
                *(u32x4*)(ACT + (size_t)(row0 + ai * HALF + m * 16) * DFF + col0) = pack8(o[0], o[1]);
            }
    }
};
struct EpiRes {
    static constexpr bool PERM = false;
    const float* base_lat; const float* base_ctx; float* out_lat; float* out_ctx; const float* modl; int gi; float coef;
    __device__ __forceinline__ void operator()(const Acc& acc, const Unit& u, int wr, int wc, int fr, int fq) const {
        const bool lat = u.pm < NLAT / BM; const int pmr = lat ? u.pm : u.pm - NLAT / BM;
        const float* bp = (lat ? base_lat : base_ctx) + (size_t)pmr * BM * D; float* op = (lat ? out_lat : out_ctx) + (size_t)pmr * BM * D;
        const float* md = modl + (size_t)(lat ? (u.pm >> 3) : 8) * MODW + gi * D;
        const int col0 = u.pn * BM + wc * 32 + 4 * fq;
        f32x4 mv[2][2];
#pragma unroll
        for (int bj = 0; bj < 2; ++bj)
#pragma unroll
            for (int n = 0; n < 2; ++n) mv[bj][n] = *(const f32x4*)(md + col0 + bj * HALF + n * 16) * coef;
#pragma unroll
        for (int ai = 0; ai < 2; ++ai)
#pragma unroll
            for (int m = 0; m < 4; ++m) { const size_t off = (size_t)(ai * HALF + wr * 64 + m * 16 + fr) * D + col0;
#pragma unroll
                for (int bj = 0; bj < 2; ++bj)
#pragma unroll
                    for (int n = 0; n < 2; ++n) { const f32x4 bs = *(const f32x4*)(bp + off + bj * HALF + n * 16); *(f32x4*)(op + off + bj * HALF + n * 16) = bs + mv[bj][n] * acc[ai][bj][m][n]; }
                if (m & 1) asm volatile("" ::: "memory"); }
    }
};
struct EpiInProj {
    static constexpr bool PERM = true;
    bf16_t* P1; float* rowss; const float* rope; const float* gqa; const float* gka; const float* gqb; const float* gkb;
    __device__ __forceinline__ void operator()(const Acc& acc, const Unit& u, int wr, int wc, int fr, int fq) const {
        const int pn = u.pn; const bool lat = u.pm < NLAT / BM;
        const int row0 = u.pm * BM + wr * 64 + fr;
        if (pn >= 2 && pn <= 4) {
            const int dstc = (pn == 2 ? P_CKV : (pn == 3 ? P_CQ : P_CQ + 256)) + wc * 32 + 8 * fq;
#pragma unroll
            for (int ai = 0; ai < 2; ++ai)
#pragma unroll
                for (int m = 0; m < 4; ++m) { const int row = row0 + ai * HALF + m * 16; float ss = 0.f;
#pragma unroll
                    for (int bj = 0; bj < 2; ++bj) { const f32x4 v0 = acc[ai][bj][m][0], v1 = acc[ai][bj][m][1];
                        *(u32x4*)(P1 + (size_t)row * P1W + dstc + bj * HALF) = pack8(v0, v1);
                        if (bj == 0 || pn != 4) ss += ((v0[0] * v0[0] + v0[1] * v0[1]) + (v0[2] * v0[2] + v0[3] * v0[3])) + ((v1[0] * v1[0] + v1[1] * v1[1]) + (v1[2] * v1[2] + v1[3] * v1[3])); }
                    ss += __shfl_xor(ss, 16); ss += __shfl_xor(ss, 32);
                    if (fq == 0) rowss[(size_t)row * 12 + (pn - 2) * 4 + wc] = ss; }
            return;
        }
        int dst; const float* gn = nullptr; float qs = 1.0f;
        if (pn == 0) { if (wc < 2) { dst = P_KA + 64 * wc; gn = gka; } else dst = P_VA + 64 * (wc - 2); }
        else if (pn == 1) { if (wc < 2) { dst = P_KB + 64 * wc; gn = gkb; } else dst = P_VB + 64 * (wc - 2); }
        else if (pn <= 6) { dst = P_QA + 64 * (4 * (pn - 5) + wc); gn = gqa; qs = QSC64; }
        else { dst = P_QB + 64 * (4 * (pn - 7) + wc); gn = gqb; qs = QSC64; }
        dst += 8 * fq;
        if (gn == nullptr) {
#pragma unroll
            for (int ai = 0; ai < 2; ++ai)
#pragma unroll
                for (int m = 0; m < 4; ++m) { const int row = row0 + ai * HALF + m * 16;
#pragma unroll
                    for (int bj = 0; bj < 2; ++bj) *(u32x4*)(P1 + (size_t)row * P1W + dst + 32 * bj) = pack8(acc[ai][bj][m][0], acc[ai][bj][m][1]); }
            return;
        }
        f32x4 gv[2][2];
#pragma unroll
        for (int bj = 0; bj < 2; ++bj)
#pragma unroll
            for (int n = 0; n < 2; ++n) gv[bj][n] = *(const f32x4*)(gn + 32 * bj + 8 * fq + 4 * n) * qs;
#pragma unroll
        for (int ai = 0; ai < 2; ++ai)
#pragma unroll
            for (int m = 0; m < 4; ++m) { const int row = row0 + ai * HALF + m * 16; float ss = 0.f;
#pragma unroll
                for (int bj = 0; bj < 2; ++bj)
#pragma unroll
                    for (int n = 0; n < 2; ++n) { const f32x4 v = acc[ai][bj][m][n]; ss += (v[0] * v[0] + v[1] * v[1]) + (v[2] * v[2] + v[3] * v[3]); }
                ss += __shfl_xor(ss, 16); ss += __shfl_xor(ss, 32);
                const float rstd = __builtin_amdgcn_rsqf(ss * (1.0f / 64.0f) + EPS);
                const float* rp = rope + (size_t)(row & 2047) * 64;
#pragma unroll
                for (int bj = 0; bj < 2; ++bj) { f32x4 o[2];
#pragma unroll
                    for (int n = 0; n < 2; ++n) { const f32x4 v = acc[ai][bj][m][n] * rstd * gv[bj][n];
                        if (lat) { const f32x4 cs = *(const f32x4*)(rp + (16 * bj + 4 * fq + 2 * n) * 2);
                            o[n][0] = v[0] * cs[0] - v[1] * cs[1]; o[n][1] = v[0] * cs[1] + v[1] * cs[0]; o[n][2] = v[2] * cs[2] - v[3] * cs[3]; o[n][3] = v[2] * cs[3] + v[3] * cs[2]; }
                        else o[n] = v; }
                    *(u32x4*)(P1 + (size_t)row * P1W + dst + 32 * bj) = pack8(o[0], o[1]); }
            }
    }
};
template <int WHICH  > struct EpiMlaUp {
    static constexpr bool PERM = true;
    bf16_t* O; const float* rowss;
    __device__ __forceinline__ void operator()(const Acc& acc, const Unit& u, int wr, int wc, int fr, int fq) const {
        constexpr int PITCH = WHICH == 0 ? 768 : 1024;
        const int row0 = u.pm * BM + wr * 64 + fr, col0 = u.pn * BM + wc * 32 + 8 * fq;
#pragma unroll
        for (int ai = 0; ai < 2; ++ai)
#pragma unroll
            for (int m = 0; m < 4; ++m) { const int row = row0 + ai * HALF + m * 16; float r;
                if (WHICH == 0) { const f32x4 a = *(const f32x4*)(rowss + (size_t)row * 12 + 4), b = *(const f32x4*)(rowss + (size_t)row * 12 + 8); r = __builtin_amdgcn_rsqf((((a.x + a.y) + (a.z + a.w)) + ((b.x + b.y) + (b.z + b.w))) * (1.0f / 384.0f) + EPS); }
                else { const f32x4 a = *(const f32x4*)(rowss + (size_t)row * 12); r = __builtin_amdgcn_rsqf(((a.x + a.y) + (a.z + a.w)) * (1.0f / 256.0f) + EPS); }
#pragma unroll
                for (int bj = 0; bj < 2; ++bj) *(u32x4*)(O + (size_t)row * PITCH + col0 + bj * HALF) = pack8(acc[ai][bj][m][0] * r, acc[ai][bj][m][1] * r);
                asm volatile("" ::: "memory"); }
    }
};
struct EpiMlaQ {
    static constexpr bool PERM = true;
    bf16_t* O; const float* rowss; float* ssq;
    __device__ __forceinline__ void operator()(const Acc& acc, const Unit& u, int wr, int wc, int fr, int fq) const {
        const int row0 = u.pm * BM + wr * 64 + fr, col0 = u.pn * BM + wc * 32 + 8 * fq;
        bf16_t* Op = (bf16_t*)((unsigned char*)O + RAS_QC + ra_panel_off(u.pm, 1536)) - (size_t)u.pm * BM * 768;
        float rr[2][4];
        { typedef float f32x2v __attribute__((ext_vector_type(2))); f32x2v t[2][4];
#pragma unroll
          for (int ai = 0; ai < 2; ++ai)
#pragma unroll
              for (int m = 0; m < 4; ++m) t[ai][m] = *(const f32x2v*)(rowss + (size_t)(row0 + ai * HALF + m * 16) * 12 + 4 + 2 * fq);
#pragma unroll
          for (int ai = 0; ai < 2; ++ai)
#pragma unroll
              for (int m = 0; m < 4; ++m) { float v = t[ai][m].x + t[ai][m].y; v += __shfl_xor(v, 16); v += __shfl_xor(v, 32); rr[ai][m] = __builtin_amdgcn_rsqf(v * (1.0f / 384.0f) + EPS); } }
#pragma unroll
        for (int ai = 0; ai < 2; ++ai)
#pragma unroll
            for (int m = 0; m < 4; ++m) { const int row = row0 + ai * HALF + m * 16;
                const float r = rr[ai][m];
#pragma unroll
                for (int bj = 0; bj < 2; ++bj) { const f32x4 v0 = acc[ai][bj][m][0] * r, v1 = acc[ai][bj][m][1] * r;
                    *(u32x4*)(Op + (size_t)row * 768 + col0 + bj * HALF) = pack8(v0, v1);
                    float ss = ((v0[0] * v0[0] + v0[1] * v0[1]) + (v0[2] * v0[2] + v0[3] * v0[3])) + ((v1[0] * v1[0] + v1[1] * v1[1]) + (v1[2] * v1[2] + v1[3] * v1[3]));
                    ss += __shfl_xor(ss, 16); ss += __shfl_xor(ss, 32);
                    if (fq == 0) ssq[(size_t)row * 24 + 8 * u.pn + 4 * bj + wc] = ss; }
                if (m & 1) asm volatile("" ::: "memory"); }
    }
};
struct EpiMlaKV {
    static constexpr bool PERM = true;
    bf16_t* KC; bf16_t* VC; const bf16_t* P1; const float* rowss; const float* gk; const float* rope;
    __device__ __forceinline__ void operator()(const Acc& acc, const Unit& u, int wr, int wc, int fr, int fq) const {
        const int row0 = u.pm * BM + wr * 64 + fr; const bool lat = u.pm < NLAT / BM;
        const int hh = 2 * u.pn + (wc & 1);
        bf16_t* KCp = (bf16_t*)((unsigned char*)KC + RAS_KC + ra_panel_off(u.pm, 1536)) - (size_t)u.pm * BM * 768;
        bf16_t* VCp = (bf16_t*)((unsigned char*)VC + RAS_VC + ra_panel_off(u.pm, 1024)) - (size_t)u.pm * BM * 512;
        float rr[2][4];
        { float t[2][4];
#pragma unroll
          for (int ai = 0; ai < 2; ++ai)
#pragma unroll
              for (int m = 0; m < 4; ++m) t[ai][m] = rowss[(size_t)(row0 + ai * HALF + m * 16) * 12 + fq];
#pragma unroll
          for (int ai = 0; ai < 2; ++ai)
#pragma unroll
              for (int m = 0; m < 4; ++m) { float v = t[ai][m]; v += __shfl_xor(v, 16); v += __shfl_xor(v, 32); rr[ai][m] = __builtin_amdgcn_rsqf(v * (1.0f / 256.0f) + EPS); } }
        if (wc >= 2) {
#pragma unroll
            for (int ai = 0; ai < 2; ++ai)
#pragma unroll
                for (int m = 0; m < 4; ++m) { const int row = row0 + ai * HALF + m * 16;
                    const float r = rr[ai][m];
#pragma unroll
                    for (int bj = 0; bj < 2; ++bj) *(u32x4*)(VCp + (size_t)row * 512 + 64 * hh + 32 * bj + 8 * fq) = pack8(acc[ai][bj][m][0] * r, acc[ai][bj][m][1] * r);
                    if (m & 1) asm volatile("" ::: "memory"); }
            return;
        }
        f32x4 gv[2][2], gr[2];
#pragma unroll
        for (int bj = 0; bj < 2; ++bj)
#pragma unroll
            for (int n = 0; n < 2; ++n) gv[bj][n] = *(const f32x4*)(gk + 32 * bj + 8 * fq + 4 * n);
        gr[0] = *(const f32x4*)(gk + 64 + 8 * fq); gr[1] = *(const f32x4*)(gk + 64 + 8 * fq + 4);
#pragma unroll
        for (int ai = 0; ai < 2; ++ai)
#pragma unroll
            for (int m = 0; m < 4; ++m) { const int row = row0 + ai * HALF + m * 16;
                const float r = rr[ai][m];
                const u32x4 kw = *(const u32x4*)(P1 + (size_t)row * P1W + P_CKR + 8 * fq);
                f32x4 k0, k1;
                k0[0] = __uint_as_float(kw.x << 16); k0[1] = __uint_as_float(kw.x & 0xffff0000u); k0[2] = __uint_as_float(kw.y << 16); k0[3] = __uint_as_float(kw.y & 0xffff0000u);
                k1[0] = __uint_as_float(kw.z << 16); k1[1] = __uint_as_float(kw.z & 0xffff0000u); k1[2] = __uint_as_float(kw.w << 16); k1[3] = __uint_as_float(kw.w & 0xffff0000u);
                float ss = ((k0[0] * k0[0] + k0[1] * k0[1]) + (k0[2] * k0[2] + k0[3] * k0[3])) + ((k1[0] * k1[0] + k1[1] * k1[1]) + (k1[2] * k1[2] + k1[3] * k1[3]));
                f32x4 v[2][2];
#pragma unroll
                for (int bj = 0; bj < 2; ++bj)
#pragma unroll
                    for (int n = 0; n < 2; ++n) { v[bj][n] = acc[ai][bj][m][n] * r; const f32x4 t = v[bj][n]; ss += (t[0] * t[0] + t[1] * t[1]) + (t[2] * t[2] + t[3] * t[3]); }
                ss += __shfl_xor(ss, 16); ss += __shfl_xor(ss, 32);
                const float rstd = __builtin_amdgcn_rsqf(ss * (1.0f / 96.0f) + EPS);
                bf16_t* o = KCp + (size_t)row * 768 + 96 * hh;
#pragma unroll
                for (int bj = 0; bj < 2; ++bj) *(u32x4*)(o + 32 * bj + 8 * fq) = pack8(v[bj][0] * rstd * gv[bj][0], v[bj][1] * rstd * gv[bj][1]);
                k0 = k0 * rstd * gr[0]; k1 = k1 * rstd * gr[1];
                if (lat) { const float* rp = rope + ((size_t)(row & 2047) * 16 + 4 * fq) * 2; const f32x4 c0 = *(const f32x4*)rp, c1 = *(const f32x4*)(rp + 4);
                    f32x4 t0, t1; t0[0] = k0[0] * c0[0] - k0[1] * c0[1]; t0[1] = k0[0] * c0[1] + k0[1] * c0[0]; t0[2] = k0[2] * c0[2] - k0[3] * c0[3]; t0[3] = k0[2] * c0[3] + k0[3] * c0[2];
                    t1[0] = k1[0] * c1[0] - k1[1] * c1[1]; t1[1] = k1[0] * c1[1] + k1[1] * c1[0]; t1[2] = k1[2] * c1[2] - k1[3] * c1[3]; t1[3] = k1[2] * c1[3] + k1[3] * c1[2]; k0 = t0; k1 = t1; }
                *(u32x4*)(o + 64 + 8 * fq) = pack8(k0, k1);
                if (m & 1) asm volatile("" ::: "memory"); }
    }
};
struct EpiSigmoid {
    static constexpr bool PERM = true;
    bf16_t* G;
    __device__ __forceinline__ void operator()(const Acc& acc, const Unit& u, int wr, int wc, int fr, int fq) const {
        const int row0 = u.pm * BM + wr * 64 + fr, col0 = u.pn * BM + wc * 32 + 8 * fq;
#pragma unroll
        for (int ai = 0; ai < 2; ++ai)
#pragma unroll
            for (int m = 0; m < 4; ++m)
#pragma unroll
                for (int bj = 0; bj < 2; ++bj) { f32x4 o[2];
#pragma unroll
                    for (int n = 0; n < 2; ++n)
#pragma unroll
                        for (int e = 0; e < 4; ++e) o[n][e] = fast_sigmoid(acc[ai][bj][m][n][e]);
                    *(u32x4*)(G + (size_t)(row0 + ai * HALF + m * 16) * 3072 + col0 + bj * HALF) = pack8(o[0], o[1]); }
    }
};
template <int Z> struct EpiMerge {
    static constexpr bool PERM = true;
    bf16_t* Mm; const bf16_t* G;
    __device__ __forceinline__ void operator()(const Acc& acc, const Unit& u, int wr, int wc, int fr, int fq) const {
        const int row0 = u.pm * BM + wr * 64 + fr, col0 = u.pn * BM + wc * 32 + 8 * fq;
#pragma unroll
        for (int ai = 0; ai < 2; ++ai)
#pragma unroll
            for (int m = 0; m < 4; ++m)
#pragma unroll
                for (int bj = 0; bj < 2; ++bj) { const size_t row = (size_t)(row0 + ai * HALF + m * 16);
                    const u32x4 gw = *(const u32x4*)(G + row * 3072 + Z * 1024 + col0 + bj * HALF);
                    u32x4 mw = (u32x4){0u, 0u, 0u, 0u}; if (Z > 0) mw = *(const u32x4*)(Mm + row * P1W + col0 + bj * HALF);
                    f32x4 o[2];
#pragma unroll
                    for (int n = 0; n < 2; ++n)
#pragma unroll
                        for (int e2 = 0; e2 < 2; ++e2) { const unsigned gg = gw[2 * n + e2], mm = mw[2 * n + e2];
                            o[n][2 * e2] = __uint_as_float(mm << 16) + __uint_as_float(gg << 16) * acc[ai][bj][m][n][2 * e2];
                            o[n][2 * e2 + 1] = __uint_as_float(mm & 0xffff0000u) + __uint_as_float(gg & 0xffff0000u) * acc[ai][bj][m][n][2 * e2 + 1]; }
                    *(u32x4*)(Mm + row * P1W + col0 + bj * HALF) = pack8(o[0], o[1]); }
    }
};
struct EpiMergeZ {
    static constexpr bool PERM = true;
    bf16_t* Mm; const bf16_t* G;
    __device__ __forceinline__ void operator()(const Acc& acc, const Unit& u, int wr, int wc, int fr, int fq) const {
        const int row0 = u.pm * BM + wr * 64 + fr, col0 = u.pn * BM + wc * 32 + 8 * fq, z = u.z, gz = z == 0 ? 2 : z - 1;
        const bf16_t* Gp = (const bf16_t*)((const unsigned char*)G + ra_panel_off(u.pm, 3072 * 2)) - (size_t)u.pm * BM * 3072;
#pragma unroll
        for (int ai = 0; ai < 2; ++ai)
#pragma unroll
            for (int m = 0; m < 4; ++m) {
#pragma unroll
                for (int bj = 0; bj < 2; ++bj) { const size_t row = (size_t)(row0 + ai * HALF + m * 16);
                    const u32x4 gw = *(const u32x4*)(Gp + row * 3072 + gz * 1024 + col0 + bj * HALF);
                    u32x4 mw = (u32x4){0u, 0u, 0u, 0u}; if (z > 0) mw = *(const u32x4*)(Mm + row * D + col0 + bj * HALF);
                    f32x4 o[2];
#pragma unroll
                    for (int n = 0; n < 2; ++n)
#pragma unroll
                        for (int e2 = 0; e2 < 2; ++e2) { const unsigned gg = gw[2 * n + e2], mm = mw[2 * n + e2];
                            o[n][2 * e2] = __uint_as_float(mm << 16) + __uint_as_float(gg << 16) * acc[ai][bj][m][n][2 * e2];
                            o[n][2 * e2 + 1] = __uint_as_float(mm & 0xffff0000u) + __uint_as_float(gg & 0xffff0000u) * acc[ai][bj][m][n][2 * e2 + 1]; }
                    *(u32x4*)(Mm + row * D + col0 + bj * HALF) = pack8(o[0], o[1]); }
                if (m & 1) asm volatile("" ::: "memory"); }
    }
};
__device__ __forceinline__ float row_r(const float* ss, int row) { const f32x4 a = *(const f32x4*)(ss + (size_t)row * 16), b = *(const f32x4*)(ss + (size_t)row * 16 + 4), c2 = *(const f32x4*)(ss + (size_t)row * 16 + 8), d = *(const f32x4*)(ss + (size_t)row * 16 + 12);
    return __builtin_amdgcn_rsqf(((((a.x + a.y) + (a.z + a.w)) + ((b.x + b.y) + (b.z + b.w))) + (((c2.x + c2.y) + (c2.z + c2.w)) + ((d.x + d.y) + (d.z + d.w)))) * (1.0f / 1024.0f) + EPS); }
__device__ __forceinline__ f32x4 bias4(const float* bias, int mb, int col) { const float* b = bias + (size_t)mb * NBIAS + col; return *(const f32x4*)b + *(const f32x4*)(b + (size_t)9 * NBIAS); }
__device__ __forceinline__ void rows_r(const float* ss, int row0, int fq, float (&rr)[2][4]) {
    f32x4 t[2][4];
#pragma unroll
    for (int ai = 0; ai < 2; ++ai)
#pragma unroll
        for (int m = 0; m < 4; ++m) t[ai][m] = *(const f32x4*)(ss + (size_t)(row0 + ai * HALF + m * 16) * 16 + 4 * fq);
#pragma unroll
    for (int ai = 0; ai < 2; ++ai)
#pragma unroll
        for (int m = 0; m < 4; ++m) { float v = (t[ai][m].x + t[ai][m].y) + (t[ai][m].z + t[ai][m].w); v += __shfl_xor(v, 16); v += __shfl_xor(v, 32); rr[ai][m] = __builtin_amdgcn_rsqf(v * (1.0f / 1024.0f) + EPS); }
}
struct EpiSwiGLU2 {
    static constexpr bool PERM = true;
    bf16_t* ACT; RowScale rs;
    static constexpr bool HAS_PRE = true;
    __device__ __forceinline__ void operator()(const Acc& acc, const Unit& u, int wr, int wc, int fr, int fq, const Pre& pre) const {
        const int row0 = wr * 64 + fr, col0 = u.pn * 128 + wc * 32 + 8 * fq;
        bf16_t* ACTp = (bf16_t*)((unsigned char*)ACT + ra_panel_off(u.pm, DFF * 2));
        const float (&rr)[2][4] = pre.rr; const f32x4 (&bv)[2][2] = pre.bv;
#pragma unroll
        for (int ai = 0; ai < 2; ++ai)
#pragma unroll
            for (int m = 0; m < 4; ++m) { const int row = row0 + ai * HALF + m * 16; const float r = rr[ai][m];
                f32x4 o[2];
#pragma unroll
                for (int n = 0; n < 2; ++n) { const f32x4 gt = acc[ai][0][m][n] * r + bv[0][n], up = acc[ai][1][m][n] * r + bv[1][n];
#pragma unroll
                    for (int e = 0; e < 4; ++e) o[n][e] = gt[e] * fast_sigmoid(gt[e]) * up[e]; }
                *(u32x4*)(ACTp + (size_t)row * DFF + col0) = pack8(o[0], o[1]);
                if (m & 1) asm volatile("" ::: "memory"); }
    }
};
struct EpiSigmoid2 {
    static constexpr bool PERM = true;
    bf16_t* G; RowScale rs;
    static constexpr bool HAS_PRE = true;
    __device__ __forceinline__ void operator()(const Acc& acc, const Unit& u, int wr, int wc, int fr, int fq, const Pre& pre) const {
        const int row0 = wr * 64 + fr, col0 = u.pn * BM + wc * 32 + 8 * fq;
        bf16_t* Gp = (bf16_t*)((unsigned char*)G + ra_panel_off(u.pm, 3072 * 2));
        const float (&rr)[2][4] = pre.rr; const f32x4 (&bv)[2][2] = pre.bv;
#pragma unroll
        for (int ai = 0; ai < 2; ++ai)
#pragma unroll
            for (int m = 0; m < 4; ++m) { const int row = row0 + ai * HALF + m * 16; const float r = rr[ai][m];
#pragma unroll
                for (int bj = 0; bj < 2; ++bj) { f32x4 o[2];
#pragma unroll
                    for (int n = 0; n < 2; ++n) { const f32x4 t = acc[ai][bj][m][n] * r + bv[bj][n];
#pragma unroll
                        for (int e = 0; e < 4; ++e) o[n][e] = fast_sigmoid(t[e]); }
                    *(u32x4*)(Gp + (size_t)row * 3072 + col0 + bj * HALF) = pack8(o[0], o[1]); }
                if (m & 1) asm volatile("" ::: "memory"); }
    }
};
struct EpiInProj2 {
    static constexpr bool PERM = true;
    bf16_t* P1; float* rowss; const float* rope; const float* gqa; const float* gka; const float* gqb; const float* gkb; RowScale rs;
    static constexpr bool HAS_PRE = true;
    __device__ __forceinline__ void operator()(const Acc& acc, const Unit& u, int wr, int wc, int fr, int fq, const Pre& pre) const {
        const int pn = u.pn; const bool lat = u.pm < NLAT / BM; const int mb = lat ? (u.pm >> 3) : 8;
        const int row0 = u.pm * BM + wr * 64 + fr;
        const float (&rr)[2][4] = pre.rr; const f32x4 (&bv)[2][2] = pre.bv;
        if (pn >= 2 && pn <= 4) {
            const int dstc = (pn == 2 ? P_CKV : (pn == 3 ? P_CQ : P_CQ + 256)) + wc * 32 + 8 * fq;
#pragma unroll
            for (int ai = 0; ai < 2; ++ai)
#pragma unroll
                for (int m = 0; m < 4; ++m) { const int row = row0 + ai * HALF + m * 16; float ss = 0.f; const float r = rr[ai][m];
#pragma unroll
                    for (int bj = 0; bj < 2; ++bj) { const f32x4 v0 = acc[ai][bj][m][0] * r + bv[bj][0], v1 = acc[ai][bj][m][1] * r + bv[bj][1];
                        *(u32x4*)(P1 + (size_t)row * P1W + dstc + bj * HALF) = pack8(v0, v1);
                        if (bj == 0 || pn != 4) ss += ((v0[0] * v0[0] + v0[1] * v0[1]) + (v0[2] * v0[2] + v0[3] * v0[3])) + ((v1[0] * v1[0] + v1[1] * v1[1]) + (v1[2] * v1[2] + v1[3] * v1[3])); }
                    ss += __shfl_xor(ss, 16); ss += __shfl_xor(ss, 32);
                    if (fq == 0) rowss[(size_t)row * 12 + (pn - 2) * 4 + wc] = ss;
                    if (m & 1) asm volatile("" ::: "memory"); }
            return;
        }
        int dst; const float* gn = nullptr; float qs = 1.0f;
        if (pn == 0) { if (wc < 2) { dst = P_KA + 64 * wc; gn = gka; } else dst = P_VA + 64 * (wc - 2); }
        else if (pn == 1) { if (wc < 2) { dst = P_KB + 64 * wc; gn = gkb; } else dst = P_VB + 64 * (wc - 2); }
        else if (pn <= 6) { dst = P_QA + 64 * (4 * (pn - 5) + wc); gn = gqa; qs = QSC64; }
        else { dst = P_QB + 64 * (4 * (pn - 7) + wc); gn = gqb; qs = QSC64; }
        dst += 8 * fq;
        if (gn == nullptr) {
#pragma unroll
            for (int ai = 0; ai < 2; ++ai)
#pragma unroll
                for (int m = 0; m < 4; ++m) { const int row = row0 + ai * HALF + m * 16; const float r = rr[ai][m];
#pragma unroll
                    for (int bj = 0; bj < 2; ++bj) *(u32x4*)(P1 + (size_t)row * P1W + dst + 32 * bj) = pack8(acc[ai][bj][m][0] * r + bv[bj][0], acc[ai][bj][m][1] * r + bv[bj][1]);
                    if (m & 1) asm volatile("" ::: "memory"); }
            return;
        }
        f32x4 gv[2][2];
#pragma unroll
        for (int bj = 0; bj < 2; ++bj)
#pragma unroll
            for (int n = 0; n < 2; ++n) gv[bj][n] = *(const f32x4*)(gn + 32 * bj + 8 * fq + 4 * n) * qs;
#pragma unroll
        for (int ai = 0; ai < 2; ++ai)
#pragma unroll
            for (int m = 0; m < 4; ++m) { const int row = row0 + ai * HALF + m * 16; float ss = 0.f; const float r = rr[ai][m];
                f32x4 t[2][2];
#pragma unroll
                for (int bj = 0; bj < 2; ++bj)
#pragma unroll
                    for (int n = 0; n < 2; ++n) { const f32x4 v = acc[ai][bj][m][n] * r + bv[bj][n]; t[bj][n] = v; ss += (v[0] * v[0] + v[1] * v[1]) + (v[2] * v[2] + v[3] * v[3]); }
                ss += __shfl_xor(ss, 16); ss += __shfl_xor(ss, 32);
                const float rstd = __builtin_amdgcn_rsqf(ss * (1.0f / 64.0f) + EPS);
                const float* rp = rope + (size_t)(row & 2047) * 64;
#pragma unroll
                for (int bj = 0; bj < 2; ++bj) { f32x4 o[2];
#pragma unroll
                    for (int n = 0; n < 2; ++n) { const f32x4 v = t[bj][n] * rstd * gv[bj][n];
                        if (lat) { const f32x4 cs = *(const f32x4*)(rp + (16 * bj + 4 * fq + 2 * n) * 2);
                            o[n][0] = v[0] * cs[0] - v[1] * cs[1]; o[n][1] = v[0] * cs[1] + v[1] * cs[0]; o[n][2] = v[2] * cs[2] - v[3] * cs[3]; o[n][3] = v[2] * cs[3] + v[3] * cs[2]; }
                        else o[n] = v; }
                    *(u32x4*)(P1 + (size_t)row * P1W + dst + 32 * bj) = pack8(o[0], o[1]); }
                if (m & 1) asm volatile("" ::: "memory"); }
    }
};
struct EpiResN {
    static constexpr bool PERM = true;
    const Params* p; int l, gi, from_input; float coef; int gin, goff, lnext, sidx;
    __device__ __forceinline__ void operator()(const Acc& acc, const Unit& u, int wr, int wc, int fr, int fq) const {
        const bool lat = u.pm < NLAT / BM; const int pmr = lat ? u.pm : u.pm - NLAT / BM; const int mb = lat ? (u.pm >> 3) : 8;
        unsigned char* ws = p->ws;
        const float* bp = (from_input ? (lat ? p->in[0] : p->in[2]) : (lat ? (const float*)p->out : (const float*)(ws + WS_Z))) + (size_t)pmr * BM * D;
        float* op = (lat ? p->out : (float*)(ws + WS_Z)) + (size_t)pmr * BM * D;
        const float* mod = (const float*)(ws + WS_MOD);
        const float* md = mod + ((size_t)l * 9 + mb) * MODW + gi * D;
        const bool emit = gin >= 0;
        const float* gnext = emit ? p->in[gin] + goff : nullptr; const float* scn = mod + ((size_t)lnext * 9 + mb) * MODW + (sidx + 1) * D;
        bf16_t* H = (bf16_t*)(ws + WS_H); float* ss = (float*)(ws + WS_SS);
        const int col0 = u.pn * BM + wc * 32 + 8 * fq;
        f32x4 mv[2][2], gs[2][2];
#pragma unroll
        for (int bj = 0; bj < 2; ++bj)
#pragma unroll
            for (int n = 0; n < 2; ++n) { const int cc = col0 + bj * HALF + 4 * n; mv[bj][n] = *(const f32x4*)(md + cc) * coef;
                gs[bj][n] = emit ? *(const f32x4*)(gnext + cc) * (*(const f32x4*)(scn + cc) + 1.0f) : (f32x4){0.f, 0.f, 0.f, 0.f}; }
#pragma unroll
        for (int ai = 0; ai < 2; ++ai)
#pragma unroll
            for (int m = 0; m < 4; ++m) { const int rl = ai * HALF + wr * 64 + m * 16 + fr; const size_t off = (size_t)rl * D + col0; float ssum = 0.f;
#pragma unroll
                for (int bj = 0; bj < 2; ++bj) { f32x4 x[2];
#pragma unroll
                    for (int n = 0; n < 2; ++n) { x[n] = *(const f32x4*)(bp + off + bj * HALF + 4 * n) + mv[bj][n] * acc[ai][bj][m][n]; *(f32x4*)(op + off + bj * HALF + 4 * n) = x[n];
                        ssum += (x[n][0] * x[n][0] + x[n][1] * x[n][1]) + (x[n][2] * x[n][2] + x[n][3] * x[n][3]); }
                    if (emit) *(u32x4*)(H + (size_t)(u.pm * BM + rl) * D + col0 + bj * HALF) = pack8(x[0] * gs[bj][0], x[1] * gs[bj][1]); }
                if (emit) { ssum += __shfl_xor(ssum, 16); ssum += __shfl_xor(ssum, 32); if (fq == 0) ss[(size_t)(u.pm * BM + rl) * 16 + u.pn * 4 + wc] = ssum; }
                if (m & 1) asm volatile("" ::: "memory"); }
    }
};
}

__device__ __forceinline__ void phase_mla_norm(Ctx& c, int l, int rows_q, int rows_k) {
    PH_IDS(c);
    const Params* p = c.p;
    const int gw = c.wg * 8 + c.wave, ngw = c.nwg * 8, h = lane_ >> 3, j = lane_ & 7;
    const float* gq = p->in[20] + l * 96 + 12 * j; const float* gk = p->in[21] + l * 96 + 12 * j;
    float gqv[12], gkv[12];
#pragma unroll
    for (int i = 0; i < 12; ++i) { gqv[i] = gq[i] * QSC96; gkv[i] = gk[i]; }
    for (int r = gw; r < rows_k; r += ngw) {
        const bool lat = r < NLAT; const int s = r & 2047;
#pragma unroll
        for (int which = 0; which < 2; ++which) {
            if (which == 0 && r >= rows_q) continue;
            float v[12];
            if (which == 0) { const u32x2* qp = (const u32x2*)(c.QC + (size_t)r * 768 + 96 * h + 12 * j);
#pragma unroll
                for (int i = 0; i < 3; ++i) { const u32x2 w = qp[i]; v[4 * i] = __uint_as_float(w.x << 16); v[4 * i + 1] = __uint_as_float(w.x & 0xffff0000u); v[4 * i + 2] = __uint_as_float(w.y << 16); v[4 * i + 3] = __uint_as_float(w.y & 0xffff0000u); } }
            else {
#pragma unroll
                for (int i = 0; i < 3; ++i) { const int d = 12 * j + 4 * i;
                    const bf16_t* src = d < 64 ? c.KVR + (size_t)r * 1024 + 128 * h + d : c.P1 + (size_t)r * P1W + P_CKR + (d - 64);
                    const u32x2 w = *(const u32x2*)src; v[4 * i] = __uint_as_float(w.x << 16); v[4 * i + 1] = __uint_as_float(w.x & 0xffff0000u); v[4 * i + 2] = __uint_as_float(w.y << 16); v[4 * i + 3] = __uint_as_float(w.y & 0xffff0000u); } }
            float ss = 0.f;
#pragma unroll
            for (int i = 0; i < 12; ++i) ss += v[i] * v[i];
            ss += __shfl_xor(ss, 1); ss += __shfl_xor(ss, 2); ss += __shfl_xor(ss, 4);
            const float rstd = 1.0f / sqrtf(ss * (1.0f / 96.0f) + EPS);
#pragma unroll
            for (int i = 0; i < 12; ++i) v[i] *= rstd * (which == 0 ? gqv[i] : gkv[i]);
            if (lat) {
#pragma unroll
                for (int i = 0; i < 6; ++i) { const int d = 12 * j + 2 * i;
                    if (d >= 64) { const float cs = c.rope_c[(s * 16 + ((d - 64) >> 1)) * 2], sn = c.rope_c[(s * 16 + ((d - 64) >> 1)) * 2 + 1];
                        const float x0 = v[2 * i], x1 = v[2 * i + 1]; v[2 * i] = x0 * cs - x1 * sn; v[2 * i + 1] = x0 * sn + x1 * cs; } }
            }
            u32x2* op = (u32x2*)((which == 0 ? c.QC : c.KC) + (size_t)r * 768 + 96 * h + 12 * j);
#pragma unroll
            for (int i = 0; i < 3; ++i) { u32x2 w; w.x = pk2(v[4 * i], v[4 * i + 1]); w.y = pk2(v[4 * i + 2], v[4 * i + 3]); op[i] = w; }
        }
    }
}

__device__ __forceinline__ void fast_ffn_up(Ctx& c, unsigned char* lds, size_t wo, int rows) {
    pg8::Gemm g{c.H, (const bf16_t*)(c.ws + WS_W + wo), rows, 2 * DFF, D, D}; pg8::StaticOrder S; S.init(rows, 2 * DFF, c.nwg, c.wg);
    pg8::EpiSwiGLU E{c.ACT};
    pg8::gemm_phase<pg8::EpiSwiGLU, pg8::StaticOrder, true>((LAS unsigned char*)lds, c.wave, g, S, E);
}
__device__ __forceinline__ void fast_res(Ctx& c, unsigned char* lds, int l, const bf16_t* A, int K, size_t wo, float coef, int gi, int rows, bool from_input) {
    pg8::Gemm g{A, (const bf16_t*)(c.ws + WS_W + wo), rows, D, K, K}; pg8::StaticOrder S; S.init(rows, D, c.nwg, c.wg);
    pg8::EpiRes E{from_input ? c.p->in[0] : c.p->out, from_input ? c.p->in[2] : c.Z, c.p->out, c.Z, c.mod + (size_t)l * 9 * MODW, gi, coef};
    pg8::gemm_phase<pg8::EpiRes, pg8::StaticOrder, true>((LAS unsigned char*)lds, c.wave, g, S, E);
}
__device__ __forceinline__ void fast_inproj(Ctx& c, unsigned char* lds, int l, int rows) {
    const Params* p = c.p;
    pg8::Gemm g{c.H, (const bf16_t*)(c.ws + WS_W + WO_P1), rows, P1W, D, D}; pg8::StaticOrder S; S.init(rows, P1W, c.nwg, c.wg);
    pg8::EpiInProj E{c.P1, c.rowss, c.rope_hd, p->in[11] + l * 64, p->in[12] + l * 64, p->in[14] + l * 64, p->in[15] + l * 64};
    pg8::gemm_phase<pg8::EpiInProj, pg8::StaticOrder, true>((LAS unsigned char*)lds, c.wave, g, S, E);
}
__device__ __forceinline__ void fast_mla_up(Ctx& c, unsigned char* lds, int l, int rows_q, int rows_k) {
    { pg8::Gemm g{c.P1 + P_CQ, (const bf16_t*)(c.ws + WS_W + WO_UQ), rows_q, 768, 384, P1W}; pg8::StaticOrder S; S.init_grp(c.lat0, c.nlat, c.ctx0, c.nctx, rows_q == MT, 768, c.nwg, c.wg);
      pg8::EpiMlaQ E{(bf16_t*)(c.ws + WS_RA), c.rowss, c.ssq};     pg8::gemm_phase<pg8::EpiMlaQ, pg8::StaticOrder, true>((LAS unsigned char*)lds, c.wave, g, S, E); }
    { pg8::Gemm g{c.P1 + P_CKV, (const bf16_t*)(c.ws + WS_W + WO_UKV), rows_k, 1024, 256, P1W}; pg8::StaticOrder S; S.init_grp(c.lat0, c.nlat, c.ctx0, c.nctx, rows_k == MT, 1024, c.nwg, c.wg);
      pg8::EpiMlaKV E{(bf16_t*)(c.ws + WS_RA), (bf16_t*)(c.ws + WS_RA), c.P1, c.rowss, c.p->in[21] + l * 96, c.rope_c};     pg8::gemm_phase<pg8::EpiMlaKV, pg8::StaticOrder, true>((LAS unsigned char*)lds, c.wave, g, S, E); }
}
__device__ __forceinline__ void fast_gates(Ctx& c, unsigned char* lds, int rows) {
    pg8::Gemm g{c.H, (const bf16_t*)(c.ws + WS_W + WO_G), rows, 3072, D, D}; pg8::StaticOrder S; S.init(rows, 3072, c.nwg, c.wg);
    pg8::EpiSigmoid E{c.G};
    pg8::gemm_phase<pg8::EpiSigmoid, pg8::StaticOrder, true>((LAS unsigned char*)lds, c.wave, g, S, E);
}
__device__ __forceinline__ void fast_merge(Ctx& c, unsigned char* lds, int rows) {
    pg8::StaticOrder S; S.init(rows, D, c.nwg, c.wg);
    { pg8::Gemm g{c.P1 + P_QA, (const bf16_t*)(c.ws + WS_W + WO_BR), rows, D, 512, P1W}; pg8::EpiMerge<0> E{c.P1, c.G}; pg8::gemm_phase<pg8::EpiMerge<0>, pg8::StaticOrder, true>((LAS unsigned char*)lds, c.wave, g, S, E); }
    { pg8::Gemm g{c.P1 + P_QB, (const bf16_t*)(c.ws + WS_W + WO_BR) + (size_t)1024 * 512, rows, D, 512, P1W}; pg8::EpiMerge<1> E{c.P1, c.G}; pg8::gemm_phase<pg8::EpiMerge<1>, pg8::StaticOrder, true>((LAS unsigned char*)lds, c.wave, g, S, E); }
    { pg8::Gemm g{c.YC, (const bf16_t*)(c.ws + WS_W + WO_BR) + (size_t)2 * 1024 * 512, rows, D, 512, 512}; pg8::EpiMerge<2> E{c.P1, c.G}; pg8::gemm_phase<pg8::EpiMerge<2>, pg8::StaticOrder, true>((LAS unsigned char*)lds, c.wave, g, S, E); }
}

__device__ __forceinline__ void fz_ffn_up(Ctx& c, unsigned char* lds, size_t wo, int boff, int rows) {
    pg8::Gemm g{c.H, (const bf16_t*)(c.ws + WS_W + wo), rows, 2 * DFF, D, D}; pg8::StaticOrder S; S.init_grp(c.lat0, c.nlat, c.ctx0, c.nctx, rows == MT, 2 * DFF, c.nwg, c.wg);
    pg8::EpiSwiGLU2 E{c.ACT, {c.ss, c.bias + boff}};
    pg8::gemm_phase<pg8::EpiSwiGLU2, pg8::StaticOrder, true>((LAS unsigned char*)lds, c.wave, g, S, E);
}
__device__ __forceinline__ void fz_res(Ctx& c, unsigned char* lds, int l, const bf16_t* A, int lda, int K, size_t wo, float coef, int gi, int rows, bool from_input, int gin, int goff, int lnext, int sidx) {
    pg8::Gemm g{A, (const bf16_t*)(c.ws + WS_W + wo), rows, D, K, lda}; g.rap = (A == c.ACT) ? DFF * 2 : 0; pg8::StaticOrder S; S.init_grp(c.lat0, c.nlat, c.ctx0, c.nctx, rows == MT, D, c.nwg, c.wg);
    pg8::EpiResN E{c.p, l, gi, from_input ? 1 : 0, coef, gin, goff, lnext, sidx};
    pg8::gemm_phase<pg8::EpiResN, pg8::StaticOrder, true>((LAS unsigned char*)lds, c.wave, g, S, E);
}
__device__ __forceinline__ void fz_inproj(Ctx& c, unsigned char* lds, int l, int rows) {
    const Params* p = c.p;
    pg8::Gemm g{c.H, (const bf16_t*)(c.ws + WS_W + WO_P1), rows, P1W, D, D}; pg8::StaticOrder S; S.init_grp(c.lat0, c.nlat, c.ctx0, c.nctx, rows == MT, P1W, c.nwg, c.wg);
    pg8::EpiInProj2 E{c.P1, c.rowss, c.rope_hd, p->in[11] + l * 64, p->in[12] + l * 64, p->in[14] + l * 64, p->in[15] + l * 64, {c.ss, c.bias + BO_P1}};
    pg8::gemm_phase<pg8::EpiInProj2, pg8::StaticOrder, true>((LAS unsigned char*)lds, c.wave, g, S, E);
}
__device__ __forceinline__ void fz_gates(Ctx& c, unsigned char* lds, int rows) {
    pg8::Gemm g{c.H, (const bf16_t*)(c.ws + WS_W + WO_G), rows, 3072, D, D}; pg8::StaticOrder S; S.init_grp(c.lat0, c.nlat, c.ctx0, c.nctx, rows == MT, 3072, c.nwg, c.wg);
    pg8::EpiSigmoid2 E{c.G, {c.ss, c.bias + BO_G}};
    pg8::gemm_phase<pg8::EpiSigmoid2, pg8::StaticOrder, true>((LAS unsigned char*)lds, c.wave, g, S, E);
}
__device__ __forceinline__ void fz_merge(Ctx& c, unsigned char* lds, int rows) {
    bf16_t* Mb = (bf16_t*)(c.ws + WS_YC); const bf16_t* W = (const bf16_t*)(c.ws + WS_W + WO_BR);
    static_assert(P_QA == P_YC + 512 && P_QB == P_YC + 1024, "branch outputs 512 columns apart: z = 0 C, 1 A, 2 B");
    pg8::Gemm g{c.P1 + P_YC, W, rows, D, 512, P1W, 512, 1024 * 512};
    pg8::TripleOrder S; S.b.init_grp(c.lat0, c.nlat, c.ctx0, c.nctx, rows == MT, D, c.nwg, c.wg);
    pg8::EpiMergeZ E{Mb, c.G};
    pg8::gemm_phase<pg8::EpiMergeZ, pg8::TripleOrder, true>((LAS unsigned char*)lds, c.wave, g, S, E);
}

__device__ __forceinline__ void fz_ffn_up_sub(Ctx& c, unsigned char* lds, size_t wo, int boff, int pm0, int npm, int G, int cc, int R0, int G1) {
    pg8::Gemm g{c.H, (const bf16_t*)(c.ws + WS_W + wo), MT, 2 * DFF, D, D}; pg8::StaticOrder S; S.init_sub(pm0, npm, 2 * DFF, G, cc, R0, G1);
    pg8::EpiSwiGLU2 E{c.ACT, {c.ss, c.bias + boff}};
    pg8::gemm_phase<pg8::EpiSwiGLU2, pg8::StaticOrder, true>((LAS unsigned char*)lds, c.wave, g, S, E);
}
__device__ __forceinline__ void fz_res_sub(Ctx& c, unsigned char* lds, int l, size_t wo, int gi, bool from_input, int gin, int goff, int lnext, int sidx, int pm0, int npm, int G, int cc) {
    pg8::Gemm g{c.ACT, (const bf16_t*)(c.ws + WS_W + wo), MT, D, DFF, DFF}; g.rap = DFF * 2; pg8::StaticOrder S; S.init_sub(pm0, npm, D, G, cc, 1 << 20, G);
    pg8::EpiResN E{c.p, l, gi, from_input ? 1 : 0, 0.5f, gin, goff, lnext, sidx};
    pg8::gemm_phase<pg8::EpiResN, pg8::StaticOrder, true>((LAS unsigned char*)lds, c.wave, g, S, E);
}

namespace fa {
#ifndef FA_FORCE_RESC
#define FA_FORCE_RESC 0
#endif
#if defined(FA_FAKE) && FA_FAKE == 1
#define FA_EXP(x) (__builtin_fabsf(x) * 0.01f + 0.01f)
#else
#define FA_EXP(x) __builtin_amdgcn_exp2f(x)
#endif
typedef float f32x16 __attribute__((ext_vector_type(16)));
typedef short s16x4 __attribute__((ext_vector_type(4)));
typedef short v4i16_t __attribute__((ext_vector_type(4)));
constexpr int KBUF = 12288, VBUF = 8192, SLOT = KBUF + VBUF, NSLOT = 4;
constexpr int OFF_WS = NSLOT * SLOT, OFF_OST = OFF_WS + 2048, LDS_TOTAL = OFF_OST + 8 * 4096;
static_assert(LDS_TOTAL <= 131072, "attention LDS");
constexpr float THR = 8.0f;
__device__ __forceinline__ int crow(int r, int hi) { return (r & 3) + 8 * (r >> 2) + 4 * hi; }
__device__ __forceinline__ s16x4 vtr(const LAS unsigned char* p) { return __builtin_bit_cast(s16x4, __builtin_amdgcn_ds_read_tr16_b64_v4i16((LAS v4i16_t*)p)); }
__device__ __forceinline__ unsigned cvtpk(float lo, float hi) { return pg8::cvt_pk_bf16(lo, hi); }
__device__ __forceinline__ float mx3(float a, float b, float c) { float d; asm("v_max3_f32 %0, %1, %2, %3" : "=v"(d) : "v"(a), "v"(b), "v"(c)); return d; }
__device__ __forceinline__ float mx2(float a, float b) { float d; asm("v_max_f32 %0, %1, %2" : "=v"(d) : "v"(a), "v"(b)); return d; }
__device__ __forceinline__ void glds16(const void* gsrc, unsigned lds_dst) { unsigned keep;
    asm volatile("s_mov_b32 %0, m0\n\ts_mov_b32 m0, %2\n\ts_nop 0\n\tglobal_load_lds_dwordx4 %1, off\n\ts_mov_b32 m0, %0" : "=&s"(keep) : "v"(gsrc), "s"(lds_dst) : "memory"); }
struct UnitDesc {
    const bf16_t* Q; bf16_t* O;
    const bf16_t* Kc; const bf16_t* Vc;
    const bf16_t* Kl; const bf16_t* Vl;
    int qpitch, opitch, kpitch, vpitch, nt_ctx, nt_lat;
    int qoff;
    float sinkl;
    const float* qss; const float* qgain; const float* qrope;
};
struct Pref { const bf16_t* Kc; const bf16_t* Vc; int kpitch, vpitch, d96; };
__device__ __forceinline__ void prefetch3(const Pref& p, LAS unsigned char* lds, int wid) {
    const int lane = lane_id(); const unsigned lds0 = (unsigned)(uintptr_t)lds;
#pragma unroll
    for (int t = 0; t < 3; ++t) {
        const bf16_t* Kt = p.Kc + (size_t)t * 64 * p.kpitch; const bf16_t* Vt = p.Vc + (size_t)t * 64 * p.vpitch; const unsigned sb = lds0 + (unsigned)(t * SLOT);
        glds16(Kt + (size_t)lane * p.kpitch + wid * 8, (unsigned)__builtin_amdgcn_readfirstlane(sb + wid * 1024));
        if (p.d96 > 0) { const int cc = 8 + (wid & 3); glds16(Kt + (size_t)lane * p.kpitch + cc * 8, (unsigned)__builtin_amdgcn_readfirstlane(sb + cc * 1024)); }
        glds16(Vt + (size_t)(16 * (wid & 3) + (lane >> 2)) * p.vpitch + (wid >> 2) * 32 + (lane & 3) * 8, (unsigned)__builtin_amdgcn_readfirstlane(sb + KBUF + wid * 1024));
    }
}
template <int DQK, bool WIN, bool SINK>
__device__ __forceinline__ void attn_unit(const UnitDesc& u, LAS unsigned char* lds, int wid, const Pref& nx) {
    const int lane = lane_id(), r32 = lane & 31, hi = lane >> 5;
    constexpr int ND = DQK / 16, NCH = DQK / 8;
    constexpr int LPT = NCH > 8 ? 3 : 2;
    const int NT = u.nt_ctx + u.nt_lat;
    LAS float* wsf = (LAS float*)(lds + OFF_WS) + wid * 64;
    const unsigned lds0 = (unsigned)(uintptr_t)lds;
    auto issue = [&](int t, int s) {
#if defined(FA_FAKE) && FA_FAKE == 5
        if (t > 2) return;
#endif
        const bool ctx = t < u.nt_ctx; const int tt = ctx ? t : t - u.nt_ctx;
        const bf16_t* Kt = (ctx ? u.Kc : u.Kl) + (size_t)tt * 64 * u.kpitch; const bf16_t* Vt = (ctx ? u.Vc : u.Vl) + (size_t)tt * 64 * u.vpitch;
        const unsigned sb = lds0 + (unsigned)(s * SLOT);
        glds16(Kt + (size_t)lane * u.kpitch + wid * 8, (unsigned)__builtin_amdgcn_readfirstlane(sb + wid * 1024));
        if (NCH > 8) { const int cc = 8 + (wid & 3);
            glds16(Kt + (size_t)lane * u.kpitch + cc * 8, (unsigned)__builtin_amdgcn_readfirstlane(sb + cc * 1024)); }
        glds16(Vt + (size_t)(16 * (wid & 3) + (lane >> 2)) * u.vpitch + (wid >> 2) * 32 + (lane & 3) * 8, (unsigned)__builtin_amdgcn_readfirstlane(sb + KBUF + wid * 1024));
    };
#if defined(FA_FAKE) && FA_FAKE == 3
#define FA_WAIT_BAR(n) asm volatile("s_waitcnt vmcnt(" #n ") lgkmcnt(0)" ::: "memory")
#else
#define FA_WAIT_BAR(n) asm volatile("s_waitcnt vmcnt(" #n ") lgkmcnt(0)\n\ts_barrier" ::: "memory")
#endif
#define FA_WAIT1() do { if (LPT == 3) FA_WAIT_BAR(3); else FA_WAIT_BAR(2); } while (0)
    bf16x8 qr[ND];
    { const bf16_t* qp = u.Q + (size_t)(wid * 32 + r32) * u.qpitch + hi * 8;
#pragma unroll
      for (int d0 = 0; d0 < ND; ++d0) qr[d0] = *(const bf16x8*)(qp + d0 * 16);
      if (DQK == 96) {
          const float* sq = u.qss + (size_t)(wid * 32 + r32) * 24; const float rstd = __builtin_amdgcn_rsqf((sq[0] + sq[1] + sq[2]) * (1.0f / 96.0f) + EPS);
#pragma unroll
          for (int d0 = 0; d0 < ND; ++d0) { const f32x4 g0 = *(const f32x4*)(u.qgain + d0 * 16 + hi * 8), g1 = *(const f32x4*)(u.qgain + d0 * 16 + hi * 8 + 4);
              float v[8];
#pragma unroll
              for (int j = 0; j < 8; ++j) v[j] = bf2f((bf16_t)qr[d0][j]) * rstd * (j < 4 ? g0[j] : g1[j - 4]) * QSC96;
              if (d0 >= 4 && u.qrope != nullptr) { const float* rp = u.qrope + ((size_t)((wid * 32 + r32) & 2047) * 16 + (d0 - 4) * 8 + hi * 4) * 2; const f32x4 c0 = *(const f32x4*)rp, c1 = *(const f32x4*)(rp + 4);
                  float t[8]; t[0] = v[0] * c0[0] - v[1] * c0[1]; t[1] = v[0] * c0[1] + v[1] * c0[0]; t[2] = v[2] * c0[2] - v[3] * c0[3]; t[3] = v[2] * c0[3] + v[3] * c0[2];
                  t[4] = v[4] * c1[0] - v[5] * c1[1]; t[5] = v[4] * c1[1] + v[5] * c1[0]; t[6] = v[6] * c1[2] - v[7] * c1[3]; t[7] = v[6] * c1[3] + v[7] * c1[2];
#pragma unroll
                  for (int j = 0; j < 8; ++j) v[j] = t[j]; }
              u32x4 w; w.x = cvtpk(v[0], v[1]); w.y = cvtpk(v[2], v[3]); w.z = cvtpk(v[4], v[5]); w.w = cvtpk(v[6], v[7]); qr[d0] = __builtin_bit_cast(bf16x8, w); } } }
    f32x16 o[2]; o[0] = f32x16{}; o[1] = f32x16{};
    f32x4 o2 = (f32x4){0.f, 0.f, 0.f, 0.f};
    bf16x8 ones; { const unsigned sel = (((lane & 15) < 8) == (((lane >> 4) & 1) == 0)) ? 0x3F803F80u : 0u; u32x4 w; w.x = sel; w.y = sel; w.z = sel; w.w = sel; ones = __builtin_bit_cast(bf16x8, w); }
    const int q2 = 4 * (lane >> 4) + ((lane & 8) ? 16 : 0);
    f32x16 negm = f32x16{};
    float m = 0.f;
    const int qi = u.qoff + wid * 32;
    const int koff = hi * 1024 + r32 * 16;
    const int voff = KBUF + ((lane >> 4) & 1) * 32 + (lane & 3) * 8 + (4 * hi + ((lane & 15) >> 2)) * 64;
    asm volatile("" :: "v"(qr[0]) : "memory");
    if (LPT == 3) FA_WAIT_BAR(6); else FA_WAIT_BAR(4);
    auto qk = [&](int t, f32x16& c0, f32x16& c1) {
        const LAS unsigned char* kb = lds + (t & (NSLOT - 1)) * SLOT + koff;
        bf16x8 kf[2 * ND];
#pragma unroll
        for (int d0 = 0; d0 < ND; ++d0) { kf[2 * d0] = *(const LAS bf16x8*)(kb + d0 * 2048); kf[2 * d0 + 1] = *(const LAS bf16x8*)(kb + d0 * 2048 + 512); }
        c0 = __builtin_amdgcn_mfma_f32_32x32x16_bf16(kf[0], qr[0], negm, 0, 0, 0); c1 = __builtin_amdgcn_mfma_f32_32x32x16_bf16(kf[1], qr[0], negm, 0, 0, 0);
#pragma unroll
#if defined(FA_FAKE) && FA_FAKE == 2
        for (int d0 = 1; d0 < 1; ++d0)
#else
        for (int d0 = 1; d0 < ND; ++d0)
#endif
        { c0 = __builtin_amdgcn_mfma_f32_32x32x16_bf16(kf[2 * d0], qr[d0], c0, 0, 0, 0); c1 = __builtin_amdgcn_mfma_f32_32x32x16_bf16(kf[2 * d0 + 1], qr[d0], c1, 0, 0, 0); }
    };
    auto mask = [&](int t, f32x16& c0, f32x16& c1) {
        if (WIN && t >= u.nt_ctx) { const int jb = (t - u.nt_ctx) * 64;
            if (!((jb + 63 - qi <= 128) && (qi + 31 - jb <= 128))) { const int q = qi + r32;
#pragma unroll
                for (int r = 0; r < 16; ++r) { const int d0_ = jb + crow(r, hi) - q, d1_ = d0_ + 32;
                    if (d0_ > 128 || d0_ < -128) c0[r] = -INFINITY; if (d1_ > 128 || d1_ < -128) c1[r] = -INFINITY; } } }
    };
    auto rowmax = [&](f32x16& c0, f32x16& c1) {
        asm volatile("s_nop 15" : "+v"(c0), "+v"(c1));
        float a0 = mx3(c0[0], c1[0], c0[4]), a1 = mx3(c0[1], c1[1], c0[5]), a2 = mx3(c0[2], c1[2], c0[6]), a3 = mx3(c0[3], c1[3], c0[7]);
        a0 = mx3(a0, c1[4], c0[8]); a1 = mx3(a1, c1[5], c0[9]); a2 = mx3(a2, c1[6], c0[10]); a3 = mx3(a3, c1[7], c0[11]);
        a0 = mx3(a0, c1[8], c0[12]); a1 = mx3(a1, c1[9], c0[13]); a2 = mx3(a2, c1[10], c0[14]); a3 = mx3(a3, c1[11], c0[15]);
        a0 = mx3(a0, c1[12], c1[13]); a1 = mx3(a1, c1[14], c1[15]);
        float rm = mx2(mx3(a0, a1, a2), a3);
        { const auto rr = __builtin_amdgcn_permlane32_swap(__float_as_uint(rm), __float_as_uint(rm), false, false); rm = mx2(__uint_as_float(rr[0]), __uint_as_float(rr[1])); }
        return rm;
    };
    auto rowmax_i = [&](const f32x16& c0, const f32x16& c1) {
        auto I = [](float x) { return __builtin_bit_cast(int, x); };
        auto mx = [](int a, int b, int c) { const int ab = a > b ? a : b; return ab > c ? ab : c; };
        int a0 = mx(I(c0[0]), I(c1[0]), I(c0[4])), a1 = mx(I(c0[1]), I(c1[1]), I(c0[5])), a2 = mx(I(c0[2]), I(c1[2]), I(c0[6])), a3 = mx(I(c0[3]), I(c1[3]), I(c0[7]));
        a0 = mx(a0, I(c1[4]), I(c0[8])); a1 = mx(a1, I(c1[5]), I(c0[9])); a2 = mx(a2, I(c1[6]), I(c0[10])); a3 = mx(a3, I(c1[7]), I(c0[11]));
        a0 = mx(a0, I(c1[8]), I(c0[12])); a1 = mx(a1, I(c1[9]), I(c0[13])); a2 = mx(a2, I(c1[10]), I(c0[14])); a3 = mx(a3, I(c1[11]), I(c0[15]));
        a0 = mx(a0, I(c1[12]), I(c1[13])); a1 = mx(a1, I(c1[14]), I(c1[15]));
        int rmi = mx(a0, a1, a2); rmi = rmi > a3 ? rmi : a3;
        { const auto rr = __builtin_amdgcn_permlane32_swap((unsigned)rmi, (unsigned)rmi, false, false); const int x = (int)rr[0], y = (int)rr[1]; rmi = x > y ? x : y; }
        return rmi;
    };
    auto pv = [&](int t, const u32x4 (&pw)[4]) {
        const LAS unsigned char* vp = lds + (t & (NSLOT - 1)) * SLOT + voff;
#pragma unroll
        for (int d0 = 0; d0 < 2; ++d0)
#pragma unroll
            for (int ks = 0; ks < 4; ++ks) { const s16x4 lo = vtr(vp + d0 * 4096 + ks * 1024), h2 = vtr(vp + d0 * 4096 + ks * 1024 + 512);
                const bf16x8 vf = (bf16x8){lo[0], lo[1], lo[2], lo[3], h2[0], h2[1], h2[2], h2[3]};
                o[d0] = __builtin_amdgcn_mfma_f32_32x32x16_bf16(__builtin_bit_cast(bf16x8, pw[ks]), vf, o[d0], 0, 0, 0); }
#pragma unroll
        for (int ks = 0; ks < 4; ++ks) o2 = __builtin_amdgcn_mfma_f32_16x16x32_bf16(__builtin_bit_cast(bf16x8, pw[ks]), ones, o2, 0, 0, 0);
    };
    auto sum_pack = [&](const f32x16& p0, const f32x16& p1, u32x4 (&pw)[4]) {
#pragma unroll
        for (int k = 0; k < 4; ++k) { pw[0][k] = cvtpk(p0[2 * k], p0[2 * k + 1]); pw[1][k] = cvtpk(p0[8 + 2 * k], p0[9 + 2 * k]); pw[2][k] = cvtpk(p1[2 * k], p1[2 * k + 1]); pw[3][k] = cvtpk(p1[8 + 2 * k], p1[9 + 2 * k]); }
    };
    f32x16 pa, pb, cp;
    qk(0, pa, pb); mask(0, pa, pb);
    { const float rm = rowmax(pa, pb); m = rm;
#pragma unroll
      for (int r = 0; r < 16; ++r) { pa[r] = FA_EXP(pa[r] - rm); cp[r] = pb[r] - rm; negm[r] = -rm; } }
    FA_WAIT1();
#pragma unroll 1
    for (int t = 1; t < NT; ++t) {
        if (t + 2 < NT) issue(t + 2, (t + 2) & (NSLOT - 1));
#define FA_SB __builtin_amdgcn_sched_barrier(0)
        f32x16 c0, c1; u32x4 pw[4]; bf16x8 vf[2][4];
        const LAS unsigned char* vpp = lds + ((t - 1) & (NSLOT - 1)) * SLOT + voff;
        { const LAS unsigned char* kb = lds + (t & (NSLOT - 1)) * SLOT + koff;
          bf16x8 kf[2 * ND];
#pragma unroll
          for (int d0 = 0; d0 < ND; ++d0) { kf[2 * d0] = *(const LAS bf16x8*)(kb + d0 * 2048); kf[2 * d0 + 1] = *(const LAS bf16x8*)(kb + d0 * 2048 + 512); if (d0 == 0) FA_SB; }
          FA_SB;
#pragma unroll
          for (int d0 = 0; d0 < ND; ++d0) {
              if (d0 == 0) { c0 = __builtin_amdgcn_mfma_f32_32x32x16_bf16(kf[0], qr[0], negm, 0, 0, 0);
                  asm("v_mfma_f32_32x32x16_bf16 %0, %1, %2, %3" : "=&v"(c1) : "v"(kf[1]), "v"(qr[0]), "v"(negm)); }
              else { c0 = __builtin_amdgcn_mfma_f32_32x32x16_bf16(kf[2 * d0], qr[d0], c0, 0, 0, 0); c1 = __builtin_amdgcn_mfma_f32_32x32x16_bf16(kf[2 * d0 + 1], qr[d0], c1, 0, 0, 0); }
              if (d0 < 4) {
#pragma unroll
                  for (int r = 4 * d0; r < 4 * d0 + 4; ++r) pb[r] = FA_EXP(cp[r]);
                  if (d0 < 3) {
#pragma unroll
                      for (int k = 0; k < 4; ++k) pw[d0][k] = d0 < 2 ? cvtpk(pa[8 * d0 + 2 * k], pa[8 * d0 + 2 * k + 1]) : cvtpk(pb[2 * k], pb[2 * k + 1]); } }
              if (d0 == ND - 1) {
#pragma unroll
                  for (int k = 0; k < 4; ++k) pw[3][k] = cvtpk(pb[8 + 2 * k], pb[9 + 2 * k]); }
              if (d0 < 4) {
#pragma unroll
                  for (int dd = 0; dd < 2; ++dd) { const s16x4 lo = vtr(vpp + dd * 4096 + d0 * 1024), h2 = vtr(vpp + dd * 4096 + d0 * 1024 + 512); vf[dd][d0] = (bf16x8){lo[0], lo[1], lo[2], lo[3], h2[0], h2[1], h2[2], h2[3]}; } }
              FA_SB; } }
        mask(t, c0, c1);
        int rmi;
        {
          auto I = [](float x) { return __builtin_bit_cast(int, x); };
          auto mx = [](int a, int b, int c) { const int ab = a > b ? a : b; return ab > c ? ab : c; };
          int am[4];
#pragma unroll
          for (int ks = 0; ks < 4; ++ks) {
              const bf16x8 pf = __builtin_bit_cast(bf16x8, pw[ks]);
              o[0] = __builtin_amdgcn_mfma_f32_32x32x16_bf16(pf, vf[0][ks], o[0], 0, 0, 0); o[1] = __builtin_amdgcn_mfma_f32_32x32x16_bf16(pf, vf[1][ks], o[1], 0, 0, 0);
              o2 = __builtin_amdgcn_mfma_f32_16x16x32_bf16(pf, ones, o2, 0, 0, 0);
              const int r0 = 4 * ks;
#pragma unroll
              for (int r = r0; r < r0 + 4; ++r) pa[r] = FA_EXP(c0[r]);
              int a = mx(I(c0[r0]), I(c1[r0]), I(c0[r0 + 1])); a = mx(a, I(c1[r0 + 1]), I(c0[r0 + 2])); a = mx(a, I(c1[r0 + 2]), I(c0[r0 + 3])); am[ks] = a > I(c1[r0 + 3]) ? a : I(c1[r0 + 3]);
              FA_SB; }
          rmi = mx(am[0], am[1], am[2]); rmi = rmi > am[3] ? rmi : am[3];
          { const auto rr = __builtin_amdgcn_permlane32_swap((unsigned)rmi, (unsigned)rmi, false, false); const int x = (int)rr[0], y = (int)rr[1]; rmi = x > y ? x : y; } }
        asm volatile("" : "+v"(pa));
        cp = c1;
#undef FA_SB
        if (FA_FORCE_RESC || __any(rmi > 0x41000000)) {
            const float rm = __builtin_bit_cast(float, rmi);
            const float dl = fmaxf(rm, 0.f); m += dl;
            const float al = __builtin_amdgcn_exp2f(-dl);
            if (hi == 0) wsf[r32] = al;
#pragma unroll
            for (int r = 0; r < 16; ++r) { pa[r] = FA_EXP(c0[r] - dl); cp[r] -= dl; negm[r] = -m; }
#pragma unroll
            for (int r = 0; r < 16; ++r) { const float a = wsf[crow(r, hi)]; o[0][r] *= a; o[1][r] *= a; }
#pragma unroll
            for (int j = 0; j < 4; ++j) o2[j] *= wsf[q2 + j];
        }
        if (t + 2 < NT) FA_WAIT1(); else FA_WAIT_BAR(0);
    }
    { u32x4 pw[4];
#pragma unroll
      for (int r = 0; r < 16; ++r) pb[r] = FA_EXP(cp[r]);
      sum_pack(pa, pb, pw); pv(NT - 1, pw); }
    asm volatile("s_waitcnt lgkmcnt(0)\n\ts_barrier" ::: "memory");
    if (nx.d96 >= 0) prefetch3(nx, lds, wid);
#undef FA_WAIT1
#undef FA_WAIT_BAR
    if (SINK && hi == 0) wsf[r32] = __builtin_amdgcn_exp2f(u.sinkl - m);
    if ((lane & 7) == 0) {
#pragma unroll
        for (int j = 0; j < 4; ++j) wsf[32 + q2 + j] = o2[j]; }
    LAS bf16_t* stg = (LAS bf16_t*)(lds + OFF_OST + wid * 4096);
#pragma unroll
    for (int r = 0; r < 16; ++r) { const int orow = crow(r, hi); float lr = wsf[32 + orow]; if (SINK) lr += wsf[orow]; const float rl = 1.0f / lr;
        stg[orow * 64 + r32] = f2bf(o[0][r] * rl); stg[orow * 64 + 32 + r32] = f2bf(o[1][r] * rl); }
    bf16_t* Ow = u.O + (size_t)(wid * 32) * u.opitch;
#pragma unroll
    for (int i = 0; i < 4; ++i) { const int row = i * 8 + (lane >> 3), ch = lane & 7; const u32x4 v = *(const LAS u32x4*)(stg + row * 64 + ch * 8); *(u32x4*)(Ow + (size_t)row * u.opitch + ch * 8) = v; }
}
}
__device__ __forceinline__ void phase_attn(Ctx& c, int l, unsigned char* lds_, bool ctx_out) {
    LAS unsigned char* lds = (LAS unsigned char*)lds_;
    const int nl = c.nb * 64, total = 3 * nl + (ctx_out ? 3 * c.nb * 8 : 0);
    auto pref_of = [&](int ui) { fa::Pref p; p.Kc = nullptr; p.Vc = nullptr; p.kpitch = 0; p.vpitch = 0; p.d96 = -1;
        if (ui >= total) return p;
        int br, b, h;
        if (ui < 3 * nl) { br = 2 - ui / nl; const int i = ui % nl; b = c.b0 + (i >> 6); h = (i >> 3) & 7; }
        else { const int j = ui - 3 * nl, nc = c.nb * 8; br = 2 - j / nc; const int i = j % nc; b = c.b0 + (i >> 3); h = i & 7; }
        if (br == 2) { const unsigned char* sl = c.ws + WS_RA + (size_t)b * RA_BSTR;
            p.Kc = (const bf16_t*)(sl + RAS_KC) + (size_t)2048 * 768 + 96 * h; p.Vc = (const bf16_t*)(sl + RAS_VC) + (size_t)2048 * 512 + 64 * h; p.kpitch = 768; p.vpitch = 512; p.d96 = 1; }
        else { const int ko = (br == 0 ? P_KA : P_KB) + 64 * (h >> 2), vo = (br == 0 ? P_VA : P_VB) + 64 * (h >> 2); const int crow0 = NLAT + b * CTXL;
            p.Kc = c.P1 + (size_t)crow0 * P1W + ko; p.Vc = c.P1 + (size_t)crow0 * P1W + vo; p.kpitch = P1W; p.vpitch = P1W; p.d96 = 0; }
        return p; };
    { const fa::Pref p0 = pref_of(c.wg); if (p0.d96 >= 0) fa::prefetch3(p0, lds, c.wave); }
    for (int ui = c.wg; ui < total; ui += c.nwg) {
        const fa::Pref nx = pref_of(ui + c.nwg);
        int br, b, h, qb; bool cq;
        if (ui < 3 * nl) { br = 2 - ui / nl; const int i = ui % nl; b = c.b0 + (i >> 6); h = (i >> 3) & 7; qb = i & 7; cq = false; }
        else { const int j = ui - 3 * nl, nc = c.nb * 8; br = 2 - j / nc; const int i = j % nc; b = c.b0 + (i >> 3); h = i & 7; qb = 0; cq = true; }
        const int qrow = cq ? NLAT + b * CTXL : b * SEQ + qb * 256, crow0 = NLAT + b * CTXL, lrow0 = b * SEQ;
        fa::UnitDesc u; u.nt_ctx = 4; u.qoff = 0; u.sinkl = 0.f; u.qss = nullptr; u.qgain = nullptr; u.qrope = nullptr;
        if (br == 2) {
            const unsigned char* sl = c.ws + WS_RA + (size_t)b * RA_BSTR; const int lq = cq ? 2048 : qb * 256;
            u.Q = (const bf16_t*)(sl + RAS_QC) + (size_t)lq * 768 + 96 * h; u.qpitch = 768; u.O = c.P1 + (size_t)qrow * P1W + P_YC + 64 * h; u.opitch = P1W;
            u.Kc = (const bf16_t*)(sl + RAS_KC) + (size_t)2048 * 768 + 96 * h; u.Kl = (const bf16_t*)(sl + RAS_KC) + 96 * h; u.kpitch = 768;
            u.Vc = (const bf16_t*)(sl + RAS_VC) + (size_t)2048 * 512 + 64 * h; u.Vl = (const bf16_t*)(sl + RAS_VC) + 64 * h; u.vpitch = 512;
            u.qss = c.ssq + (size_t)qrow * 24 + 3 * h; u.qgain = c.p->in[20] + l * 96; u.qrope = cq ? nullptr : c.rope_c + (size_t)(qb * 256) * 32;
            u.nt_lat = cq ? 0 : 32;
            fa::attn_unit<96, false, false>(u, lds, c.wave, nx);
        } else {
            const int qo = br == 0 ? P_QA : P_QB, ko = (br == 0 ? P_KA : P_KB) + 64 * (h >> 2), vo = (br == 0 ? P_VA : P_VB) + 64 * (h >> 2);
            bf16_t* qp = c.P1 + (size_t)qrow * P1W + qo + 64 * h;
            u.Q = qp; u.O = qp; u.qpitch = P1W; u.opitch = P1W; u.kpitch = P1W; u.vpitch = P1W;
            u.Kc = c.P1 + (size_t)crow0 * P1W + ko; u.Vc = c.P1 + (size_t)crow0 * P1W + vo;
            if (br == 1) { u.Kl = c.P1 + (size_t)lrow0 * P1W + ko; u.Vl = c.P1 + (size_t)lrow0 * P1W + vo; u.nt_lat = cq ? 0 : 32;
                fa::attn_unit<64, false, false>(u, lds, c.wave, nx); }
            else {
                u.sinkl = c.p->in[13][l * 8 + h] * LOG2E;
                if (cq) { u.Kl = u.Kc; u.Vl = u.Vc; u.nt_lat = 0; fa::attn_unit<64, false, true>(u, lds, c.wave, nx); }
                else { const int lt0 = 4 * qb - 2 < 0 ? 0 : 4 * qb - 2, lt1 = 4 * qb + 5 > 31 ? 31 : 4 * qb + 5;
                    u.Kl = c.P1 + (size_t)(lrow0 + 64 * lt0) * P1W + ko; u.Vl = c.P1 + (size_t)(lrow0 + 64 * lt0) * P1W + vo; u.nt_lat = lt1 - lt0 + 1; u.qoff = 256 * qb - 64 * lt0;
                    fa::attn_unit<64, true, true>(u, lds, c.wave, nx); }
            }
        }
    }
}

constexpr int CW_BAR = 4096;
constexpr int MISC_OFF = 131072 + 320;
#define XB_TMO      128
#define XB_XCNT(j)  (256  + 64 * (j))
#define XB_XSUB(j)  (1280 + 64 * (j))
#define XB_XGEN(j)  (2304 + 64 * (j))
#define XB_TOP      3328
#define XB_TOPGEN   3392
#define XCD_BAR_WORDS 3456
#define XB_SPIN_CAP (1u << 18)
__device__ __forceinline__ unsigned xb_ld(unsigned* p)              { return __hip_atomic_load(p, __ATOMIC_RELAXED, __HIP_MEMORY_SCOPE_AGENT); }
__device__ __forceinline__ unsigned xb_add(unsigned* p, unsigned v) { return __hip_atomic_fetch_add(p, v, __ATOMIC_RELAXED, __HIP_MEMORY_SCOPE_AGENT); }
__device__ __forceinline__ unsigned xb_xcc_id() { return (unsigned)__builtin_amdgcn_s_getreg((3 << 11) | 20) & 0xFu; }
#define XB_SPIN(cond, bar) do { unsigned _sp = 0; while (cond) { __builtin_amdgcn_s_sleep(1); \
    if ((++_sp & 255u) == 0u) { if (xb_ld(&(bar)[XB_TMO])) break; if (_sp > XB_SPIN_CAP) { atomicAdd(&(bar)[XB_TMO], 1u); break; } } } } while (0)
struct XcdBarrier { unsigned* bar; unsigned x; volatile LAS unsigned* st; };
__device__ __forceinline__ void xcd_barrier_complete(unsigned* bar, unsigned x, unsigned& nloc, unsigned& nx) {
    const unsigned G = gridDim.x * gridDim.y * gridDim.z;
    unsigned sum, cnt, mine, sp = 0u;
    for (;;) {
        sum = 0u; cnt = 0u; mine = 0u;
#pragma unroll
        for (unsigned j = 0; j < 16; ++j) { const unsigned cc = xb_ld(&bar[XB_XCNT(j)]); sum += cc; cnt += (cc > 0u) ? 1u : 0u; mine = (j == x) ? cc : mine; }
        if (sum == G) break;
        __builtin_amdgcn_s_sleep(1);
        if ((++sp & 255u) == 0u) { if (xb_ld(&bar[XB_TMO])) break; if (sp > XB_SPIN_CAP) { atomicAdd(&bar[XB_TMO], 1u); break; } }
    }
    nloc = mine > 0u ? mine : 1u; nx = cnt > 0u ? cnt : 1u;
}
__device__ __forceinline__ void xcd_barrier(const XcdBarrier& b, int wave, bool local = false) {
    asm volatile("s_waitcnt vmcnt(0)" ::: "memory");
    __syncthreads();
    if (wave == 0 && lane_id() == 0) {
        unsigned* bar = b.bar;
        __builtin_amdgcn_s_waitcnt(0);
        unsigned nloc = b.st[0], nx = b.st[1];
        if (nloc == 0u) { xcd_barrier_complete(bar, b.x, nloc, nx); b.st[0] = nloc; b.st[1] = nx; }
        const unsigned old = xb_add(&bar[XB_XSUB(b.x)], 1u);
        const unsigned gen = old / nloc;
        if (old + 1u == (gen + 1u) * nloc && local) {
            xb_add(&bar[XB_XGEN(b.x)], 1u);
            __builtin_amdgcn_fence(__ATOMIC_ACQUIRE, "agent");
            asm volatile("s_waitcnt vmcnt(0)" ::: "memory");
        } else if (old + 1u == (gen + 1u) * nloc) {
            __builtin_amdgcn_fence(__ATOMIC_RELEASE, "agent");
            asm volatile("s_waitcnt vmcnt(0)" ::: "memory");
            const unsigned og = xb_add(&bar[XB_TOP], 1u);
            const unsigned tg = og / nx;
            if (og + 1u == (tg + 1u) * nx) xb_add(&bar[XB_TOPGEN], 1u);
            else XB_SPIN(xb_ld(&bar[XB_TOPGEN]) == tg, bar);
            __builtin_amdgcn_fence(__ATOMIC_ACQUIRE, "agent");
            xb_add(&bar[XB_XGEN(b.x)], 1u);
            asm volatile("s_waitcnt vmcnt(0)" ::: "memory");
        } else {
            XB_SPIN(xb_ld(&bar[XB_XGEN(b.x)]) == gen, bar);
            __builtin_amdgcn_fence(__ATOMIC_ACQUIRE, "agent");
            asm volatile("s_waitcnt vmcnt(0)" ::: "memory");
        }
    }
    __syncthreads();
}

template <int S> __device__ __forceinline__ void run_stage(Ctx& c, int l, unsigned char* lds) {
    const Params* p = c.p;
    const bool last = l == DEPTH - 1;
    const int rows_all = MT, rows_mix = last ? NLAT : MT;
    if constexpr (S == -1) phase_mod(c, (float*)lds);
    if constexpr (S == 0) phase_norm(c, l, p->in[6] + l * D, 0, rows_all, l == 0);
    if constexpr (S == 1) naive_ffn_up(c, p->in[7] + (size_t)l * D * 2 * DFF, rows_all);
    if constexpr (S == 2) naive_res(c, l, c.ACT, DFF, DFF, p->in[8] + (size_t)l * DFF * D, 0.5f, 2, rows_all, l == 0);
    if constexpr (S == 3) phase_norm(c, l, p->in[9] + l * D, 3, rows_all, false);
    if constexpr (S == 4) naive_inproj(c, l, rows_all);
    if constexpr (S == 5) naive_rowss(c, rows_all);
    if constexpr (S == 6) { naive_mla_q(c, l, rows_mix); naive_mla_kv(c, l, rows_all); }
    if constexpr (S == 7) naive_attn(c, l, 0, rows_mix);
    if constexpr (S == 8) naive_gates(c, l, rows_mix);
    if constexpr (S == 9) naive_merge(c, l, rows_mix);
    if constexpr (S == 10) naive_res(c, l, c.H, D, D, p->in[25] + (size_t)l * D * D, 1.0f, 5, rows_mix, false);
    if constexpr (S == 11) phase_norm(c, l, p->in[26] + l * D, 6, rows_mix, false);
    if constexpr (S == 12) naive_ffn_up(c, p->in[27] + (size_t)l * D * 2 * DFF, rows_mix);
    if constexpr (S == 13) naive_res(c, l, c.ACT, DFF, DFF, p->in[28] + (size_t)l * DFF * D, 0.5f, 8, rows_mix, false);
    if constexpr (S == 20) phase_convert(c, l, lds);
    if constexpr (S == 21) fast_ffn_up(c, lds, WO_F1IN, rows_all);
    if constexpr (S == 22) fast_res(c, lds, l, c.ACT, DFF, WO_F1OUT, 0.5f, 2, rows_all, l == 0);
    if constexpr (S == 24) fast_inproj(c, lds, l, rows_all);
    if constexpr (S == 26) fast_mla_up(c, lds, l, rows_mix, rows_all);
    if constexpr (S == 27) phase_mla_norm(c, l, rows_mix, rows_all);
    if constexpr (S == 28) fast_gates(c, lds, rows_mix);
    if constexpr (S == 29) fast_merge(c, lds, rows_mix);
    if constexpr (S == 30) fast_res(c, lds, l, c.H, D, WO_OUT, 1.0f, 5, rows_mix, false);
    if constexpr (S == 32) fast_ffn_up(c, lds, WO_F2IN, rows_mix);
    if constexpr (S == 33) fast_res(c, lds, l, c.ACT, DFF, WO_F2OUT, 0.5f, 8, rows_mix, false);
    if constexpr (S == 40) phase_attn(c, l, lds, !last);
    if constexpr (S == 50) phase_convert_bias(c, l, lds);
    if constexpr (S == 51) phase_xg(c, 0, p->in[6], 0, MT, true);
    if constexpr (S == 52) fz_ffn_up(c, lds, WO_F1IN, BO_F1, rows_all);
    if constexpr (S == 53) fz_res(c, lds, l, c.ACT, DFF, DFF, WO_F1OUT, 0.5f, 2, rows_all, l == 0, 9, l * D, l, 3);
    if constexpr (S == 54) fz_inproj(c, lds, l, rows_all);
    if constexpr (S == 55) fz_gates(c, lds, rows_mix);
    if constexpr (S == 56) fz_merge(c, lds, rows_mix);
    if constexpr (S == 57) fz_res(c, lds, l, (const bf16_t*)(c.ws + WS_YC), D, D, WO_OUT, 1.0f, 5, rows_mix, false, 26, l * D, l, 6);
    if constexpr (S == 58) fz_ffn_up(c, lds, WO_F2IN, BO_F2, rows_mix);
    { const int nz = 4 * c.nctx, g1 = c.nwg - nz, cz = c.wg >= g1 ? c.wg - g1 : -1;
    if constexpr (S == 60) fz_ffn_up_sub(c, lds, WO_F1IN, BO_F1, c.ctx0, c.nctx, c.nwg, c.wg, 1 << 20, c.nwg);
    if constexpr (S == 61) { fz_res_sub(c, lds, l, WO_F1OUT, 2, l == 0, 9, l * D, l, 3, c.ctx0, c.nctx, nz, cz);
                             fz_ffn_up_sub(c, lds, WO_F1IN, BO_F1, c.lat0, c.nlat, c.nwg, c.wg, 3, g1); }
    if constexpr (S == 62) fz_res_sub(c, lds, l, WO_F1OUT, 2, l == 0, 9, l * D, l, 3, c.lat0, c.nlat, c.nwg, c.wg);
    if constexpr (S == 63) fz_ffn_up_sub(c, lds, WO_F2IN, BO_F2, c.ctx0, c.nctx, c.nwg, c.wg, 1 << 20, c.nwg);
    if constexpr (S == 64) { fz_res_sub(c, lds, l, WO_F2OUT, 8, false, 6, (l + 1) * D, l + 1, 0, c.ctx0, c.nctx, nz, cz);
                             fz_ffn_up_sub(c, lds, WO_F2IN, BO_F2, c.lat0, c.nlat, c.nwg, c.wg, 3, g1); }
    if constexpr (S == 65) fz_res_sub(c, lds, l, WO_F2OUT, 8, false, 6, (l + 1) * D, l + 1, 0, c.lat0, c.nlat, c.nwg, c.wg); }
    if constexpr (S == 59) fz_res(c, lds, l, c.ACT, DFF, DFF, WO_F2OUT, 0.5f, 8, rows_mix, false, last ? -1 : 6, (l + 1) * D, last ? l : l + 1, 0);
}
template <int S> __global__ void __launch_bounds__(512, 2) k_stage(Params prm, int l) {
    extern __shared__ __attribute__((aligned(16))) unsigned char lds[];
    Ctx c; ctx_init(c, &prm, blockIdx.x, gridDim.x);
    run_stage<S>(c, l, lds);
}
constexpr int LDS_NAIVE = 65536, LDS_FAST = 147456;
#ifndef MULTI
#define MULTI 0
#endif
#ifndef PROBE_K
#define PROBE_K -1
#endif
#ifndef PROBE_WG
#define PROBE_WG 0
#endif
#ifndef PROBE_SCALE
#define PROBE_SCALE 10000.0f
#endif
__global__ void __launch_bounds__(512, 2) mega_kernel(Params prm) {
    extern __shared__ __attribute__((aligned(16))) unsigned char lds[];
    Ctx c; ctx_init(c, &prm, blockIdx.x, gridDim.x);
    volatile LAS unsigned* MISC = (volatile LAS unsigned*)((LAS unsigned char*)lds + MISC_OFF);
    { const int ln = lane_id(); if (c.wave == 0 && ln < 32) MISC[ln] = 0u; }
    __syncthreads();
    XcdBarrier bar; bar.bar = (unsigned*)(prm.ws + WS_CTL) + CW_BAR; bar.x = xb_xcc_id(); bar.st = MISC + 8;
    if (c.wave == 0 && lane_id() == 0) MISC[10] = xb_add(&bar.bar[XB_XCNT(bar.x)], 1u);
    __syncthreads();
#if PROBE_K >= 0
    unsigned long long tacc = 0, t0 = __builtin_amdgcn_s_memrealtime(), t1; int lastk = -1;
#ifndef PROBE_INCL_BAR
#define PROBE_INCL_BAR 0
#endif
#if PROBE_K >= 10
#define PH(k, body) do { t0 = __builtin_amdgcn_s_memtime(); body; t1 = __builtin_amdgcn_s_memtime(); lastk = (k); if (PROBE_K - 10 == (k)) tacc += t1 - t0; } while (0)
#else
#define PH(k, body) do { t0 = __builtin_amdgcn_s_memrealtime(); body; t1 = __builtin_amdgcn_s_memrealtime(); lastk = (k); if (PROBE_K == (k) || PROBE_K == 7) tacc += t1 - t0; } while (0)
#endif
#define GRID_BAR() do { t0 = __builtin_amdgcn_s_memrealtime(); xcd_barrier(bar, c.wave); t1 = __builtin_amdgcn_s_memrealtime(); if (PROBE_K == 1 || PROBE_K == 7 || (PROBE_INCL_BAR && PROBE_K == lastk)) tacc += t1 - t0; } while (0)
#define LBAR() do { t0 = __builtin_amdgcn_s_memrealtime(); xcd_barrier(bar, c.wave, local); t1 = __builtin_amdgcn_s_memrealtime(); if (PROBE_K == 1 || PROBE_K == 7 || (PROBE_INCL_BAR && PROBE_K == lastk)) tacc += t1 - t0; } while (0)
#else
#define PH(k, body) do { body; } while (0)
#define GRID_BAR() xcd_barrier(bar, c.wave)
#define LBAR() xcd_barrier(bar, c.wave, local)
#endif
    PH(6, run_stage<-1>(c, 0, lds)); GRID_BAR();
    bool local = false; int gb = 0;
    { int npop = 0, below = 0; bool uni = true;
#pragma unroll
      for (unsigned j = 0; j < 16; ++j) { const unsigned cj = (unsigned)__builtin_amdgcn_readfirstlane((int)xb_ld(&bar.bar[XB_XCNT(j)])); if (cj) { ++npop; uni = uni && cj == 32u; below += (j < bar.x) ? 1 : 0; } }
      local = gridDim.x == 256 && npop == 8 && uni; gb = below; }
    const int gwg = c.wg, gnwg = c.nwg;
    const int lrank = __builtin_amdgcn_readfirstlane((int)MISC[10]);
#define SET_LOCAL() do { if (local) { c.wg = lrank; c.nwg = 32; c.lat0 = 8 * gb; c.nlat = 8; c.ctx0 = NLAT / 256 + gb; c.nctx = 1; c.b0 = gb; c.nb = 1; } } while (0)
#define SET_GLOBAL() do { c.wg = gwg; c.nwg = gnwg; c.lat0 = 0; c.nlat = NLAT / 256; c.ctx0 = NLAT / 256; c.nctx = NCTX / 256; c.b0 = 0; c.nb = NB_; } while (0)
#pragma unroll 1
    for (int l = 0; l < DEPTH; ++l) {
        SET_GLOBAL();
        PH(6, run_stage<50>(c, l, lds); if (l == 0) run_stage<51>(c, l, lds)); GRID_BAR();
        SET_LOCAL();
        const bool split = c.nctx > 0 && (c.nwg - 4 * c.nctx) * 2 >= c.nwg && c.nlat * 22 >= 3 * c.nwg;
        if (split) { PH(2, run_stage<60>(c, l, lds)); LBAR(); PH(2, run_stage<61>(c, l, lds)); LBAR(); PH(3, run_stage<62>(c, l, lds)); LBAR(); }
        else { PH(2, run_stage<52>(c, l, lds)); LBAR(); PH(3, run_stage<53>(c, l, lds)); LBAR(); }
        PH(4, run_stage<54>(c, l, lds)); LBAR();
        PH(5, run_stage<26>(c, l, lds)); LBAR();
        PH(0, run_stage<40>(c, l, lds)); LBAR();
        PH(4, run_stage<55>(c, l, lds)); LBAR();
        PH(5, run_stage<56>(c, l, lds)); LBAR();
        PH(5, run_stage<57>(c, l, lds)); LBAR();
        if (l + 1 < DEPTH) {
            if (split) { PH(2, run_stage<63>(c, l, lds)); LBAR(); PH(2, run_stage<64>(c, l, lds)); LBAR(); PH(3, run_stage<65>(c, l, lds)); }
            else { PH(2, run_stage<58>(c, l, lds)); LBAR(); PH(3, run_stage<59>(c, l, lds)); }
            GRID_BAR();
        } else { PH(2, run_stage<58>(c, l, lds)); LBAR(); PH(3, run_stage<59>(c, l, lds)); }
    }
#undef SET_LOCAL
#undef SET_GLOBAL
#undef LBAR
#if PROBE_K >= 0
    xcd_barrier(bar, c.wave);
    if (blockIdx.x == PROBE_WG && c.wave == 0 && lane_id() == 0) prm.out[0] +=
#ifdef FA_FAKE
        (float)((tacc / 1600ull) * 16ull) / PROBE_SCALE;
#else
        (float)tacc * 0.01f / PROBE_SCALE;
#endif
    (void)0;
#endif
#undef GRID_BAR
#undef PH
}
#ifndef PROBE_WG
#define PROBE_WG 0
#endif
static int g_cus = 0;
template <int S> static void launch_stage(const Params& p, int l, hipStream_t stream) {
    constexpr bool fast = S >= 20;
    static int inited = 0;
    if (!inited) { (void)hipFuncSetAttribute((const void*)k_stage<S>, hipFuncAttributeMaxDynamicSharedMemorySize, fast ? LDS_FAST : LDS_NAIVE); inited = 1; }
    hipLaunchKernelGGL(k_stage<S>, dim3(fast ? g_cus : 1024), dim3(512), fast ? LDS_FAST : LDS_NAIVE, stream, p, l);
}
#ifndef FASTMASK
#define FASTMASK 0xffff
#endif
template <int BIT, int SF, int SN> static void launch_sel(const Params& p, int l, hipStream_t stream) { if constexpr ((FASTMASK >> BIT) & 1) launch_stage<SF>(p, l, stream); else launch_stage<SN>(p, l, stream); }

extern "C" void kernel_launch(void* const* d_in, const int* in_sizes, int n_in, void* d_out, int out_size, void* d_ws, size_t ws_size, hipStream_t stream) {
    if (n_in != 29 || out_size != NLAT * D || ws_size < WS_END) { fprintf(stderr, "kernel_launch: unexpected shapes (n_in %d out %d ws %zu need %zu)\n", n_in, out_size, ws_size, (size_t)WS_END); return; }
    if (!g_cus) { int dev = 0; (void)hipGetDevice(&dev); (void)hipDeviceGetAttribute(&g_cus, hipDeviceAttributeMultiprocessorCount, dev); if (g_cus <= 0) g_cus = 256;
        (void)hipFuncSetAttribute((const void*)mega_kernel, hipFuncAttributeMaxDynamicSharedMemorySize, LDS_FAST); }
    Params p{};
    for (int i = 0; i < 29; ++i) p.in[i] = (const float*)d_in[i];
    p.out = (float*)d_out; p.ws = (unsigned char*)d_ws;
    for (int f = 0; f < 16; ++f) p.invf_hd[f] = (float)pow(10000.0, -(double)f / 16.0);
    for (int f = 0; f < 8; ++f) p.invf_c[f] = (float)pow(10000.0, -(double)f / 8.0);
    (void)hipMemsetAsync((char*)d_ws + WS_CTL, 0, 64u << 10, stream);
#if !MULTI
    hipLaunchKernelGGL(mega_kernel, dim3(g_cus), dim3(512), LDS_FAST, stream, p);
#else
    launch_stage<-1>(p, 0, stream);
    for (int l = 0; l < DEPTH; ++l) {
        launch_stage<20>(p, l, stream);
        launch_stage<0>(p, l, stream);
        launch_sel<0, 21, 1>(p, l, stream);
        launch_sel<1, 22, 2>(p, l, stream);
        launch_stage<3>(p, l, stream);
        launch_sel<2, 24, 4>(p, l, stream);
        if constexpr (!((FASTMASK >> 2) & 1)) launch_stage<5>(p, l, stream);
        if constexpr ((FASTMASK >> 3) & 1) { launch_stage<26>(p, l, stream); } else launch_stage<6>(p, l, stream);
        launch_sel<9, 40, 7>(p, l, stream);
        launch_sel<4, 28, 8>(p, l, stream);
        launch_sel<5, 29, 9>(p, l, stream);
        launch_sel<6, 30, 10>(p, l, stream);
        launch_stage<11>(p, l, stream);
        launch_sel<7, 32, 12>(p, l, stream);
        launch_sel<8, 33, 13>(p, l, stream);
    }
#endif
}
```
